# Optimizing an MI355X kernel written in HIP

```python
import functools
import jax
import jax.numpy as jnp
from jax import lax
import numpy as np

D_MODEL = 2048
BATCH = 1
SEQ = 8192
DEPTH = 2
DEC_BATCH = 32
DEC_SEQ = 8
PAST_LEN = 8192
PAGE_SIZE = 128

HEAD_DIM = 128
N_HEADS_TOTAL = D_MODEL // HEAD_DIM
H_M = N_HEADS_TOTAL // 2
H_A = N_HEADS_TOTAL - H_M
DK_M = HEAD_DIM // 2
DV_M = HEAD_DIM
MLSTM_CHUNK = 64
DILATIONS = ((128, 1), (512, 4), (2048, 16))
MAX_WINDOW = 2048
ATT_BLOCK = 128
ROPE_THETA = 10000.0
D_FF = 5632
CONV_W = 3
ALPHA = (2 * DEPTH) ** 0.25
BETA = (8 * DEPTH) ** -0.25
LN_EPS = 1e-5
HEAD_NORM_EPS = 1e-6
IN_SIZES = (H_M * DK_M, H_M * DK_M, H_M * DV_M, H_M * DV_M, H_M, H_M,
            H_A * HEAD_DIM, H_A * HEAD_DIM, H_A * HEAD_DIM)
D_IN = sum(IN_SIZES)

kernel_name = 'hymba_mlstm_dilated_convffn_step'


def _layer_norm(x, g, b):
    xf = x.astype(jnp.float32)
    mu = jnp.mean(xf, -1, keepdims=True)
    var = jnp.mean(jnp.square(xf - mu), -1, keepdims=True)
    y = (xf - mu) * lax.rsqrt(var + LN_EPS) * g.astype(jnp.float32) + b.astype(jnp.float32)
    return y.astype(x.dtype)


def _rope(x, pos):
    half = HEAD_DIM // 2
    inv = ROPE_THETA ** (-jnp.arange(half, dtype=jnp.float32) / half)
    ang = pos.astype(jnp.float32)[:, None] * inv[None, :]
    cos = jnp.cos(ang)[None, :, None, :]
    sin = jnp.sin(ang)[None, :, None, :]
    xf = x.astype(jnp.float32)
    x1, x2 = xf[..., :half], xf[..., half:]
    return jnp.concatenate([x1 * cos - x2 * sin, x2 * cos + x1 * sin], -1).astype(x.dtype)


def _split_cols(p):
    outs, start = [], 0
    for n in IN_SIZES:
        outs.append(p[..., start:start + n])
        start += n
    return outs


def _project_in(u, w_in, b_gate, pos):
    B, T, _ = u.shape
    f32 = jnp.float32
    qm, km, vm, om, ig, fg, qa, ka, va = _split_cols(u @ w_in)
    qm = qm.reshape(B, T, H_M, DK_M).astype(f32)
    km = km.reshape(B, T, H_M, DK_M).astype(f32) * (DK_M ** -0.5)
    vm = vm.reshape(B, T, H_M, DV_M).astype(f32)
    ig = ig.astype(f32) + b_gate[0].astype(f32)
    lf = jax.nn.log_sigmoid(fg.astype(f32) + b_gate[1].astype(f32))
    qa = _rope(qa.reshape(B, T, H_A, HEAD_DIM), pos)
    ka = _rope(ka.reshape(B, T, H_A, HEAD_DIM), pos)
    va = va.reshape(B, T, H_A, HEAD_DIM)
    return qm, km, vm, om, ig, lf, qa, ka, va


def _mlstm_chunk(carry, inp):
    C0, n0, m0 = carry
    q, k, v, ig, lf = inp
    L = q.shape[1]
    b = jnp.cumsum(lf, axis=1)
    causal = jnp.arange(L)[:, None] >= jnp.arange(L)[None, :]
    dmat = b[:, :, None] - b[:, None] + ig[:, None]
    dmat = jnp.where(causal[None, :, :, None], dmat, -jnp.inf)
    m_inter = b + m0[:, None]
    m = jnp.maximum(m_inter, dmat.max(axis=2))
    w = jnp.exp(dmat - m[:, :, None])
    g = jnp.exp(m_inter - m)
    s = jnp.einsum('bthk,bshk->btsh', q, k) * w
    num = g[..., None] * jnp.einsum('bthk,bhkv->bthv', q, C0) + jnp.einsum('btsh,bshv->bthv', s, v)
    den = g * jnp.einsum('bthk,bhk->bth', q, n0) + s.sum(2)
    h = num / jnp.maximum(jnp.abs(den), jnp.exp(-m))[..., None]
    a = b[:, -1:] - b + ig
    m_end = jnp.maximum(b[:, -1] + m0, a.max(1))
    ws = jnp.exp(a - m_end[:, None])
    g_end = jnp.exp(b[:, -1] + m0 - m_end)
    C1 = g_end[..., None, None] * C0 + jnp.einsum('bsh,bshk,bshv->bhkv', ws, k, v)
    n1 = g_end[..., None] * n0 + jnp.einsum('bsh,bshk->bhk', ws, k)
    return (C1, n1, m_end), h


def _mlstm_prompt(q, k, v, ig, lf):
    B, S = q.shape[:2]
    L = MLSTM_CHUNK
    NC = S // L

    def chunks(x):
        return jnp.moveaxis(x.reshape((B, NC, L) + x.shape[2:]), 1, 0)

    f32 = jnp.float32
    init = (jnp.zeros((B, H_M, DK_M, DV_M), f32), jnp.zeros((B, H_M, DK_M), f32), jnp.zeros((B, H_M), f32))
    state, h = lax.scan(_mlstm_chunk, init, (chunks(q), chunks(k), chunks(v), chunks(ig), chunks(lf)))
    h = jnp.moveaxis(h, 0, 1).reshape(B, S, H_M, DV_M)
    return h, state


def _dilated_branch_prompt(q, k, v, window, dil):
    B, S, H, D = q.shape
    U = S // dil
    nb = -(-U // ATT_BLOCK)
    Up = nb * ATT_BLOCK

    def sub(x):
        return jnp.transpose(x.reshape(B, U, dil, H, D), (0, 2, 1, 3, 4))

    qs = jnp.pad(sub(q), ((0, 0), (0, 0), (0, Up - U), (0, 0), (0, 0))).reshape(B, dil, nb, ATT_BLOCK, H, D)

    def kwin(x):
        xp = jnp.pad(sub(x), ((0, 0), (0, 0), (ATT_BLOCK, Up - U), (0, 0), (0, 0)))
        xp = xp.reshape(B, dil, nb + 1, ATT_BLOCK, H, D)
        return jnp.concatenate([xp[:, :, :-1], xp[:, :, 1:]], axis=3)

    ks, vs = kwin(k), kwin(v)
    s = jnp.einsum('bgnqhd,bgnkhd->bgnhqk', qs, ks)
    qi = jnp.arange(ATT_BLOCK)[:, None]
    ki = jnp.arange(2 * ATT_BLOCK)[None, :]
    dist = qi + ATT_BLOCK - ki
    key_sub = jnp.arange(nb)[:, None, None] * ATT_BLOCK - ATT_BLOCK + ki[None]
    valid = (dist >= 0) & (dist <= window // dil) & (key_sub >= 0)
    s = jnp.where(valid[:, None], s, -jnp.inf)
    m = s.max(-1)
    p = jnp.exp(s - m[..., None])
    den = p.sum(-1)
    num = jnp.einsum('bgnhqk,bgnkhd->bgnqhd', p, vs)

    def unsub(y):
        y = y.reshape((B, dil, Up) + y.shape[4:])[:, :, :U]
        y = jnp.moveaxis(y, 1, 2)
        return y.reshape((B, S) + y.shape[3:])

    return unsub(num), unsub(jnp.swapaxes(m, -1, -2)), unsub(jnp.swapaxes(den, -1, -2))


def _dilated_branch_sample(q, k_all, v_all, window, dil):
    T = q.shape[1]
    n_buf = k_all.shape[1] - T
    J = window // dil + 1
    idx = n_buf + jnp.arange(T)[:, None] - dil * jnp.arange(J)[None, :]
    valid = idx >= 0
    idxc = jnp.maximum(idx, 0)
    kg = k_all[:, idxc]
    vg = v_all[:, idxc]
    s = jnp.einsum('bthd,btjhd->bthj', q, kg)
    s = jnp.where(valid[None, :, None, :], s, -jnp.inf)
    m = s.max(-1)
    p = jnp.exp(s - m[..., None])
    den = p.sum(-1)
    num = jnp.einsum('bthj,btjhd->bthd', p, vg)
    return num, m, den


def _combine(parts):
    M = parts[0][1]
    for _, m, _ in parts[1:]:
        M = jnp.maximum(M, m)
    num, m0, den0 = parts[0]
    w0 = jnp.exp(m0 - M)
    acc_num = w0[..., None] * num
    acc_den = w0 * den0
    for num, m, den in parts[1:]:
        w = jnp.exp(m - M)
        acc_num = acc_num + w[..., None] * num
        acc_den = acc_den + w * den
    return acc_num / acc_den[..., None]


def _mixer_merge(h, om, g_head, att, w_out):
    B, T = h.shape[:2]
    hn = h * lax.rsqrt(jnp.mean(h * h, -1, keepdims=True) + HEAD_NORM_EPS) * g_head.astype(jnp.float32)
    hm = hn.reshape(B, T, H_M * DV_M) * jax.nn.sigmoid(om.astype(jnp.float32))
    cat = jnp.concatenate([hm, att.reshape(B, T, H_A * HEAD_DIM)], -1).astype(w_out.dtype)
    return cat @ w_out


def _conv_ffn(u, buf, w_up, conv_w, conv_b, w_down):
    T = u.shape[1]
    gv = u @ w_up
    g, v = gv[..., :D_FF], gv[..., D_FF:]
    gp = jnp.concatenate([buf.astype(g.dtype), g], axis=1)
    acc = gp[:, 0:T] * conv_w[0]
    for j in range(1, CONV_W):
        acc = acc + gp[:, j:j + T] * conv_w[j]
    a = jax.nn.silu(acc + conv_b) * v
    return a @ w_down, gp[:, T:]


def _prompt_core(qm, km, vm, ig, lf, qa, ka, va):
    S = qm.shape[1]
    h, (C, n, m) = _mlstm_prompt(qm, km, vm, ig, lf)
    q = qa.astype(jnp.float32) * (HEAD_DIM ** -0.5)
    k = ka.astype(jnp.float32)
    v = va.astype(jnp.float32)
    att = _combine([_dilated_branch_prompt(q, k, v, w, d) for (w, d) in DILATIONS])
    wp = min(MAX_WINDOW, S)
    return h, att, (ka[:, S - wp:], va[:, S - wp:], C, n, m)


def _sample_core(qm, km, vm, ig, lf, qa, ka, va, cache_k, cache_v, C0, n0, m0):
    f32 = jnp.float32
    (C, n, m), h = _mlstm_chunk((C0.astype(f32), n0.astype(f32), m0.astype(f32)), (qm, km, vm, ig, lf))
    q = qa.astype(f32) * (HEAD_DIM ** -0.5)
    k_all = jnp.concatenate([cache_k.astype(f32), ka.astype(f32)], axis=1)
    v_all = jnp.concatenate([cache_v.astype(f32), va.astype(f32)], axis=1)
    att = _combine([_dilated_branch_sample(q, k_all, v_all, w, d) for (w, d) in DILATIONS])
    return h, att, (ka, va, C, n, m)


def _trunk_layer(x, c, pos, core, conv_buf, w_ada, b_ada, w_in, b_gate, g_head, w_out,
                 ln1_g, ln1_b, w_up, conv_w, conv_b, w_down, ln2_g, ln2_b):
    mod = (jax.nn.silu(c) @ w_ada + b_ada)[:, None, :]
    sh1, sc1, gt1, sh2, sc2, gt2 = jnp.split(mod, 6, axis=-1)
    u = x * (1 + sc1) + sh1
    qm, km, vm, om, ig, lf, qa, ka, va = _project_in(u, w_in, b_gate, pos)
    h, att, mix_state = core(qm, km, vm, ig, lf, qa, ka, va)
    mix = _mixer_merge(h, om, g_head, att, w_out)
    x = _layer_norm(ALPHA * x + (1 + gt1) * mix, ln1_g, ln1_b)
    u2 = x * (1 + sc2) + sh2
    f, new_buf = _conv_ffn(u2, conv_buf, w_up, conv_w, conv_b, w_down)
    x = _layer_norm(ALPHA * x + (1 + gt2) * f, ln2_g, ln2_b)
    return x, mix_state, new_buf


def setup_inputs(seed: int = 0) -> dict:
    key = jax.random.key(seed)
    ks = jax.random.split(key, 32)
    f32 = jnp.float32

    def nrm(k, shape, s):
        return s * jax.random.normal(k, shape, f32)

    wb = min(MAX_WINDOW, PAST_LEN)
    b_gate = jnp.stack([nrm(ks[0], (DEPTH, H_M), 0.1),
                        jnp.linspace(3.0, 6.0, H_M, dtype=f32)[None, :] + nrm(ks[1], (DEPTH, H_M), 0.1)], axis=1)
    return {
        'x_prompt': nrm(ks[2], (BATCH, SEQ, D_MODEL), 1.0),
        'x_sample': nrm(ks[3], (DEC_BATCH, DEC_SEQ, D_MODEL), 1.0),
        'cache_k_win': nrm(ks[4], (DEPTH, DEC_BATCH, wb, H_A, HEAD_DIM), 1.0),
        'cache_v_win': nrm(ks[5], (DEPTH, DEC_BATCH, wb, H_A, HEAD_DIM), 1.0),
        'state_C': nrm(ks[6], (DEPTH, DEC_BATCH, H_M, DK_M, DV_M), 1.0),
        'state_n': nrm(ks[7], (DEPTH, DEC_BATCH, H_M, DK_M), 1.0),
        'state_m': nrm(ks[8], (DEPTH, DEC_BATCH, H_M), 1.0),
        'state_conv': nrm(ks[9], (DEPTH, DEC_BATCH, CONV_W - 1, D_FF), 1.0),
        'c_prompt': nrm(ks[10], (BATCH, D_MODEL), 1.0),
        'c_sample': nrm(ks[11], (DEC_BATCH, D_MODEL), 1.0),
        'w_ada': nrm(ks[12], (DEPTH, D_MODEL, 6 * D_MODEL), 0.1 * D_MODEL ** -0.5),
        'b_ada': nrm(ks[13], (DEPTH, 6 * D_MODEL), 0.02),
        'w_in': nrm(ks[14], (DEPTH, D_MODEL, D_IN), D_MODEL ** -0.5),
        'b_gate': b_gate,
        'g_head': 1.0 + nrm(ks[15], (DEPTH, H_M, DV_M), 0.02),
        'w_out': nrm(ks[16], (DEPTH, D_MODEL, D_MODEL), BETA * D_MODEL ** -0.5),
        'ln1_g': 1.0 + nrm(ks[17], (DEPTH, D_MODEL), 0.02),
        'ln1_b': nrm(ks[18], (DEPTH, D_MODEL), 0.02),
        'w_up': nrm(ks[19], (DEPTH, D_MODEL, 2 * D_FF), D_MODEL ** -0.5),
        'conv_w': nrm(ks[20], (DEPTH, CONV_W, D_FF), CONV_W ** -0.5),
        'conv_b': nrm(ks[21], (DEPTH, D_FF), 0.02),
        'w_down': nrm(ks[22], (DEPTH, D_FF, D_MODEL), BETA * (2.0 / (D_FF + D_MODEL)) ** 0.5),
        'ln2_g': 1.0 + nrm(ks[23], (DEPTH, D_MODEL), 0.02),
        'ln2_b': nrm(ks[24], (DEPTH, D_MODEL), 0.02),
    }


def reference(x_prompt, x_sample, cache_k_win, cache_v_win, state_C, state_n, state_m, state_conv,
              c_prompt, c_sample, w_ada, b_ada, w_in, b_gate, g_head, w_out, ln1_g, ln1_b,
              w_up, conv_w, conv_b, w_down, ln2_g, ln2_b):
    B, S = x_prompt.shape[:2]
    T = x_sample.shape[1]
    pos_p = jnp.arange(S, dtype=jnp.int32)
    pos_s = PAST_LEN + jnp.arange(T, dtype=jnp.int32)
    xp, xs = x_prompt, x_sample
    kp_l, vp_l, Cp_l, np_l, mp_l, bp_l = [], [], [], [], [], []
    ks_l, vs_l, Cs_l, ns_l, ms_l, bs_l = [], [], [], [], [], []
    for l in range(DEPTH):
        wl = (w_ada[l], b_ada[l], w_in[l], b_gate[l], g_head[l], w_out[l], ln1_g[l], ln1_b[l],
              w_up[l], conv_w[l], conv_b[l], w_down[l], ln2_g[l], ln2_b[l])
        buf0 = jnp.zeros((B, CONV_W - 1, D_FF), xp.dtype)
        xp, (kp, vp, Cp, n_p, mp), bp = _trunk_layer(xp, c_prompt, pos_p, _prompt_core, buf0, *wl)
        core_s = functools.partial(_sample_core, cache_k=cache_k_win[l], cache_v=cache_v_win[l],
                                   C0=state_C[l], n0=state_n[l], m0=state_m[l])
        xs, (ksn, vsn, Cs, n_s, ms), bs = _trunk_layer(xs, c_sample, pos_s, core_s, state_conv[l], *wl)
        kp_l.append(kp); vp_l.append(vp); Cp_l.append(Cp); np_l.append(n_p); mp_l.append(mp); bp_l.append(bp)
        ks_l.append(ksn); vs_l.append(vsn); Cs_l.append(Cs); ns_l.append(n_s); ms_l.append(ms); bs_l.append(bs)
    return (xp, xs,
            jnp.stack(kp_l), jnp.stack(vp_l), jnp.stack(Cp_l), jnp.stack(np_l), jnp.stack(mp_l), jnp.stack(bp_l),
            jnp.stack(ks_l), jnp.stack(vs_l), jnp.stack(Cs_l), jnp.stack(ns_l), jnp.stack(ms_l), jnp.stack(bs_l))
```

```cpp
#include <hip/hip_runtime.h>
#include <cstdio>
#include <cstdint>
namespace pg8 {
#define PG8_LAS __attribute__((address_space(3)))
typedef unsigned short bf16_t;
typedef short bf16x8 __attribute__((ext_vector_type(8)));
typedef float f32x4 __attribute__((ext_vector_type(4)));
typedef unsigned u32x4 __attribute__((ext_vector_type(4)));
constexpr int BM = 256, BK = 64, HALF = 128, HTB = HALF * BK * 2  , STAGE_BYTES = 8 * HTB, NXCD = 8, WGM = 8;

__host__ __device__ __forceinline__ int lds_byte(int r, int c) { const int st = (r >> 4) * 2 + (c >> 5), rr = r & 15, cc = c & 31, ob = rr * 64 + cc * 2; return st * 1024 + (ob ^ (((ob >> 9) & 1) << 5)); }
__host__ __device__ __forceinline__ void stage_rc(int b, int& R, int& C) { const int st = b / 1024, sb = b % 1024, swz = sb ^ (((sb >> 9) & 1) << 5); R = (st >> 1) * 16 + swz / 64; C = (st & 1) * 32 + (swz % 64) / 2; }
__host__ __device__ __forceinline__ int perm32(int rho) { const int n = rho >> 4, i = rho & 15; return 8 * (i >> 2) + 4 * n + (i & 3); }

struct Unit { int pm, pn; };
struct Gemm { const bf16_t* A; const bf16_t* Bt; int M, N, K; };

struct StaticOrder {
    int nM, nN, nwg, G, c;
    __host__ __device__ void init(int M, int N, int G_, int c_) { nM = M / BM; nN = N / BM; nwg = nM * nN; G = G_; c = c_; }
    __host__ __device__ bool next(int i, Unit& u) const {
        const long L = (long)i * G + c; if (L >= nwg) return false;
        int wgid = (int)L; { const int q = nwg / NXCD, r = nwg % NXCD, xcd = wgid % NXCD, off = wgid / NXCD; wgid = (xcd < r ? xcd * (q + 1) : r * (q + 1) + (xcd - r) * q) + off; }
        const int nig = WGM * nN, gid = wgid / nig, fm = gid * WGM, gsz = (nM - fm) < WGM ? (nM - fm) : WGM;
        u.pm = fm + ((wgid % nig) % gsz); u.pn = (wgid % nig) / gsz; return true;
    }
    __device__ __forceinline__ void a_ready(const Unit&) const {}
    __device__ __forceinline__ void done(const Unit&) const {}
};

__device__ __forceinline__ unsigned cvt_pk_bf16(float lo, float hi) { unsigned r; asm volatile("v_cvt_pk_bf16_f32 %0, %1, %2" : "=v"(r) : "v"(lo), "v"(hi)); return r; }
template <class Epi, class Sched, bool ALIGN_EPI = false, bool SP2 = false>
__device__ __forceinline__ void gemm_phase(PG8_LAS unsigned char* lds, const Gemm g, const Sched& S, const Epi& E) {
    int tid_ = threadIdx.x; asm volatile("" : "+v"(tid_));
    const int tid = tid_, wid = __builtin_amdgcn_readfirstlane(tid >> 6), lane = tid & 63, wr = wid >> 2, wc = wid & 3, fr = lane & 15, fq = lane >> 4;
    const int K = g.K, nt = K / BK;
    unsigned voffA[2], voffB[2];
#pragma unroll
    for (int i = 0; i < 2; ++i) { int R, C; stage_rc(tid * 16 + i * 8192, R, C); const int Rb = Epi::PERM ? ((R & ~31) + perm32(R & 31)) : R;
        voffA[i] = (unsigned)(R * K + C) * 2u; voffB[i] = (unsigned)(Rb * K + C) * 2u; }
    const size_t kstep = (size_t)(BK * 2);
    const size_t hstep = (size_t)HALF * K * 2;
    const size_t tstep = 2 * hstep;
    const unsigned ldsw = (unsigned)wid * 1024u;
    const int aoff = lds_byte(wr * 64 + fr, fq * 8), boff = lds_byte(wc * 32 + fr, fq * 8);
#define PG8_SA(b, h) (((b) * 2 + (h)) * HTB)
#define PG8_SB(b, h) ((4 + (b) * 2 + (h)) * HTB)
#define PG8_STAGE(bufoff, gbase, voff) do { _Pragma("unroll") for (int _i = 0; _i < 2; ++_i) \
        __builtin_amdgcn_global_load_lds((const unsigned*)((const char*)(gbase) + (voff)[_i]), (PG8_LAS unsigned*)(lds + (bufoff) + ldsw + _i * 8192), 16, 0, 0); } while (0)
#define PG8_LDA(dst, b, h) do { _Pragma("unroll") for (int m = 0; m < 4; ++m) _Pragma("unroll") for (int k = 0; k < 2; ++k) dst[m][k] = *(const PG8_LAS bf16x8*)(lds + PG8_SA(b, h) + aoff + m * 2048 + k * 1024); } while (0)
#define PG8_LDB(dst, b, h) do { _Pragma("unroll") for (int n = 0; n < 2; ++n) _Pragma("unroll") for (int k = 0; k < 2; ++k) dst[n][k] = *(const PG8_LAS bf16x8*)(lds + PG8_SB(b, h) + boff + n * 2048 + k * 1024); } while (0)
#define PG8_MMA(ai, bj, At, Bt) do { __builtin_amdgcn_s_setprio(1); _Pragma("unroll") for (int m = 0; m < 4; ++m) _Pragma("unroll") for (int n = 0; n < 2; ++n) _Pragma("unroll") for (int k = 0; k < 2; ++k) \
        acc[ai][bj][m][n] = __builtin_amdgcn_mfma_f32_16x16x32_bf16(Bt[n][k], At[m][k], acc[ai][bj][m][n], 0, 0, 0); __builtin_amdgcn_s_setprio(0); } while (0)
#define PG8_WAIT_V(n) asm volatile("s_waitcnt vmcnt(" #n ")" ::: "memory")
#define PG8_WAIT_L(n) asm volatile("s_waitcnt lgkmcnt(" #n ")" ::: "memory")
#define PG8_BAR __builtin_amdgcn_s_barrier()
#define PG8_SCHED __builtin_amdgcn_sched_barrier(0)
    Unit cur, nxt; int ui = 0;
    if (!S.next(0, cur)) return;
    f32x4 acc[2][2][4][2];
#pragma unroll
    for (int a = 0; a < 2; ++a)
#pragma unroll
        for (int b = 0; b < 2; ++b)
#pragma unroll
            for (int m = 0; m < 4; ++m)
#pragma unroll
                for (int n = 0; n < 2; ++n) acc[a][b][m][n] = (f32x4){0.f, 0.f, 0.f, 0.f};
    bf16x8 At[4][2], B0[2][2], B1[2][2];
    const char* cA = (const char*)g.A + (size_t)cur.pm * tstep; const char* cB = (const char*)g.Bt + (size_t)cur.pn * tstep;
    S.a_ready(cur);
    if constexpr (SP2) {
        PG8_STAGE(PG8_SB(0, 0), cB, voffB); PG8_STAGE(PG8_SB(0, 1), cB + hstep, voffB); PG8_STAGE(PG8_SA(0, 0), cA, voffA); PG8_STAGE(PG8_SA(0, 1), cA + hstep, voffA);
        if (wr == 1) PG8_BAR;
        PG8_WAIT_V(2); PG8_BAR;
        PG8_STAGE(PG8_SB(1, 0), cB + kstep, voffB); PG8_STAGE(PG8_SA(1, 0), cA + kstep, voffA); PG8_STAGE(PG8_SB(1, 1), cB + hstep + kstep, voffB);
        PG8_WAIT_V(6); PG8_BAR;
    } else {
        PG8_STAGE(PG8_SB(0, 0), cB, voffB); PG8_STAGE(PG8_SA(0, 0), cA, voffA); PG8_STAGE(PG8_SB(0, 1), cB + hstep, voffB); PG8_STAGE(PG8_SA(0, 1), cA + hstep, voffA);
        if (wr == 1) PG8_BAR;
        PG8_WAIT_V(4); PG8_BAR;
        PG8_STAGE(PG8_SB(1, 0), cB + kstep, voffB); PG8_STAGE(PG8_SA(1, 0), cA + kstep, voffA); PG8_STAGE(PG8_SB(1, 1), cB + hstep + kstep, voffB);
        PG8_WAIT_V(6); PG8_BAR;
    }
    for (;;) {
        const bool has_next = S.next(ui + 1, nxt);
        const char* nA = has_next ? (const char*)g.A + (size_t)nxt.pm * tstep : cA; const char* nB = has_next ? (const char*)g.Bt + (size_t)nxt.pn * tstep : cB;
        for (int t = 0; t < nt; t += 2) {
            const bool last = (t == nt - 2);
            const char* a1 = cA + (size_t)(t + 1) * kstep;
            const char* a2 = last ? nA : cA + (size_t)(t + 2) * kstep; const char* b2 = last ? nB : cB + (size_t)(t + 2) * kstep;
            const char* a3 = a2 + kstep; const char* b3 = b2 + kstep;
            if (last && has_next) S.a_ready(nxt);
            if constexpr (SP2) {
            PG8_LDB(B0, 0, 0); PG8_LDB(B1, 0, 1); PG8_SCHED; PG8_LDA(At, 0, 0); PG8_STAGE(PG8_SA(1, 1), a1 + hstep, voffA);
            PG8_WAIT_V(8); PG8_WAIT_L(0); PG8_BAR; PG8_MMA(0, 0, At, B0); PG8_MMA(0, 1, At, B1); PG8_BAR; PG8_SCHED;
            PG8_LDA(At, 0, 1); PG8_STAGE(PG8_SB(0, 0), b2, voffB); PG8_STAGE(PG8_SB(0, 1), b2 + hstep, voffB); PG8_STAGE(PG8_SA(0, 0), a2, voffA);
            PG8_WAIT_V(8); PG8_WAIT_L(0); PG8_BAR; PG8_MMA(1, 0, At, B0); PG8_MMA(1, 1, At, B1); PG8_BAR; PG8_SCHED;
            PG8_LDB(B0, 1, 0); PG8_LDB(B1, 1, 1); PG8_SCHED; PG8_LDA(At, 1, 0); PG8_STAGE(PG8_SA(0, 1), a2 + hstep, voffA);
            PG8_WAIT_V(8); PG8_WAIT_L(0); PG8_BAR; PG8_MMA(0, 0, At, B0); PG8_MMA(0, 1, At, B1); PG8_BAR; PG8_SCHED;
            PG8_LDA(At, 1, 1); PG8_STAGE(PG8_SB(1, 0), b3, voffB); PG8_STAGE(PG8_SB(1, 1), b3 + hstep, voffB); PG8_STAGE(PG8_SA(1, 0), a3, voffA);
            PG8_WAIT_V(8); PG8_WAIT_L(0); PG8_BAR; PG8_MMA(1, 0, At, B0); PG8_MMA(1, 1, At, B1); PG8_BAR; PG8_SCHED;
            } else {
            PG8_LDB(B0, 0, 0); PG8_SCHED; PG8_LDA(At, 0, 0); PG8_STAGE(PG8_SA(1, 1), a1 + hstep, voffA);
            PG8_WAIT_L(8); PG8_BAR; PG8_WAIT_L(0); PG8_MMA(0, 0, At, B0); PG8_BAR; PG8_SCHED;
            PG8_LDB(B1, 0, 1); PG8_STAGE(PG8_SB(0, 0), b2, voffB);
            PG8_BAR; PG8_WAIT_L(0); PG8_MMA(0, 1, At, B1); PG8_BAR;
            PG8_LDA(At, 0, 1); PG8_STAGE(PG8_SA(0, 0), a2, voffA);
            PG8_BAR; PG8_WAIT_L(0); PG8_MMA(1, 0, At, B0); PG8_BAR; PG8_SCHED;
            PG8_STAGE(PG8_SB(0, 1), b2 + hstep, voffB);
            PG8_WAIT_V(6); PG8_BAR; PG8_MMA(1, 1, At, B1); PG8_BAR;
            PG8_LDB(B0, 1, 0); PG8_SCHED; PG8_LDA(At, 1, 0); PG8_STAGE(PG8_SA(0, 1), a2 + hstep, voffA);
            PG8_WAIT_L(8); PG8_BAR; PG8_WAIT_L(0); PG8_MMA(0, 0, At, B0); PG8_BAR; PG8_SCHED;
            PG8_LDB(B1, 1, 1); PG8_STAGE(PG8_SB(1, 0), b3, voffB);
            PG8_BAR; PG8_WAIT_L(0); PG8_MMA(0, 1, At, B1); PG8_BAR;
            PG8_LDA(At, 1, 1); PG8_STAGE(PG8_SA(1, 0), a3, voffA);
            PG8_BAR; PG8_WAIT_L(0); PG8_MMA(1, 0, At, B0); PG8_BAR; PG8_SCHED;
            PG8_STAGE(PG8_SB(1, 1), b3 + hstep, voffB);
            PG8_WAIT_V(6); PG8_BAR; PG8_MMA(1, 1, At, B1); PG8_BAR;
            }
        }
        if constexpr (ALIGN_EPI) { if (wr == 0) PG8_BAR; }
        if constexpr (!Epi::AFTER_DRAIN) { E(acc, cur, wr, wc, fr, fq); S.done(cur); }
        if (!has_next) break;
#pragma unroll
        for (int a = 0; a < 2; ++a)
#pragma unroll
            for (int b = 0; b < 2; ++b)
#pragma unroll
                for (int m = 0; m < 4; ++m)
#pragma unroll
                    for (int n = 0; n < 2; ++n) acc[a][b][m][n] = (f32x4){0.f, 0.f, 0.f, 0.f};
        cur = nxt; cA = nA; cB = nB; ++ui;
        if constexpr (ALIGN_EPI) { if (wr == 1) PG8_BAR; }
    }
    PG8_WAIT_V(0);
    if constexpr (!ALIGN_EPI) { if (wr == 0) PG8_BAR; }
    PG8_BAR;
    if constexpr (Epi::AFTER_DRAIN) { E.fused(acc, cur, wr, wc, fr, fq, lds, wid, lane); S.done(cur); }
#undef PG8_SA
#undef PG8_SB
#undef PG8_STAGE
#undef PG8_LDA
#undef PG8_LDB
#undef PG8_MMA
#undef PG8_WAIT_V
#undef PG8_WAIT_L
#undef PG8_BAR
#undef PG8_SCHED
}
}

#define DI __device__ __forceinline__
#define GAS __attribute__((address_space(1)))
#define LAS __attribute__((address_space(3)))
typedef unsigned short bf16;
typedef float f32x4 __attribute__((ext_vector_type(4)));
typedef float f32x16 __attribute__((ext_vector_type(16)));
typedef short bf16x8 __attribute__((ext_vector_type(8)));
typedef short s16x4 __attribute__((ext_vector_type(4)));
typedef unsigned u32x4 __attribute__((ext_vector_type(4)));
typedef unsigned u32x2 __attribute__((ext_vector_type(2)));
typedef GAS unsigned gu32;
#define RLX_AGENT __ATOMIC_RELAXED, __HIP_MEMORY_SCOPE_AGENT
#define LDS_WAIT() asm volatile("s_waitcnt lgkmcnt(0)" ::: "memory")
#define VM_WAIT() asm volatile("s_waitcnt vmcnt(0)" ::: "memory")

constexpr int DM = 2048, SEQ = 8192, NSMP = 256, MR = SEQ + NSMP, DFF = 5632, NUP = 2 * DFF, NINP = 6400, DIN = 6160, NMOD = 6 * DM, PW = 6144;
constexpr int NCH = 128, LCH = 64, NHM = 8, NUNIT = NCH * NHM;
constexpr float ALPHA_RES = 1.4142135623730951f;
constexpr float QSCALE = 0.12751743082459868f;
constexpr float LOG2E = 1.4426950408889634f;
constexpr int NWAVES = 8, NTHR = 512;

constexpr size_t O_XP = 0, O_XS = 16777216, O_KP = 17301504, O_VP = 21495808, O_CP = 25690112, O_NP = 25821184, O_MP = 25822208, O_BP = 25822224,
                 O_KS = 25844752, O_VS = 26369040, O_CS = 26893328, O_NS = 31087632, O_MS = 31120400, O_BS = 31120912, O_END = 31841808;

constexpr size_t al256(size_t x) { return (x + 255) & ~(size_t)255; }
constexpr size_t WS_CTL = 0, CTL_ZERO_BYTES = 1u << 20;
constexpr size_t WS_MOD  = CTL_ZERO_BYTES;
constexpr size_t WS_ROPE = WS_MOD  + al256((size_t)2 * 33 * NMOD * 4);
constexpr size_t WS_WIN  = WS_ROPE + al256((size_t)2 * 8200 * 64 * 4);
constexpr size_t WS_WOUT = WS_WIN  + (size_t)2 * NINP * DM * 2;
constexpr size_t WS_WUP  = WS_WOUT + (size_t)2 * DM * DM * 2;
constexpr size_t WS_WDN  = WS_WUP  + (size_t)2 * NUP * DM * 2;
constexpr size_t WS_U    = WS_WDN  + (size_t)2 * DM * DFF * 2;
constexpr size_t WS_P    = WS_U    + (size_t)MR * DM * 2;
constexpr size_t WS_IG   = WS_P    + (size_t)MR * PW * 2;
constexpr size_t WS_LF   = WS_IG   + al256((size_t)MR * 8 * 4);
constexpr size_t WS_SCAL = WS_LF   + al256((size_t)MR * 8 * 4);
constexpr size_t WS_DCT  = WS_SCAL + (size_t)NUNIT * 192 * 4;
constexpr size_t WS_CST  = WS_DCT  + al256((size_t)NUNIT * 129 * 64 * 4);
constexpr size_t WS_MST  = WS_CST  + (size_t)NUNIT * 160 * 64 * 2;
constexpr size_t WS_OPART= WS_MST  + al256((size_t)NUNIT * 4);
constexpr size_t WS_ML   = WS_OPART+ (size_t)3 * SEQ * 1024 * 2;
constexpr size_t WS_CAT  = WS_ML   + (size_t)3 * SEQ * 8 * 2 * 4;
constexpr size_t WS_Y    = WS_CAT  + (size_t)MR * DM * 2;
constexpr size_t WS_XA   = WS_Y    + (size_t)MR * DM * 4;
constexpr size_t WS_XR   = WS_XA   + (size_t)MR * DM * 4;
constexpr size_t WS_GV   = WS_XR   + (size_t)MR * DM * 4;
constexpr size_t WS_ACT  = WS_GV   + (size_t)MR * NUP * 2;
constexpr size_t WS_END  = WS_ACT  + (size_t)MR * DFF * 2;
constexpr int CW_BAR = 4096;

constexpr int RING_BYTES = 131072, LDSCTL_OFF = RING_BYTES, MISC_OFF = LDSCTL_OFF + 320, LDS_BYTES = 147456;

DI unsigned f2bf(float f) { unsigned u = __builtin_bit_cast(unsigned, f); return (u + 0x7fffu + ((u >> 16) & 1u)) >> 16; }
DI unsigned pk2(float lo, float hi) { return f2bf(lo) | (f2bf(hi) << 16); }
DI float bf2f(unsigned b) { return __builtin_bit_cast(float, b << 16); }
DI float bflo(unsigned w) { return __builtin_bit_cast(float, w << 16); }
DI float bfhi(unsigned w) { return __builtin_bit_cast(float, w & 0xffff0000u); }
DI f32x4 ld4(const float* p) { return *(const GAS f32x4*)p; }
DI void st4(float* p, f32x4 v) { *(GAS f32x4*)p = v; }
DI u32x4 ld16(const void* p) { return *(const GAS u32x4*)p; }
DI void st16(void* p, u32x4 v) { *(GAS u32x4*)p = v; }
DI u32x2 ld8(const void* p) { return *(const GAS u32x2*)p; }
DI void st8(void* p, u32x2 v) { *(GAS u32x2*)p = v; }
DI float ldf(const float* p) { return *(const GAS float*)p; }
DI void stf(float* p, float v) { *(GAS float*)p = v; }
DI bf16x8 ldfrag(const bf16* p) { return __builtin_bit_cast(bf16x8, *(const GAS u32x4*)p); }
DI float fexp2(float x) { return __builtin_amdgcn_exp2f(x); }
DI float fexp(float x) { return __builtin_amdgcn_exp2f(x * LOG2E); }
DI float frcp(float x) { return __builtin_amdgcn_rcpf(x); }
DI float sigmoidf_(float x) { return frcp(1.f + fexp(-x)); }
DI float siluf_(float x) { return x * sigmoidf_(x); }
DI int crow(int reg, int h) { return (reg & 3) + 8 * (reg >> 2) + 4 * h; }
DI f32x16 zero16() { f32x16 z; for (int i = 0; i < 16; ++i) z[i] = 0.f; return z; }
#define MFMA32(a, b, c) __builtin_amdgcn_mfma_f32_32x32x16_bf16((a), (b), (c), 0, 0, 0)
DI float wave_sum(float v) {
#pragma unroll
    for (int o = 1; o < 64; o <<= 1) v += __shfl_xor(v, o);
    return v;
}
DI float wave_max(float v) {
#pragma unroll
    for (int o = 1; o < 64; o <<= 1) v = fmaxf(v, __shfl_xor(v, o));
    return v;
}
DI bf16x8 pack_step(const f32x16& x, int s) {
    u32x4 p; p[0] = pk2(x[8 * s], x[8 * s + 1]); p[1] = pk2(x[8 * s + 2], x[8 * s + 3]); p[2] = pk2(x[8 * s + 4], x[8 * s + 5]); p[3] = pk2(x[8 * s + 6], x[8 * s + 7]);
    return __builtin_bit_cast(bf16x8, p);
}
DI bf16x8 tr_pair(unsigned tile, int pitch, int s0, int s1, int cbase, int lane) {
    const int i = lane & 15, q = i >> 2, p = i & 3, cb = (lane >> 4) & 1;
    const unsigned a0 = tile + (unsigned)((s0 + q) * pitch + (cbase + 16 * cb + 4 * p) * 2);
    const unsigned a1 = tile + (unsigned)((s1 + q) * pitch + (cbase + 16 * cb + 4 * p) * 2);
    s16x4 lo, hi;
    asm volatile("ds_read_b64_tr_b16 %0, %2\n\tds_read_b64_tr_b16 %1, %3\n\ts_waitcnt lgkmcnt(0)" : "=&v"(lo), "=&v"(hi) : "v"(a0), "v"(a1) : "memory");
    return __builtin_shufflevector(lo, hi, 0, 1, 2, 3, 4, 5, 6, 7);
}

DI int mod_row(int row) { return row < SEQ ? 0 : 1 + ((row - SEQ) >> 3); }

DI int win_src_col(int nb) {
    const int n0 = nb * 32;
    if (n0 < 3072) return n0;
    if (n0 < 5120) {
        const int which = (n0 - 3072) / 1024, rel = (n0 - 3072) % 1024, tile = rel / 256, j0 = rel % 256;
        const int bj = j0 / 128, h2 = (j0 % 128) / 64, ib = (j0 % 64) / 32;
        return 3088 + which * 1024 + (2 * tile + h2) * 128 + bj * 64 + 32 * ib;
    }
    if (n0 < 6144) return 5136 + (n0 - 5120);
    if (n0 == 6144) return 3072;
    return 0;
}
DI void transpose_item(const float* W, int N, int K, bf16* WT, int drow0, int scol0, int k0, LAS float* scr, int lane) {
#pragma unroll 8
    for (int i = 0; i < 32; ++i) { const int kk = 2 * i + (lane >> 5); scr[kk * 33 + (lane & 31)] = ldf(W + (size_t)(k0 + kk) * N + scol0 + (lane & 31)); }
    LDS_WAIT();
    const int c = lane & 7;
#pragma unroll
    for (int j = 0; j < 4; ++j) { const int n = (lane >> 3) + 8 * j; const LAS float* s = scr + (8 * c) * 33 + n;
        u32x4 o; o.x = pk2(s[0 * 33], s[1 * 33]); o.y = pk2(s[2 * 33], s[3 * 33]); o.z = pk2(s[4 * 33], s[5 * 33]); o.w = pk2(s[6 * 33], s[7 * 33]);
        st16(WT + (size_t)(drow0 + n) * K + k0 + 8 * c, o); }
    LDS_WAIT();
}
constexpr int IT_IN = 32 * 200, IT_OUT = 32 * 64, IT_UP = 32 * 352, IT_DN = 88 * 64, IT_LAYER = IT_IN + IT_OUT + IT_UP + IT_DN;

DI void p0_weights(const float* w_in, const float* w_out, const float* w_up, const float* w_down, unsigned char* ws, LAS unsigned char* lds, int gw, int ngw, int wave, int lane) {
    LAS float* scr = (LAS float*)(lds + wave * 16384);
    for (int it = gw; it < 2 * IT_LAYER; it += ngw) {
        const int l = it / IT_LAYER; int r = it % IT_LAYER;
        if (r < IT_IN) { const int kb = r / 200, nb = r % 200;
            transpose_item(w_in + (size_t)l * DM * DIN, DIN, DM, (bf16*)(ws + WS_WIN) + (size_t)l * NINP * DM, nb * 32, win_src_col(nb), kb * 64, scr, lane); continue; }
        r -= IT_IN;
        if (r < IT_OUT) { const int kb = r / 64, nb = r % 64;
            transpose_item(w_out + (size_t)l * DM * DM, DM, DM, (bf16*)(ws + WS_WOUT) + (size_t)l * DM * DM, nb * 32, nb * 32, kb * 64, scr, lane); continue; }
        r -= IT_OUT;
        if (r < IT_UP) { const int kb = r / 352, nb = r % 352;
            transpose_item(w_up + (size_t)l * DM * NUP, NUP, DM, (bf16*)(ws + WS_WUP) + (size_t)l * NUP * DM, nb * 32, nb * 32, kb * 64, scr, lane); continue; }
        r -= IT_UP;
        { const int kb = r / 64, nb = r % 64;
            transpose_item(w_down + (size_t)l * DFF * DM, DM, DFF, (bf16*)(ws + WS_WDN) + (size_t)l * DM * DFF, nb * 32, nb * 32, kb * 64, scr, lane); }
    }
}
DI void p0_rope(float* cosT, float* sinT, int gt, int ngt) {
    for (int e = gt; e < 8200 * 64; e += ngt) {
        const int pos = e >> 6, i = e & 63;
        double inv = 1.0;
        if (i & 1) inv *= 0.8659643233600653;
        if (i & 2) inv *= 0.7498942093324559;
        if (i & 4) inv *= 0.5623413251903491;
        if (i & 8) inv *= 0.31622776601683794;
        if (i & 16) inv *= 0.1;
        if (i & 32) inv *= 0.01;
        double rev = (double)pos * inv * 0.15915494309189535;
        rev = rev - __builtin_rint(rev);
        const float fr = (float)rev;
        stf(cosT + e, __builtin_amdgcn_cosf(fr)); stf(sinT + e, __builtin_amdgcn_sinf(fr));
    }
}
DI void p0_mod(const float* c_prompt, const float* c_sample, const float* w_ada, const float* b_ada, float* MOD, LAS unsigned char* lds, int bid, int G, int tid, int wave, int lane) {
    LAS float* cpl = (LAS float*)(lds + 65536);
    LAS float* red = (LAS float*)(lds + 65536 + 8192);
    const int h = lane >> 5, r31 = lane & 31, kbase = 256 * wave;
    for (int i = tid; i < DM; i += NTHR) cpl[i] = siluf_(ldf(c_prompt + i));
    __syncthreads();
    for (int item = bid; item < 768; item += G) {
        const int l = item / 384, n0 = (item % 384) * 32;
        const float* W = w_ada + (size_t)l * DM * NMOD + n0 + r31;
        f32x16 acc = zero16(); float pacc = 0.f;
#pragma unroll 4
        for (int ks = 0; ks < 16; ++ks) { const int k0 = kbase + 16 * ks + 8 * h; float w[8];
#pragma unroll
            for (int j = 0; j < 8; ++j) w[j] = ldf(W + (size_t)(k0 + j) * NMOD);
            const float* cp = c_sample + (size_t)r31 * DM + k0; const f32x4 ca = ld4(cp), cb = ld4(cp + 4);
            u32x4 pa; pa.x = pk2(siluf_(ca.x), siluf_(ca.y)); pa.y = pk2(siluf_(ca.z), siluf_(ca.w)); pa.z = pk2(siluf_(cb.x), siluf_(cb.y)); pa.w = pk2(siluf_(cb.z), siluf_(cb.w));
            u32x4 p; p.x = pk2(w[0], w[1]); p.y = pk2(w[2], w[3]); p.z = pk2(w[4], w[5]); p.w = pk2(w[6], w[7]);
            acc = MFMA32(__builtin_bit_cast(bf16x8, pa), __builtin_bit_cast(bf16x8, p), acc);
            const LAS f32x4* cq = (const LAS f32x4*)(cpl + k0); const f32x4 c0 = cq[0], c1 = cq[1];
            pacc += c0.x * w[0] + c0.y * w[1] + c0.z * w[2] + c0.w * w[3] + c1.x * w[4] + c1.y * w[5] + c1.z * w[6] + c1.w * w[7]; }
        pacc += __shfl_xor(pacc, 32);
#pragma unroll
        for (int reg = 0; reg < 16; ++reg) red[(wave * 33 + 1 + crow(reg, h)) * 32 + r31] = acc[reg];
        if (h == 0) red[(wave * 33) * 32 + r31] = pacc;
        __syncthreads();
        for (int i = tid; i < 33 * 32; i += NTHR) { const int r = i >> 5, c = i & 31; float s = 0.f;
#pragma unroll
            for (int w = 0; w < 8; ++w) s += red[(w * 33 + r) * 32 + c];
            stf(MOD + ((size_t)l * 33 + r) * NMOD + n0 + c, s + ldf(b_ada + (size_t)l * NMOD + n0 + c)); }
        __syncthreads();
    }
}
DI void modulate_row(const float* xrow, const float* sh, const float* sc, bf16* urow, int lane) {
#pragma unroll
    for (int j = 0; j < 8; ++j) { const int col = 4 * lane + 256 * j; const f32x4 v = ld4(xrow + col), a = ld4(sc + col), b = ld4(sh + col);
        u32x2 o; o.x = pk2(v.x * (1.f + a.x) + b.x, v.y * (1.f + a.y) + b.y); o.y = pk2(v.z * (1.f + a.z) + b.z, v.w * (1.f + a.w) + b.w); st8(urow + col, o); }
}
DI void ln_row(const float* yrow, const float* g, const float* b, float* xo, const float* sh, const float* sc, bf16* urow, int lane) {
    f32x4 v[8]; float s = 0.f;
#pragma unroll
    for (int j = 0; j < 8; ++j) { v[j] = ld4(yrow + 4 * lane + 256 * j); s += (v[j].x + v[j].y) + (v[j].z + v[j].w); }
    const float mean = wave_sum(s) * (1.f / DM); float s2 = 0.f;
#pragma unroll
    for (int j = 0; j < 8; ++j) { v[j] = v[j] - mean; s2 += (v[j].x * v[j].x + v[j].y * v[j].y) + (v[j].z * v[j].z + v[j].w * v[j].w); }
    const float rstd = 1.f / sqrtf(wave_sum(s2) * (1.f / DM) + 1e-5f);
#pragma unroll
    for (int j = 0; j < 8; ++j) { const int col = 4 * lane + 256 * j; const f32x4 gg = ld4(g + col), bb = ld4(b + col); const f32x4 o = v[j] * rstd * gg + bb; st4(xo + col, o);
        if (urow) { const f32x4 a = ld4(sc + col), c = ld4(sh + col); u32x2 w; w.x = pk2(o.x * (1.f + a.x) + c.x, o.y * (1.f + a.y) + c.y); w.y = pk2(o.z * (1.f + a.z) + c.z, o.w * (1.f + a.w) + c.w); st8(urow + col, w); } }
}
#define XB_TMO      128
#define XB_XCNT(j)  (256  + 64 * (j))
#define XB_XSUB(j)  (1280 + 64 * (j))
#define XB_XGEN(j)  (2304 + 64 * (j))
#define XB_TOP      3328
#define XB_TOPGEN   3392
#define XCD_BAR_WORDS 3456
#define XB_SPIN_CAP (1u << 18)

__device__ __forceinline__ unsigned xb_ld(unsigned* p)              { return __hip_atomic_load(p, __ATOMIC_RELAXED, __HIP_MEMORY_SCOPE_AGENT); }
__device__ __forceinline__ unsigned xb_add(unsigned* p, unsigned v) { return __hip_atomic_fetch_add(p, v, __ATOMIC_RELAXED, __HIP_MEMORY_SCOPE_AGENT); }
__device__ __forceinline__ unsigned xb_xcc_id() { return (unsigned)__builtin_amdgcn_s_getreg((3 << 11) | 20) & 0xFu; }
#define XB_SPIN(cond, bar) do { unsigned _sp = 0; while (cond) { __builtin_amdgcn_s_sleep(1); \
    if ((++_sp & 255u) == 0u) { if (xb_ld(&(bar)[XB_TMO])) break; if (_sp > XB_SPIN_CAP) { atomicAdd(&(bar)[XB_TMO], 1u); break; } } } } while (0)

struct XcdBarrier {
    unsigned* bar; unsigned x;
    volatile LAS unsigned* st;
};

__device__ __forceinline__ XcdBarrier xcd_barrier_post(unsigned* bar, volatile LAS unsigned* st) {
    XcdBarrier b; b.bar = bar; b.x = xb_xcc_id(); b.st = st;
    if (threadIdx.x == 0) (void)xb_add(&bar[XB_XCNT(b.x)], 1u);
    return b;
}
__device__ __forceinline__ void xcd_barrier_complete(unsigned* bar, unsigned x, unsigned& nloc, unsigned& nx) {
    const unsigned G = gridDim.x * gridDim.y * gridDim.z;
    unsigned sum, cnt, mine, sp = 0u;
    for (;;) {
        sum = 0u; cnt = 0u; mine = 0u;
#pragma unroll
        for (unsigned j = 0; j < 16; ++j) { const unsigned c = xb_ld(&bar[XB_XCNT(j)]); sum += c; cnt += (c > 0u) ? 1u : 0u; mine = (j == x) ? c : mine; }
        if (sum == G) break;
        __builtin_amdgcn_s_sleep(1);
        if ((++sp & 255u) == 0u) { if (xb_ld(&bar[XB_TMO])) break; if (sp > XB_SPIN_CAP) { atomicAdd(&bar[XB_TMO], 1u); break; } }
    }
    nloc = mine > 0u ? mine : 1u; nx = cnt > 0u ? cnt : 1u;
}

__device__ __forceinline__ void xcd_barrier(const XcdBarrier& b) {
    asm volatile("s_waitcnt vmcnt(0)" ::: "memory");
    __syncthreads();
    if (threadIdx.x == 0) {
        unsigned* bar = b.bar;
        __builtin_amdgcn_s_waitcnt(0);
        unsigned nloc = b.st[0], nx = b.st[1];
        if (nloc == 0u) { xcd_barrier_complete(bar, b.x, nloc, nx); b.st[0] = nloc; b.st[1] = nx; }
        const unsigned old = xb_add(&bar[XB_XSUB(b.x)], 1u);
        const unsigned gen = old / nloc;
        if (old + 1u == (gen + 1u) * nloc) {
            __builtin_amdgcn_fence(__ATOMIC_RELEASE, "agent");
            asm volatile("s_waitcnt vmcnt(0)" ::: "memory");
            const unsigned og = xb_add(&bar[XB_TOP], 1u);
            const unsigned tg = og / nx;
            if (og + 1u == (tg + 1u) * nx) xb_add(&bar[XB_TOPGEN], 1u);
            else XB_SPIN(xb_ld(&bar[XB_TOPGEN]) == tg, bar);
            __builtin_amdgcn_fence(__ATOMIC_ACQUIRE, "agent");
            xb_add(&bar[XB_XGEN(b.x)], 1u);
            asm volatile("s_waitcnt vmcnt(0)" ::: "memory");
        } else {
            XB_SPIN(xb_ld(&bar[XB_XGEN(b.x)]) == gen, bar);
            __builtin_amdgcn_fence(__ATOMIC_ACQUIRE, "agent");
            asm volatile("s_waitcnt vmcnt(0)" ::: "memory");
        }
    }
    __syncthreads();
}

DI u32x4 pack8(f32x4 a, f32x4 b) { u32x4 w; w.x = pg8::cvt_pk_bf16(a[0], a[1]); w.y = pg8::cvt_pk_bf16(a[2], a[3]); w.z = pg8::cvt_pk_bf16(b[0], b[1]); w.w = pg8::cvt_pk_bf16(b[2], b[3]); return w; }
DI float logsigmoidf_(float v) { const float e = fexp(-fabsf(v)); return fminf(v, 0.f) - __logf(1.f + e); }

struct EpiIn {
    static constexpr bool PERM = true, AFTER_DRAIN = false;
    unsigned char* wsb; float* outb; const float* bgate; int l;
    DI void operator()(const f32x4 (&acc)[2][2][4][2], const pg8::Unit& u, int wr, int wc, int fr, int fq) const {
        bf16* P = (bf16*)(wsb + WS_P); float* IG = (float*)(wsb + WS_IG); float* LF = (float*)(wsb + WS_LF); const float* cosT = (const float*)(wsb + WS_ROPE); const float* sinT = cosT + 8200 * 64;
        float* kp = outb + O_KP + (size_t)l * 2048 * 1024; float* vp = outb + O_VP + (size_t)l * 2048 * 1024; float* ks = outb + O_KS + (size_t)l * NSMP * 1024; float* vs = outb + O_VS + (size_t)l * NSMP * 1024;
        const int pn = u.pn, rowb = u.pm * 256 + wr * 64 + fr;
        if (pn < 12 || (pn >= 20 && pn < 24)) {
            const float sc = (pn == 2 || pn == 3) ? 0.125f : 1.f;
            const int colP = (pn < 12 ? pn * 256 : 5120 + (pn - 20) * 256) + wc * 32 + 8 * fq;
#pragma unroll
            for (int ai = 0; ai < 2; ++ai)
#pragma unroll
                for (int m = 0; m < 4; ++m) { const int row = rowb + ai * 128 + m * 16; bf16* rp = P + (size_t)row * PW + colP;
                    float* o = nullptr;
                    if (pn >= 20) { if (row >= SEQ) o = vs + (size_t)(row - SEQ) * 1024; else if (row >= SEQ - 2048) o = vp + (size_t)(row - (SEQ - 2048)) * 1024; }
#pragma unroll
                    for (int bj = 0; bj < 2; ++bj) { st16(rp + bj * 128, pack8(acc[ai][bj][m][0] * sc, acc[ai][bj][m][1] * sc));
                        if (o) { float* oc = o + (pn - 20) * 256 + bj * 128 + wc * 32 + 8 * fq; st4(oc, acc[ai][bj][m][0]); st4(oc + 4, acc[ai][bj][m][1]); } } }
        } else if (pn < 20) {
            const bool isq = pn < 16; const int tile = (pn - 12) & 3, head = 2 * tile + (wc >> 1), i0 = 32 * (wc & 1) + 8 * fq;
            const float qs = isq ? QSCALE : 1.f;
            const int colP = (isq ? 3072 : 4096) + head * 128 + i0;
#pragma unroll
            for (int ai = 0; ai < 2; ++ai)
#pragma unroll
                for (int m = 0; m < 4; ++m) { const int row = rowb + ai * 128 + m * 16; const int pos = row < SEQ ? row : SEQ + ((row - SEQ) & 7);
                    const f32x4 c0 = ld4(cosT + pos * 64 + i0), c1 = ld4(cosT + pos * 64 + i0 + 4), s0 = ld4(sinT + pos * 64 + i0), s1 = ld4(sinT + pos * 64 + i0 + 4);
                    const f32x4 x1a = acc[ai][0][m][0], x1b = acc[ai][0][m][1], x2a = acc[ai][1][m][0], x2b = acc[ai][1][m][1];
                    const f32x4 o1a = (x1a * c0 - x2a * s0) * qs, o1b = (x1b * c1 - x2b * s1) * qs, o2a = (x2a * c0 + x1a * s0) * qs, o2b = (x2b * c1 + x1b * s1) * qs;
                    bf16* rp = P + (size_t)row * PW + colP; st16(rp, pack8(o1a, o1b)); st16(rp + 64, pack8(o2a, o2b));
                    if (!isq) { float* o = nullptr; if (row >= SEQ) o = ks + (size_t)(row - SEQ) * 1024; else if (row >= SEQ - 2048) o = kp + (size_t)(row - (SEQ - 2048)) * 1024;
                        if (o) { o += head * 128 + i0; st4(o, o1a); st4(o + 4, o1b); st4(o + 64, o2a); st4(o + 68, o2b); } }
                    asm volatile("" ::: "memory"); }
        } else {
            if (wc == 0 && fq < 2) {
#pragma unroll
                for (int ai = 0; ai < 2; ++ai)
#pragma unroll
                    for (int m = 0; m < 4; ++m) { const int row = rowb + ai * 128 + m * 16;
#pragma unroll
                        for (int n = 0; n < 2; ++n)
#pragma unroll
                            for (int e = 0; e < 4; ++e) { const int hd = 4 * n + e; const float v = acc[ai][0][m][n][e] + ldf(bgate + fq * 8 + hd);
                                if (fq == 0) stf(IG + (size_t)row * 8 + hd, v); else stf(LF + (size_t)row * 8 + hd, logsigmoidf_(v)); } }
            }
        }
    }
};
struct EpiRes {
    static constexpr bool PERM = false, AFTER_DRAIN = false;
    float* Y; const float* resP; const float* resS; const float* gate;
    DI void operator()(const f32x4 (&acc)[2][2][4][2], const pg8::Unit& u, int wr, int wc, int fr, int fq) const {
        const int rowb = u.pm * 256 + wr * 64 + fr, col0 = u.pn * 256 + wc * 32 + 4 * fq;
#pragma unroll
        for (int ai = 0; ai < 2; ++ai)
#pragma unroll
            for (int m = 0; m < 4; ++m) { const int row = rowb + ai * 128 + m * 16;
                const float* res = row < SEQ ? resP + (size_t)row * DM : resS + (size_t)(row - SEQ) * DM; const float* gp = gate + (size_t)mod_row(row) * NMOD; float* yp = Y + (size_t)row * DM;
#pragma unroll
                for (int bj = 0; bj < 2; ++bj)
#pragma unroll
                    for (int n = 0; n < 2; ++n) { const int col = col0 + bj * 128 + n * 16; const f32x4 r = ld4(res + col), g = ld4(gp + col);
                        st4(yp + col, r * ALPHA_RES + (g + 1.f) * acc[ai][bj][m][n]); }
                asm volatile("" ::: "memory"); }
    }
};
struct EpiUp {
    static constexpr bool PERM = true, AFTER_DRAIN = false;
    bf16* GV; float* bp; float* bs;
    DI void operator()(const f32x4 (&acc)[2][2][4][2], const pg8::Unit& u, int wr, int wc, int fr, int fq) const {
        const int rowb = u.pm * 256 + wr * 64 + fr, colb = u.pn * 256 + wc * 32 + 8 * fq;
#pragma unroll
        for (int ai = 0; ai < 2; ++ai)
#pragma unroll
            for (int m = 0; m < 4; ++m) { const int row = rowb + ai * 128 + m * 16; bf16* rp = GV + (size_t)row * NUP + colb;
                float* o = nullptr;
                if (u.pn < 22) { if (row < SEQ) { if (row >= SEQ - 2) o = bp + (size_t)(row - (SEQ - 2)) * DFF; } else { const int t = (row - SEQ) & 7; if (t >= 6) o = bs + ((size_t)((row - SEQ) >> 3) * 2 + (t - 6)) * DFF; } }
#pragma unroll
                for (int bj = 0; bj < 2; ++bj) { st16(rp + bj * 128, pack8(acc[ai][bj][m][0], acc[ai][bj][m][1]));
                    if (o) { st4(o + colb + bj * 128, acc[ai][bj][m][0]); st4(o + colb + bj * 128 + 4, acc[ai][bj][m][1]); } } }
    }
};

constexpr int VPITCH = 272, KPITCH = 144;

DI void attn_prompt_unit(const bf16* P, bf16* OP, float* ML, int u, LAS unsigned char* lds, unsigned ldsbase, int wave, int lane) {
    const int br = u >> 8, rem = u & 255, head = rem >> 5, blk = rem & 31;
    const int ld = 2 * br;
    const int sb = blk * 8 + wave, nbl = 8 - ld;
    const int r = sb >> nbl, u0 = (sb & ((1 << nbl) - 1)) << 5;
    const int r31 = lane & 31, h = lane >> 5;
    const unsigned vt = ldsbase + (unsigned)wave * (32 * VPITCH); LAS unsigned char* vtp = lds + wave * (32 * VPITCH);
    const int tokq = ((u0 + r31) << ld) + r;
    bf16x8 Qf[8];
    { const bf16* qp = P + (size_t)tokq * PW + 3072 + head * 128 + 8 * h;
#pragma unroll
      for (int ks = 0; ks < 8; ++ks) Qf[ks] = ldfrag(qp + 16 * ks); }
    f32x16 O[4];
#pragma unroll
    for (int d = 0; d < 4; ++d) O[d] = zero16();
    float mrun = -1e30f, lrun = 0.f;
    for (int jt = 0; jt < 5; ++jt) {
        const int ub = u0 - 128 + 32 * jt;
        if (ub < 0) continue;
        const bf16* kp = P + (size_t)(((ub + r31) << ld) + r) * PW + 4096 + head * 128 + 8 * h;
        bf16x8 Kf[8];
#pragma unroll
        for (int ks = 0; ks < 8; ++ks) Kf[ks] = ldfrag(kp + 16 * ks);
        u32x4 vst[8];
#pragma unroll
        for (int i = 0; i < 8; ++i) { const int row = 4 * i + (lane >> 4), ch = lane & 15; vst[i] = ld16(P + (size_t)(((ub + row) << ld) + r) * PW + 5120 + head * 128 + ch * 8); }
        f32x16 S = zero16();
#pragma unroll
        for (int ks = 0; ks < 8; ++ks) S = MFMA32(Kf[ks], Qf[ks], S);
#pragma unroll
        for (int i = 0; i < 8; ++i) { const int row = 4 * i + (lane >> 4), ch = lane & 15; *(LAS u32x4*)(vtp + row * VPITCH + ch * 16) = vst[i]; }
        float tmax = -INFINITY;
#pragma unroll
        for (int reg = 0; reg < 16; ++reg) { const int kk = crow(reg, h); const bool ok = (jt == 0) ? (kk >= r31) : ((jt == 4) ? (kk <= r31) : true);
            S[reg] = ok ? S[reg] : -INFINITY; tmax = fmaxf(tmax, S[reg]); }
        tmax = fmaxf(tmax, __shfl_xor(tmax, 32));
        const float mnew = fmaxf(mrun, tmax), alpha = fexp2(mrun - mnew); mrun = mnew;
        float psum = 0.f;
#pragma unroll
        for (int reg = 0; reg < 16; ++reg) { S[reg] = fexp2(S[reg] - mnew); psum += S[reg]; }
        psum += __shfl_xor(psum, 32);
        lrun = lrun * alpha + psum;
#pragma unroll
        for (int d = 0; d < 4; ++d) O[d] = O[d] * alpha;
        const bf16x8 P0 = pack_step(S, 0), P1 = pack_step(S, 1);
        LDS_WAIT();
#pragma unroll
        for (int d = 0; d < 4; ++d) {
            const bf16x8 A0 = tr_pair(vt, VPITCH, 4 * h, 8 + 4 * h, 32 * d, lane);
            O[d] = MFMA32(A0, P0, O[d]);
            const bf16x8 A1 = tr_pair(vt, VPITCH, 16 + 4 * h, 24 + 4 * h, 32 * d, lane);
            O[d] = MFMA32(A1, P1, O[d]);
        }
    }
    const float inv = 1.f / lrun;
    bf16* op = OP + ((size_t)br * SEQ + tokq) * 1024 + head * 128;
#pragma unroll
    for (int d = 0; d < 4; ++d)
#pragma unroll
        for (int g = 0; g < 4; ++g) { u32x2 w; w.x = pk2(O[d][4 * g] * inv, O[d][4 * g + 1] * inv); w.y = pk2(O[d][4 * g + 2] * inv, O[d][4 * g + 3] * inv); st8(op + 32 * d + 8 * g + 4 * h, w); }
    if (h == 0) { float* mp = ML + (((size_t)br * SEQ + tokq) * 8 + head) * 2; stf(mp, mrun); stf(mp + 1, lrun); }
}

DI void mlstm_m1_item(const bf16* P, const float* IG, const float* LF, float* SCAL, float* DCT, int it, LAS unsigned char* lds, unsigned ldsbase, int wave, int lane) {
    const int half = wave >> 2, wq = wave & 3, unit = it * 2 + half, c = unit >> 3, hd = unit & 7, row0 = c * LCH;
    const int hoff = half * 32768;
    LAS unsigned char* Vt = lds + hoff; LAS unsigned char* Kt = lds + hoff + 64 * VPITCH; LAS float* sc = (LAS float*)(lds + hoff + 64 * VPITCH + 64 * KPITCH);
    const int r31 = lane & 31, h = lane >> 5, t256 = wq * 64 + lane;
    if (wq == 0) {
        const float lf = ldf(LF + (size_t)(row0 + lane) * 8 + hd), ig = ldf(IG + (size_t)(row0 + lane) * 8 + hd);
        float b = lf;
#pragma unroll
        for (int o = 1; o < 64; o <<= 1) { const float t = __shfl_up(b, o); if (lane >= o) b += t; }
        const float d = ig - b; float pm = d;
#pragma unroll
        for (int o = 1; o < 64; o <<= 1) { const float t = __shfl_up(pm, o); if (lane >= o) pm = fmaxf(pm, t); }
        const float pm63 = __shfl(pm, 63);
        sc[lane] = fexp(d - pm63);
        float* sp = SCAL + (size_t)unit * 192; stf(sp + lane, b); stf(sp + 64 + lane, d); stf(sp + 128 + lane, pm);
    }
#pragma unroll
    for (int i = 0; i < 4; ++i) { const int id = i * 256 + t256, row = id >> 4, ch = id & 15;
        *(LAS u32x4*)(Vt + row * VPITCH + ch * 16) = ld16(P + (size_t)(row0 + row) * PW + 1024 + hd * 128 + ch * 8); }
    __syncthreads();
#pragma unroll
    for (int i = 0; i < 2; ++i) { const int id = i * 256 + t256, row = id >> 3, ch = id & 7; const float w = sc[row];
        const u32x4 kv = ld16(P + (size_t)(row0 + row) * PW + 512 + hd * 64 + ch * 8); u32x4 o;
        o.x = pk2(bflo(kv.x) * w, bfhi(kv.x) * w); o.y = pk2(bflo(kv.y) * w, bfhi(kv.y) * w); o.z = pk2(bflo(kv.z) * w, bfhi(kv.z) * w); o.w = pk2(bflo(kv.w) * w, bfhi(kv.w) * w);
        *(LAS u32x4*)(Kt + row * KPITCH + ch * 16) = o; }
    __syncthreads();
    f32x16 a0 = zero16(), a1 = zero16();
    const unsigned vtb = ldsbase + hoff, ktb = ldsbase + hoff + 64 * VPITCH;
#pragma unroll
    for (int ks = 0; ks < 4; ++ks) {
        const bf16x8 A = tr_pair(vtb, VPITCH, 16 * ks + 8 * h, 16 * ks + 8 * h + 4, 32 * wq, lane);
        const bf16x8 B0 = tr_pair(ktb, KPITCH, 16 * ks + 8 * h, 16 * ks + 8 * h + 4, 0, lane);
        const bf16x8 B1 = tr_pair(ktb, KPITCH, 16 * ks + 8 * h, 16 * ks + 8 * h + 4, 32, lane);
        a0 = MFMA32(A, B0, a0); a1 = MFMA32(A, B1, a1);
    }
    float* dp = DCT + (size_t)unit * (129 * 64);
#pragma unroll
    for (int reg = 0; reg < 16; ++reg) { const int dv = 32 * wq + crow(reg, h); stf(dp + dv * 64 + r31, a0[reg]); stf(dp + dv * 64 + 32 + r31, a1[reg]); }
    if (wq == 1) { float s = 0.f;
#pragma unroll 8
        for (int r = 0; r < 64; ++r) s += bf2f(*(const LAS unsigned short*)(Kt + r * KPITCH + lane * 2));
        stf(dp + 128 * 64 + lane, s); }
    __syncthreads();
}

DI void mlstm_m2(const float* SCAL, const float* DCT, bf16* CST, float* MST, float* outC, float* outN, float* outM, int e) {
    const int hd = e / 8256, idx = e % 8256;
    float C = 0.f, m = 0.f;
#pragma unroll 4
    for (int c = 0; c < NCH; ++c) {
        const int unit = c * 8 + hd;
        const float Bc = ldf(SCAL + (size_t)unit * 192 + 63), pmc = ldf(SCAL + (size_t)unit * 192 + 191), Ac = Bc + pmc;
        const float dc = ldf(DCT + (size_t)unit * 8256 + idx);
        const float mn = fmaxf(Bc + m, Ac), f1 = fexp(Bc + m - mn), f2 = fexp(Ac - mn);
        *(GAS unsigned short*)(CST + (size_t)unit * (160 * 64) + idx) = (unsigned short)f2bf(C);
        if (idx == 0) stf(MST + unit, m);
        C = f1 * C + f2 * dc; m = mn;
    }
    const int row = idx >> 6, dk = idx & 63;
    if (row < 128) stf(outC + (size_t)hd * 8192 + dk * 128 + row, C); else stf(outN + hd * 64 + dk, C);
    if (idx == 0) stf(outM + hd, m);
}
DI void attn_combine(const bf16* OP, const float* ML, bf16* CAT, int e) {
    const int tok = e >> 7, c8 = e & 127, head = c8 >> 4;
    float m[3], l[3];
#pragma unroll
    for (int b = 0; b < 3; ++b) { const float* mp = ML + (((size_t)b * SEQ + tok) * 8 + head) * 2; m[b] = ldf(mp); l[b] = ldf(mp + 1); }
    const float M = fmaxf(m[0], fmaxf(m[1], m[2]));
    float w[3], ws = 0.f;
#pragma unroll
    for (int b = 0; b < 3; ++b) { w[b] = fexp2(m[b] - M) * l[b]; ws += w[b]; }
    const float inv = 1.f / ws; float o[8];
#pragma unroll
    for (int j = 0; j < 8; ++j) o[j] = 0.f;
#pragma unroll
    for (int b = 0; b < 3; ++b) { const u32x4 v = ld16(OP + ((size_t)b * SEQ + tok) * 1024 + c8 * 8); const float wb = w[b] * inv;
        o[0] += wb * bflo(v.x); o[1] += wb * bfhi(v.x); o[2] += wb * bflo(v.y); o[3] += wb * bfhi(v.y); o[4] += wb * bflo(v.z); o[5] += wb * bfhi(v.z); o[6] += wb * bflo(v.w); o[7] += wb * bfhi(v.w); }
    u32x4 r; r.x = pk2(o[0], o[1]); r.y = pk2(o[2], o[3]); r.z = pk2(o[4], o[5]); r.w = pk2(o[6], o[7]);
    st16(CAT + (size_t)tok * DM + 1024 + c8 * 8, r);
}

DI void mlstm_m3_item(const bf16* P, const float* SCAL, const bf16* CST, const float* MST, const float* ghead, bf16* CAT, int it, LAS unsigned char* lds, unsigned ldsbase, int wave, int lane) {
    const int slot = wave >> 1, tw = wave & 1, unit = it * 4 + slot, c = unit >> 3, hd = unit & 7, row0 = c * LCH;
    const int r31 = lane & 31, h = lane >> 5, t = 32 * tw + r31;
    LAS unsigned char* Vt = lds + slot * (64 * VPITCH); const unsigned vtb = ldsbase + slot * (64 * VPITCH);
    { const int t128 = tw * 64 + lane;
#pragma unroll
      for (int i = 0; i < 8; ++i) { const int id = i * 128 + t128, row = id >> 4, ch = id & 15;
          *(LAS u32x4*)(Vt + row * VPITCH + ch * 16) = ld16(P + (size_t)(row0 + row) * PW + 1024 + hd * 128 + ch * 8); } }
    const float* sp = SCAL + (size_t)unit * 192;
    const float mc = ldf(MST + unit), bt = ldf(sp + t), pmt = ldf(sp + 128 + t);
    const float Mt = fmaxf(mc, pmt), gt = fexp(mc - Mt);
    bf16x8 Qf[4], Qg[4];
    { const bf16* qp = P + (size_t)(row0 + t) * PW + hd * 64 + 8 * h;
#pragma unroll
      for (int ks = 0; ks < 4; ++ks) { const u32x4 q = ld16(qp + 16 * ks); Qf[ks] = __builtin_bit_cast(bf16x8, q); u32x4 g;
          g.x = pk2(bflo(q.x) * gt, bfhi(q.x) * gt); g.y = pk2(bflo(q.y) * gt, bfhi(q.y) * gt); g.z = pk2(bflo(q.z) * gt, bfhi(q.z) * gt); g.w = pk2(bflo(q.w) * gt, bfhi(q.w) * gt); Qg[ks] = __builtin_bit_cast(bf16x8, g); } }
    f32x16 acc[5];
#pragma unroll
    for (int d = 0; d < 5; ++d) acc[d] = zero16();
    { const bf16* cp = CST + (size_t)unit * (160 * 64) + (size_t)r31 * 64 + 8 * h;
#pragma unroll
      for (int d = 0; d < 5; ++d)
#pragma unroll
          for (int ks = 0; ks < 4; ++ks) acc[d] = MFMA32(ldfrag(cp + d * 32 * 64 + 16 * ks), Qg[ks], acc[d]); }
    __syncthreads();
    float rowsum = 0.f;
    for (int st = 0; st <= tw; ++st) {
        const bf16* kp = P + (size_t)(row0 + 32 * st + r31) * PW + 512 + hd * 64 + 8 * h;
        f32x16 S = zero16();
#pragma unroll
        for (int ks = 0; ks < 4; ++ks) S = MFMA32(ldfrag(kp + 16 * ks), Qf[ks], S);
#pragma unroll
        for (int g = 0; g < 4; ++g) { const f32x4 dv = ld4(sp + 64 + 32 * st + 8 * g + 4 * h);
#pragma unroll
            for (int e = 0; e < 4; ++e) { const int kk = 8 * g + 4 * h + e; const bool ok = (st < tw) || (kk <= r31);
                const float p = ok ? S[4 * g + e] * fexp(dv[e] - Mt) : 0.f; S[4 * g + e] = p; rowsum += p; } }
        const bf16x8 P0 = pack_step(S, 0), P1 = pack_step(S, 1);
#pragma unroll
        for (int d = 0; d < 4; ++d) {
            const bf16x8 A0 = tr_pair(vtb, VPITCH, 32 * st + 4 * h, 32 * st + 8 + 4 * h, 32 * d, lane);
            acc[d] = MFMA32(A0, P0, acc[d]);
            const bf16x8 A1 = tr_pair(vtb, VPITCH, 32 * st + 16 + 4 * h, 32 * st + 24 + 4 * h, 32 * d, lane);
            acc[d] = MFMA32(A1, P1, acc[d]);
        }
    }
    rowsum += __shfl_xor(rowsum, 32);
    const float qn = __shfl(acc[4][0], r31);
    const float den = qn + rowsum, dn = fmaxf(fabsf(den), fexp(-(bt + Mt))), inv = 1.f / dn;
    float ss = 0.f;
#pragma unroll
    for (int d = 0; d < 4; ++d)
#pragma unroll
        for (int reg = 0; reg < 16; ++reg) { acc[d][reg] *= inv; ss += acc[d][reg] * acc[d][reg]; }
    ss += __shfl_xor(ss, 32);
    const float rn = 1.f / sqrtf(ss * (1.f / 128.f) + 1e-6f);
    const bf16* omp = P + (size_t)(row0 + t) * PW + 2048 + hd * 128; bf16* cp = CAT + (size_t)(row0 + t) * DM + hd * 128;
#pragma unroll
    for (int d = 0; d < 4; ++d)
#pragma unroll
        for (int g = 0; g < 4; ++g) { const int dv0 = 32 * d + 8 * g + 4 * h; const f32x4 gh = ld4(ghead + hd * 128 + dv0); const u32x2 om = ld8(omp + dv0);
            const float o0 = acc[d][4 * g] * rn * gh.x * sigmoidf_(bflo(om.x)), o1 = acc[d][4 * g + 1] * rn * gh.y * sigmoidf_(bfhi(om.x));
            const float o2 = acc[d][4 * g + 2] * rn * gh.z * sigmoidf_(bflo(om.y)), o3 = acc[d][4 * g + 3] * rn * gh.w * sigmoidf_(bfhi(om.y));
            u32x2 w; w.x = pk2(o0, o1); w.y = pk2(o2, o3); st8(cp + dv0, w); }
    __syncthreads();
}

DI void sample_mlstm_unit(const bf16* P, const float* IG, const float* LF, const float* C0g, const float* n0g, const float* m0g, const float* ghead, bf16* CAT,
                          float* outC, float* outN, float* outM, int b, int hd, LAS unsigned char* lds, int tid, int wave, int lane) {
    LAS float* q = (LAS float*)lds;
    LAS float* k = q + 512;
    LAS float* v = k + 512;
    LAS float* S = v + 1024;
    LAS float* sb = S + 64;
    LAS float* sd = sb + 8;
    LAS float* sM = sd + 8;
    LAS float* sg = sM + 8;
    LAS float* sqn = sg + 8;
    LAS float* sdi = sqn + 8;
    LAS float* sss = sdi + 8;
    LAS float* skw = sss + 16;
    const int R0 = SEQ + 8 * b;
    { const int t = tid >> 6, dk = tid & 63;
      q[tid] = bf2f(*(const GAS unsigned short*)(P + (size_t)(R0 + t) * PW + hd * 64 + dk));
      k[tid] = bf2f(*(const GAS unsigned short*)(P + (size_t)(R0 + t) * PW + 512 + hd * 64 + dk));
#pragma unroll
      for (int i = 0; i < 2; ++i) { const int e = tid + 512 * i, tt = e >> 7, dv = e & 127; v[e] = bf2f(*(const GAS unsigned short*)(P + (size_t)(R0 + tt) * PW + 1024 + hd * 128 + dv)); } }
    const float m0 = ldf(m0g);
    if (wave == 0) {
        const int tt = lane & 7;
        const float lf = ldf(LF + (size_t)(R0 + tt) * 8 + hd), ig = ldf(IG + (size_t)(R0 + tt) * 8 + hd);
        float bb = lf;
#pragma unroll
        for (int o = 1; o < 8; o <<= 1) { const float x = __shfl_up(bb, o, 8); if (tt >= o) bb += x; }
        const float d = ig - bb; float pm = d;
#pragma unroll
        for (int o = 1; o < 8; o <<= 1) { const float x = __shfl_up(pm, o, 8); if (tt >= o) pm = fmaxf(pm, x); }
        if (lane < 8) { const float M = fmaxf(m0, pm); sb[tt] = bb; sd[tt] = d; sM[tt] = M; sg[tt] = fexp(m0 - M); }
    }
    __syncthreads();
    if (tid < 64) { const int t = tid >> 3, s = tid & 7; float a = 0.f;
#pragma unroll 8
        for (int dk = 0; dk < 64; ++dk) a += q[t * 64 + dk] * k[s * 64 + dk];
        S[tid] = (s <= t) ? a * fexp(sd[s] - sM[t]) : 0.f;
    } else if (tid < 128) { const int i = tid - 64, t = i >> 3, part = i & 7; float a = 0.f;
#pragma unroll
        for (int j = 0; j < 8; ++j) a += q[t * 64 + part * 8 + j] * ldf(n0g + part * 8 + j);
        a += __shfl_xor(a, 1); a += __shfl_xor(a, 2); a += __shfl_xor(a, 4);
        if (part == 0) sqn[t] = a;
    }
    { const int s = tid >> 6, dk = tid & 63; skw[tid] = fexp(sd[s] - sM[7]) * k[s * 64 + dk]; }
    __syncthreads();
    if (tid < 8) { float rs = 0.f;
#pragma unroll
        for (int s = 0; s < 8; ++s) rs += S[tid * 8 + s];
        const float den = sg[tid] * sqn[tid] + rs; sdi[tid] = 1.f / fmaxf(fabsf(den), fexp(-(sb[tid] + sM[tid]))); }
    __syncthreads();
    const int dv = tid & 127, tq = tid >> 7;
    float a0 = 0.f, a1 = 0.f;
#pragma unroll 8
    for (int dk = 0; dk < 64; ++dk) { const float c = ldf(C0g + dk * 128 + dv); a0 += q[tq * 64 + dk] * c; a1 += q[(tq + 4) * 64 + dk] * c; }
    float vv[8];
#pragma unroll
    for (int s = 0; s < 8; ++s) vv[s] = v[s * 128 + dv];
    float n0_ = sg[tq] * a0, n1_ = sg[tq + 4] * a1;
#pragma unroll
    for (int s = 0; s < 8; ++s) { n0_ += S[tq * 8 + s] * vv[s]; n1_ += S[(tq + 4) * 8 + s] * vv[s]; }
    const float h0 = n0_ * sdi[tq], h1 = n1_ * sdi[tq + 4];
    const float p0 = wave_sum(h0 * h0), p1 = wave_sum(h1 * h1);
    if (lane == 0) { sss[tq * 2 + (wave & 1)] = p0; sss[(tq + 4) * 2 + (wave & 1)] = p1; }
    __syncthreads();
    { const float r0 = 1.f / sqrtf((sss[tq * 2] + sss[tq * 2 + 1]) * (1.f / 128.f) + 1e-6f), r1 = 1.f / sqrtf((sss[(tq + 4) * 2] + sss[(tq + 4) * 2 + 1]) * (1.f / 128.f) + 1e-6f);
      const float gh = ldf(ghead + hd * 128 + dv);
      const float om0 = bf2f(*(const GAS unsigned short*)(P + (size_t)(R0 + tq) * PW + 2048 + hd * 128 + dv)), om1 = bf2f(*(const GAS unsigned short*)(P + (size_t)(R0 + tq + 4) * PW + 2048 + hd * 128 + dv));
      *(GAS unsigned short*)(CAT + (size_t)(R0 + tq) * DM + hd * 128 + dv) = (unsigned short)f2bf(h0 * r0 * gh * sigmoidf_(om0));
      *(GAS unsigned short*)(CAT + (size_t)(R0 + tq + 4) * DM + hd * 128 + dv) = (unsigned short)f2bf(h1 * r1 * gh * sigmoidf_(om1)); }
    const float gend = sg[7];
#pragma unroll 4
    for (int j = 0; j < 16; ++j) { const int dk = 16 * tq + j; float c = gend * ldf(C0g + dk * 128 + dv);
#pragma unroll
        for (int s = 0; s < 8; ++s) c += skw[s * 64 + dk] * vv[s];
        stf(outC + dk * 128 + dv, c); }
    if (tid < 64) { float n = gend * ldf(n0g + tid);
#pragma unroll
        for (int s = 0; s < 8; ++s) n += skw[s * 64 + tid];
        stf(outN + tid, n); }
    if (tid == 0) stf(outM, sb[7] + sM[7]);
    __syncthreads();
}

DI void sample_attn_unit(const bf16* P, const float* ck, const float* cv, bf16* CAT, int b, int head, LAS unsigned char* lds, int wave, int lane) {
    LAS float* sc = (LAS float*)lds + wave * 136;
    const int t = wave, half = lane >> 5, r31 = lane & 31, R0 = SEQ + 8 * b;
    f32x4 q;
    { const u32x2 w = ld8(P + (size_t)(R0 + t) * PW + 3072 + head * 128 + 4 * r31); q.x = bflo(w.x); q.y = bfhi(w.x); q.z = bflo(w.y); q.w = bfhi(w.y); }
    float Mr = -1e30f, Lr = 0.f; f32x4 Ar = {0.f, 0.f, 0.f, 0.f};
    const float* ckb = ck + (size_t)b * 2048 * 1024 + head * 128 + 4 * r31; const float* cvb = cv + (size_t)b * 2048 * 1024 + head * 128 + 4 * r31;
    for (int br = 0; br < 3; ++br) {
        const int ld = 2 * br;
#pragma unroll 5
        for (int jj = 0; jj < 65; ++jj) { const int j = 2 * jj + half; const bool ok = j <= 128; const int idx = 2048 + t - ((ok ? j : 0) << ld);
            f32x4 kv;
            if (idx >= 2048) { const u32x2 w = ld8(P + (size_t)(R0 + idx - 2048) * PW + 4096 + head * 128 + 4 * r31); kv.x = bflo(w.x); kv.y = bfhi(w.x); kv.z = bflo(w.y); kv.w = bfhi(w.y); }
            else kv = ld4(ckb + (size_t)idx * 1024);
            float s = q.x * kv.x + q.y * kv.y + q.z * kv.z + q.w * kv.w;
            s += __shfl_xor(s, 1); s += __shfl_xor(s, 2); s += __shfl_xor(s, 4); s += __shfl_xor(s, 8); s += __shfl_xor(s, 16);
            if (r31 == 0 && ok) sc[j] = s; }
        LDS_WAIT();
        float s0 = sc[lane], s1 = sc[64 + lane], s2 = (lane == 0) ? sc[128] : -INFINITY;
        const float m = wave_max(fmaxf(s0, fmaxf(s1, s2)));
        s0 = fexp2(s0 - m); s1 = fexp2(s1 - m); s2 = fexp2(s2 - m);
        const float l = wave_sum(s0 + s1 + s2);
        sc[lane] = s0; sc[64 + lane] = s1; if (lane == 0) sc[128] = s2;
        LDS_WAIT();
        f32x4 acc = {0.f, 0.f, 0.f, 0.f};
#pragma unroll 5
        for (int jj = 0; jj < 65; ++jj) { const int j = 2 * jj + half; const bool ok = j <= 128; const int idx = 2048 + t - ((ok ? j : 0) << ld);
            f32x4 vv;
            if (idx >= 2048) { const u32x2 w = ld8(P + (size_t)(R0 + idx - 2048) * PW + 5120 + head * 128 + 4 * r31); vv.x = bflo(w.x); vv.y = bfhi(w.x); vv.z = bflo(w.y); vv.w = bfhi(w.y); }
            else vv = ld4(cvb + (size_t)idx * 1024);
            const float p = ok ? sc[ok ? j : 0] : 0.f;
            acc += vv * p; }
        acc.x += __shfl_xor(acc.x, 32); acc.y += __shfl_xor(acc.y, 32); acc.z += __shfl_xor(acc.z, 32); acc.w += __shfl_xor(acc.w, 32);
        const float Mn = fmaxf(Mr, m), fa = fexp2(Mr - Mn), fb = fexp2(m - Mn);
        Ar = Ar * fa + acc * fb; Lr = Lr * fa + l * fb; Mr = Mn;
        LDS_WAIT();
    }
    if (half == 0) { const float inv = 1.f / Lr; u32x2 w; w.x = pk2(Ar.x * inv, Ar.y * inv); w.y = pk2(Ar.z * inv, Ar.w * inv);
        st8(CAT + (size_t)(R0 + t) * DM + 1024 + head * 128 + 4 * r31, w); }
}

DI void conv_task(const bf16* GV, bf16* ACT, const float* cw, const float* cb, const float* sconv, int e) {
    int row0, nrows, cg; f32x4 gm2[2], gm1[2];
    if (e < 256 * 704) { const int rc = e / 704; cg = e % 704; row0 = rc * 32; nrows = 32;
        if (rc == 0) { gm2[0] = gm2[1] = gm1[0] = gm1[1] = (f32x4){0.f, 0.f, 0.f, 0.f}; }
        else { const u32x4 a = ld16(GV + (size_t)(row0 - 2) * NUP + cg * 8), b = ld16(GV + (size_t)(row0 - 1) * NUP + cg * 8);
            gm2[0] = (f32x4){bflo(a.x), bfhi(a.x), bflo(a.y), bfhi(a.y)}; gm2[1] = (f32x4){bflo(a.z), bfhi(a.z), bflo(a.w), bfhi(a.w)};
            gm1[0] = (f32x4){bflo(b.x), bfhi(b.x), bflo(b.y), bfhi(b.y)}; gm1[1] = (f32x4){bflo(b.z), bfhi(b.z), bflo(b.w), bfhi(b.w)}; }
    } else { const int e2 = e - 256 * 704, bb = e2 / 704; cg = e2 % 704; row0 = SEQ + 8 * bb; nrows = 8;
        const float* s0 = sconv + ((size_t)bb * 2) * DFF + cg * 8;
        gm2[0] = ld4(s0); gm2[1] = ld4(s0 + 4); gm1[0] = ld4(s0 + DFF); gm1[1] = ld4(s0 + DFF + 4); }
    const int c0 = cg * 8;
    const f32x4 w0a = ld4(cw + c0), w0b = ld4(cw + c0 + 4), w1a = ld4(cw + DFF + c0), w1b = ld4(cw + DFF + c0 + 4), w2a = ld4(cw + 2 * DFF + c0), w2b = ld4(cw + 2 * DFF + c0 + 4);
    const f32x4 ba = ld4(cb + c0), bb4 = ld4(cb + c0 + 4);
    for (int r = 0; r < nrows; ++r) { const size_t ro = (size_t)(row0 + r) * NUP + c0;
        const u32x4 gw = ld16(GV + ro), vw = ld16(GV + ro + DFF);
        const f32x4 g0 = {bflo(gw.x), bfhi(gw.x), bflo(gw.y), bfhi(gw.y)}, g1 = {bflo(gw.z), bfhi(gw.z), bflo(gw.w), bfhi(gw.w)};
        const f32x4 v0 = {bflo(vw.x), bfhi(vw.x), bflo(vw.y), bfhi(vw.y)}, v1 = {bflo(vw.z), bfhi(vw.z), bflo(vw.w), bfhi(vw.w)};
        const f32x4 x0 = gm2[0] * w0a + gm1[0] * w1a + g0 * w2a + ba, x1 = gm2[1] * w0b + gm1[1] * w1b + g1 * w2b + bb4;
        u32x4 o; o.x = pk2(siluf_(x0.x) * v0.x, siluf_(x0.y) * v0.y); o.y = pk2(siluf_(x0.z) * v0.z, siluf_(x0.w) * v0.w);
        o.z = pk2(siluf_(x1.x) * v1.x, siluf_(x1.y) * v1.y); o.w = pk2(siluf_(x1.z) * v1.z, siluf_(x1.w) * v1.w);
        st16(ACT + (size_t)(row0 + r) * DFF + c0, o);
        gm2[0] = gm1[0]; gm2[1] = gm1[1]; gm1[0] = g0; gm1[1] = g1; }
}

#ifndef MK_SPLIT
#define MK_SPLIT 0
#endif
constexpr int N_PHASES = 22;
struct Args { const float* in[24]; float* out; unsigned char* ws; int ph_lo, ph_hi, li, pad; };

typedef const Args __attribute__((address_space(4)))* KArgs;
__global__ void __launch_bounds__(NTHR, 2) mk_fwd(Args a) {
    extern __shared__ __attribute__((aligned(16))) unsigned char lds_raw[];
    LAS unsigned char* lds = (LAS unsigned char*)lds_raw;
    const unsigned ldsbase = (unsigned)(size_t)lds_raw;
    const int tid = threadIdx.x, lane = tid & 63, wave = __builtin_amdgcn_readfirstlane(tid >> 6);
    const int G = gridDim.x, bid = blockIdx.x;
    volatile LAS unsigned* MISC = (volatile LAS unsigned*)(lds + MISC_OFF);
    for (int u = tid; u < (LDS_BYTES - LDSCTL_OFF) / 4; u += NTHR) ((LAS unsigned*)(lds + LDSCTL_OFF))[u] = 0u;
    __syncthreads();
    unsigned char* const ws = a.ws; float* const out0 = a.out;
    const KArgs ka0 = (KArgs)__builtin_amdgcn_kernarg_segment_ptr();
    XcdBarrier bar = xcd_barrier_post((unsigned*)ws + CW_BAR + a.li * XCD_BAR_WORDS, MISC + 8);
    const int lo = a.ph_lo, hi = a.ph_hi;
#ifndef MK_MASK
#define MK_MASK 0xFFFFFFFFu
#endif
#ifndef MK_P0
#define MK_P0 7
#endif
#ifndef MK_P3
#define MK_P3 15
#endif
#define RUN(k) (lo <= (k) && (k) < hi)
#define EN(j) ((MK_MASK >> (j)) & 1u)
#define SEAM(k) do { if (RUN(k) && RUN((k) + 1)) xcd_barrier(bar); } while (0)
#define PH() int ln = lane, td = tid; unsigned char* wsl = ws; float* out = out0; KArgs ka = ka0; asm volatile("" : "+v"(ln), "+v"(td), "+s"(wsl), "+s"(out), "+s"(ka)); \
             const int gw = bid * NWAVES + wave, ngw = G * NWAVES, gt = bid * NTHR + td, ngt = G * NTHR; (void)ln; (void)td; (void)gw; (void)ngw; (void)gt; (void)ngt; (void)out; (void)ka
#define W_(T, off) ((T*)(wsl + (off)))
#define IN_(k) (ka->in[k])

    if (EN(0) && RUN(0)) {
        if (MK_P0 & 1) { PH(); p0_mod(IN_(8), IN_(9), IN_(10), IN_(11), W_(float, WS_MOD), lds, bid, G, td, wave, ln); }
        if (MK_P0 & 2) { PH(); p0_rope(W_(float, WS_ROPE), W_(float, WS_ROPE) + 8200 * 64, gt, ngt); }
        if (MK_P0 & 4) { PH(); p0_weights(IN_(12), IN_(15), IN_(18), IN_(21), wsl, lds, gw, ngw, wave, ln); }
    }
    SEAM(0);
    if (EN(1) && RUN(1)) { PH(); const float* xp = IN_(0); const float* xs = IN_(1);
        for (int row = gw; row < MR; row += ngw) { const float* x = row < SEQ ? xp + (size_t)row * DM : xs + (size_t)(row - SEQ) * DM; const float* mr = W_(float, WS_MOD) + (size_t)mod_row(row) * NMOD;
            modulate_row(x, mr, mr + DM, W_(bf16, WS_U) + (size_t)row * DM, ln); }
    }
    SEAM(1);
    for (int l = 0; l < 2; ++l) {
        const int pb = 2 + 10 * l;
        if (EN(2) && RUN(pb + 0)) { PH();
            pg8::Gemm g{W_(bf16, WS_U), W_(bf16, WS_WIN) + (size_t)l * NINP * DM, MR, NINP, DM}; pg8::StaticOrder S; S.init(MR, NINP, G, bid);
            EpiIn E{wsl, out, IN_(13) + l * 16, l};
            pg8::gemm_phase<EpiIn, pg8::StaticOrder, true, true>(lds, g, S, E);
        }
        SEAM(pb + 0);
        if (EN(3) && RUN(pb + 1)) {
            if (MK_P3 & 1) { PH(); for (int u = bid; u < 768; u += G) attn_prompt_unit(W_(bf16, WS_P), W_(bf16, WS_OPART), W_(float, WS_ML), u, lds, ldsbase, wave, ln); }
            __syncthreads();
            if (MK_P3 & 2) { PH(); for (int it = bid; it < NUNIT / 2; it += G) mlstm_m1_item(W_(bf16, WS_P), W_(float, WS_IG), W_(float, WS_LF), W_(float, WS_SCAL), W_(float, WS_DCT), it, lds, ldsbase, wave, ln); }
            if (MK_P3 & 4) { PH(); for (int u = bid; u < 256; u += G) { const int b = u >> 3, hd = u & 7; const size_t so = ((size_t)(l * 32 + b) * 8 + hd);
                sample_mlstm_unit(W_(bf16, WS_P), W_(float, WS_IG), W_(float, WS_LF), IN_(4) + so * 8192, IN_(5) + so * 64, IN_(6) + so, IN_(14) + l * 1024, W_(bf16, WS_CAT), out + O_CS + so * 8192, out + O_NS + so * 64, out + O_MS + so, b, hd, lds, td, wave, ln); } }
            if (MK_P3 & 8) { PH(); for (int u = bid; u < 256; u += G) { const int b = u >> 3, hd = u & 7;
                sample_attn_unit(W_(bf16, WS_P), IN_(2) + (size_t)l * 32 * 2048 * 1024, IN_(3) + (size_t)l * 32 * 2048 * 1024, W_(bf16, WS_CAT), b, hd, lds, wave, ln); } }
            __syncthreads();
        }
        SEAM(pb + 1);
        if (EN(4) && RUN(pb + 2)) { PH();
            if (gt < 8 * 8256) mlstm_m2(W_(float, WS_SCAL), W_(float, WS_DCT), W_(bf16, WS_CST), W_(float, WS_MST), out + O_CP + (size_t)l * 65536, out + O_NP + (size_t)l * 512, out + O_MP + (size_t)l * 8, gt);
            else if (ngt > 8 * 8256) { for (int e = gt - 8 * 8256; e < SEQ * 128; e += ngt - 8 * 8256) attn_combine(W_(bf16, WS_OPART), W_(float, WS_ML), W_(bf16, WS_CAT), e); }
        }
        SEAM(pb + 2);
        if (EN(5) && RUN(pb + 3)) { PH(); for (int it = bid; it < NUNIT / 4; it += G) mlstm_m3_item(W_(bf16, WS_P), W_(float, WS_SCAL), W_(bf16, WS_CST), W_(float, WS_MST), IN_(14) + l * 1024, W_(bf16, WS_CAT), it, lds, ldsbase, wave, ln); }
        SEAM(pb + 3);
        if (EN(6) && RUN(pb + 4)) { PH();
            pg8::Gemm g{W_(bf16, WS_CAT), W_(bf16, WS_WOUT) + (size_t)l * DM * DM, MR, DM, DM}; pg8::StaticOrder S; S.init(MR, DM, G, bid);
            EpiRes E{W_(float, WS_Y), l == 0 ? IN_(0) : W_(float, WS_XR), l == 0 ? IN_(1) : W_(float, WS_XR) + (size_t)SEQ * DM, W_(float, WS_MOD) + (size_t)l * 33 * NMOD + 2 * DM};
            pg8::gemm_phase<EpiRes, pg8::StaticOrder, true, true>(lds, g, S, E);
        }
        SEAM(pb + 4);
        if (EN(7) && RUN(pb + 5)) { PH(); const float* lg = IN_(16) + l * DM; const float* lb = IN_(17) + l * DM;
            for (int row = gw; row < MR; row += ngw) { const float* mr = W_(float, WS_MOD) + ((size_t)l * 33 + mod_row(row)) * NMOD;
                ln_row(W_(float, WS_Y) + (size_t)row * DM, lg, lb, W_(float, WS_XA) + (size_t)row * DM, mr + 3 * DM, mr + 4 * DM, W_(bf16, WS_U) + (size_t)row * DM, ln); }
        }
        SEAM(pb + 5);
        if (EN(8) && RUN(pb + 6)) { PH();
            pg8::Gemm g{W_(bf16, WS_U), W_(bf16, WS_WUP) + (size_t)l * NUP * DM, MR, NUP, DM}; pg8::StaticOrder S; S.init(MR, NUP, G, bid);
            EpiUp E{W_(bf16, WS_GV), out + O_BP + (size_t)l * 2 * DFF, out + O_BS + (size_t)l * 32 * 2 * DFF};
            pg8::gemm_phase<EpiUp, pg8::StaticOrder, true, true>(lds, g, S, E);
        }
        SEAM(pb + 6);
        if (EN(9) && RUN(pb + 7)) { PH(); const float* cw = IN_(19) + (size_t)l * 3 * DFF; const float* cb = IN_(20) + (size_t)l * DFF; const float* sc = IN_(7) + (size_t)l * 32 * 2 * DFF;
            for (int e = gt; e < (256 + 32) * 704; e += ngt) conv_task(W_(bf16, WS_GV), W_(bf16, WS_ACT), cw, cb, sc, e); }
        SEAM(pb + 7);
        if (EN(10) && RUN(pb + 8)) { PH();
            pg8::Gemm g{W_(bf16, WS_ACT), W_(bf16, WS_WDN) + (size_t)l * DM * DFF, MR, DM, DFF}; pg8::StaticOrder S; S.init(MR, DM, G, bid);
            EpiRes E{W_(float, WS_Y), W_(float, WS_XA), W_(float, WS_XA) + (size_t)SEQ * DM, W_(float, WS_MOD) + (size_t)l * 33 * NMOD + 5 * DM};
            pg8::gemm_phase<EpiRes, pg8::StaticOrder, true, true>(lds, g, S, E);
        }
        SEAM(pb + 8);
        if (EN(11) && RUN(pb + 9)) { PH(); const float* lg = IN_(22) + l * DM; const float* lb = IN_(23) + l * DM; float* xo = l == 0 ? W_(float, WS_XR) : out + O_XP;
            for (int row = gw; row < MR; row += ngw) { const float* mr = W_(float, WS_MOD) + (size_t)(33 + mod_row(row)) * NMOD;
                ln_row(W_(float, WS_Y) + (size_t)row * DM, lg, lb, xo + (size_t)row * DM, mr, mr + DM, l == 0 ? W_(bf16, WS_U) + (size_t)row * DM : (bf16*)nullptr, ln); }
        }
        SEAM(pb + 9);
    }
#undef RUN
#undef SEAM
}

extern "C" void kernel_launch(void* const* d_in, const int* in_sizes, int n_in, void* d_out, int out_size, void* d_ws, size_t ws_size, hipStream_t stream) {
    static int grid = 0;
    if (grid == 0) {
        if (n_in != 24 || out_size != (int)O_END || ws_size < WS_END) { fprintf(stderr, "kernel_launch: unexpected shapes: n_in %d out %d ws %zu (need %zu)\n", n_in, out_size, ws_size, (size_t)WS_END); grid = -1; return; }
        int dev = 0, cus = 0, per_cu = 0;
        if (hipGetDevice(&dev) != hipSuccess || hipDeviceGetAttribute(&cus, hipDeviceAttributeMultiprocessorCount, dev) != hipSuccess) { fprintf(stderr, "kernel_launch: device query failed\n"); grid = -1; return; }
        if (hipFuncSetAttribute((const void*)mk_fwd, hipFuncAttributeMaxDynamicSharedMemorySize, LDS_BYTES) != hipSuccess) { fprintf(stderr, "kernel_launch: hipFuncSetAttribute failed\n"); grid = -1; return; }
        if (hipOccupancyMaxActiveBlocksPerMultiprocessor(&per_cu, (const void*)mk_fwd, NTHR, LDS_BYTES) != hipSuccess || per_cu < 1) fprintf(stderr, "kernel_launch: note: occupancy query reports %d blocks per CU\n", per_cu);
        (void)hipGetLastError();
        grid = cus;
    }
    if (grid < 0) return;
    (void)in_sizes;
    if (hipMemsetAsync((char*)d_ws + WS_CTL, 0, CTL_ZERO_BYTES, stream) != hipSuccess) { fprintf(stderr, "kernel_launch: memset failed\n"); return; }
    Args a{};
    for (int i = 0; i < 24; ++i) a.in[i] = (const float*)d_in[i];
    a.out = (float*)d_out; a.ws = (unsigned char*)d_ws; a.pad = 0;
#if MK_SPLIT
    for (int p = 0; p < N_PHASES; ++p) { a.ph_lo = p; a.ph_hi = p + 1; a.li = p; hipLaunchKernelGGL(mk_fwd, dim3(grid), dim3(NTHR), LDS_BYTES, stream, a); }
#else
    a.ph_lo = 0; a.ph_hi = N_PHASES; a.li = 0;
    hipLaunchKernelGGL(mk_fwd, dim3(grid), dim3(NTHR), LDS_BYTES, stream, a);
#endif
    const hipError_t le = hipPeekAtLastError();
    if (le != hipSuccess) fprintf(stderr, "kernel_launch: launch failed: %s\n", hipGetErrorName(le));
}
```

```cpp
#include <hip/hip_runtime.h>
#include <cstdio>
#include <cstdint>
namespace pg8 {
#define PG8_LAS __attribute__((address_space(3)))
typedef unsigned short bf16_t;
typedef short bf16x8 __attribute__((ext_vector_type(8)));
typedef float f32x4 __attribute__((ext_vector_type(4)));
typedef unsigned u32x4 __attribute__((ext_vector_type(4)));
constexpr int BM = 256, BK = 64, HALF = 128, HTB = HALF * BK * 2  , STAGE_BYTES = 8 * HTB, NXCD = 8, WGM = 8;

__host__ __device__ __forceinline__ int lds_byte(int r, int c) { const int st = (r >> 4) * 2 + (c >> 5), rr = r & 15, cc = c & 31, ob = rr * 64 + cc * 2; return st * 1024 + (ob ^ (((ob >> 9) & 1) << 5)); }
__host__ __device__ __forceinline__ void stage_rc(int b, int& R, int& C) { const int st = b / 1024, sb = b % 1024, swz = sb ^ (((sb >> 9) & 1) << 5); R = (st >> 1) * 16 + swz / 64; C = (st & 1) * 32 + (swz % 64) / 2; }
__host__ __device__ __forceinline__ int perm32(int rho) { const int n = rho >> 4, i = rho & 15; return 8 * (i >> 2) + 4 * n + (i & 3); }

struct Unit { int pm, pn, ks; };
struct Gemm { const bf16_t* A; const bf16_t* Bt; int M, N, K, ld; };

struct StaticOrder {
    int nM, nN, nwg, G, c;
    __host__ __device__ void init(int M, int N, int G_, int c_) { nM = M / BM; nN = N / BM; nwg = nM * nN; G = G_; c = c_; }
    __host__ __device__ bool next(int i, Unit& u) const {
        const long L = (long)i * G + c; if (L >= nwg) return false;
        int wgid = (int)L; { const int q = nwg / NXCD, r = nwg % NXCD, xcd = wgid % NXCD, off = wgid / NXCD; wgid = (xcd < r ? xcd * (q + 1) : r * (q + 1) + (xcd - r) * q) + off; }
        const int nig = WGM * nN, gid = wgid / nig, fm = gid * WGM, gsz = (nM - fm) < WGM ? (nM - fm) : WGM;
        u.pm = fm + ((wgid % nig) % gsz); u.pn = (wgid % nig) / gsz; u.ks = 0; return true;
    }
    __device__ __forceinline__ void a_ready(const Unit&) const {}
    __device__ __forceinline__ void done(const Unit&) const {}
};

__device__ __forceinline__ unsigned cvt_pk_bf16(float lo, float hi) { unsigned r; asm volatile("v_cvt_pk_bf16_f32 %0, %1, %2" : "=v"(r) : "v"(lo), "v"(hi)); return r; }
template <class Epi, class Sched, bool ALIGN_EPI = false, bool SP2 = false>
__device__ __forceinline__ void gemm_phase(PG8_LAS unsigned char* lds, const Gemm g, const Sched& S, const Epi& E) {
    int tid_ = threadIdx.x; asm volatile("" : "+v"(tid_));
    const int tid = tid_, wid = __builtin_amdgcn_readfirstlane(tid >> 6), lane = tid & 63, wr = wid >> 2, wc = wid & 3, fr = lane & 15, fq = lane >> 4;
    const int K = g.K, nt = K / BK;
    unsigned voffA[2], voffB[2];
#pragma unroll
    for (int i = 0; i < 2; ++i) { int R, C; stage_rc(tid * 16 + i * 8192, R, C); const int Rb = Epi::PERM ? ((R & ~31) + perm32(R & 31)) : R;
        voffA[i] = (unsigned)(R * g.ld + C) * 2u; voffB[i] = (unsigned)(Rb * g.ld + C) * 2u; }
    const size_t kstep = (size_t)(BK * 2);
    const size_t hstep = (size_t)HALF * g.ld * 2;
    const size_t tstep = 2 * hstep;
    const unsigned ldsw = (unsigned)wid * 1024u;
    const int aoff = lds_byte(wr * 64 + fr, fq * 8), boff = lds_byte(wc * 32 + fr, fq * 8);
#define PG8_SA(b, h) (((b) * 2 + (h)) * HTB)
#define PG8_SB(b, h) ((4 + (b) * 2 + (h)) * HTB)
#define PG8_STAGE(bufoff, gbase, voff) do { _Pragma("unroll") for (int _i = 0; _i < 2; ++_i) \
        __builtin_amdgcn_global_load_lds((const unsigned*)((const char*)(gbase) + (voff)[_i]), (PG8_LAS unsigned*)(lds + (bufoff) + ldsw + _i * 8192), 16, 0, 0); } while (0)
#define PG8_LDA(dst, b, h) do { _Pragma("unroll") for (int m = 0; m < 4; ++m) _Pragma("unroll") for (int k = 0; k < 2; ++k) dst[m][k] = *(const PG8_LAS bf16x8*)(lds + PG8_SA(b, h) + aoff + m * 2048 + k * 1024); } while (0)
#define PG8_LDB(dst, b, h) do { _Pragma("unroll") for (int n = 0; n < 2; ++n) _Pragma("unroll") for (int k = 0; k < 2; ++k) dst[n][k] = *(const PG8_LAS bf16x8*)(lds + PG8_SB(b, h) + boff + n * 2048 + k * 1024); } while (0)
#define PG8_MMA(ai, bj, At, Bt) do { __builtin_amdgcn_s_setprio(1); _Pragma("unroll") for (int m = 0; m < 4; ++m) _Pragma("unroll") for (int n = 0; n < 2; ++n) _Pragma("unroll") for (int k = 0; k < 2; ++k) \
        acc[ai][bj][m][n] = __builtin_amdgcn_mfma_f32_16x16x32_bf16(Bt[n][k], At[m][k], acc[ai][bj][m][n], 0, 0, 0); __builtin_amdgcn_s_setprio(0); } while (0)
#define PG8_WAIT_V(n) asm volatile("s_waitcnt vmcnt(" #n ")" ::: "memory")
#define PG8_WAIT_L(n) asm volatile("s_waitcnt lgkmcnt(" #n ")" ::: "memory")
#define PG8_BAR __builtin_amdgcn_s_barrier()
#define PG8_SCHED __builtin_amdgcn_sched_barrier(0)
    Unit cur, nxt; int ui = 0;
    if (!S.next(0, cur)) return;
    f32x4 acc[2][2][4][2];
#pragma unroll
    for (int a = 0; a < 2; ++a)
#pragma unroll
        for (int b = 0; b < 2; ++b)
#pragma unroll
            for (int m = 0; m < 4; ++m)
#pragma unroll
                for (int n = 0; n < 2; ++n) acc[a][b][m][n] = (f32x4){0.f, 0.f, 0.f, 0.f};
    bf16x8 At[4][2], B0[2][2], B1[2][2];
    const char* cA = (const char*)g.A + (size_t)cur.pm * tstep + (size_t)cur.ks * K * 2; const char* cB = (const char*)g.Bt + (size_t)cur.pn * tstep + (size_t)cur.ks * K * 2;
    S.a_ready(cur);
    if constexpr (SP2) {
        PG8_STAGE(PG8_SB(0, 0), cB, voffB); PG8_STAGE(PG8_SB(0, 1), cB + hstep, voffB); PG8_STAGE(PG8_SA(0, 0), cA, voffA); PG8_STAGE(PG8_SA(0, 1), cA + hstep, voffA);
        if (wr == 1) PG8_BAR;
        PG8_WAIT_V(2); PG8_BAR;
        PG8_STAGE(PG8_SB(1, 0), cB + kstep, voffB); PG8_STAGE(PG8_SA(1, 0), cA + kstep, voffA); PG8_STAGE(PG8_SB(1, 1), cB + hstep + kstep, voffB);
        PG8_WAIT_V(6); PG8_BAR;
    } else {
        PG8_STAGE(PG8_SB(0, 0), cB, voffB); PG8_STAGE(PG8_SA(0, 0), cA, voffA); PG8_STAGE(PG8_SB(0, 1), cB + hstep, voffB); PG8_STAGE(PG8_SA(0, 1), cA + hstep, voffA);
        if (wr == 1) PG8_BAR;
        PG8_WAIT_V(4); PG8_BAR;
        PG8_STAGE(PG8_SB(1, 0), cB + kstep, voffB); PG8_STAGE(PG8_SA(1, 0), cA + kstep, voffA); PG8_STAGE(PG8_SB(1, 1), cB + hstep + kstep, voffB);
        PG8_WAIT_V(6); PG8_BAR;
    }
    for (;;) {
        const bool has_next = S.next(ui + 1, nxt);
        const char* nA = has_next ? (const char*)g.A + (size_t)nxt.pm * tstep + (size_t)nxt.ks * K * 2 : cA; const char* nB = has_next ? (const char*)g.Bt + (size_t)nxt.pn * tstep + (size_t)nxt.ks * K * 2 : cB;
        for (int t = 0; t < nt; t += 2) {
            const bool last = (t == nt - 2);
            const char* a1 = cA + (size_t)(t + 1) * kstep;
            const char* a2 = last ? nA : cA + (size_t)(t + 2) * kstep; const char* b2 = last ? nB : cB + (size_t)(t + 2) * kstep;
            const char* a3 = a2 + kstep; const char* b3 = b2 + kstep;
            if (last && has_next) S.a_ready(nxt);
            if constexpr (SP2) {
            PG8_LDB(B0, 0, 0); PG8_LDB(B1, 0, 1); PG8_SCHED; PG8_LDA(At, 0, 0); PG8_STAGE(PG8_SA(1, 1), a1 + hstep, voffA);
            PG8_WAIT_V(8); PG8_WAIT_L(0); PG8_BAR; PG8_MMA(0, 0, At, B0); PG8_MMA(0, 1, At, B1); PG8_BAR; PG8_SCHED;
            PG8_LDA(At, 0, 1); PG8_STAGE(PG8_SB(0, 0), b2, voffB); PG8_STAGE(PG8_SB(0, 1), b2 + hstep, voffB); PG8_STAGE(PG8_SA(0, 0), a2, voffA);
            PG8_WAIT_V(8); PG8_WAIT_L(0); PG8_BAR; PG8_MMA(1, 0, At, B0); PG8_MMA(1, 1, At, B1); PG8_BAR; PG8_SCHED;
            PG8_LDB(B0, 1, 0); PG8_LDB(B1, 1, 1); PG8_SCHED; PG8_LDA(At, 1, 0); PG8_STAGE(PG8_SA(0, 1), a2 + hstep, voffA);
            PG8_WAIT_V(8); PG8_WAIT_L(0); PG8_BAR; PG8_MMA(0, 0, At, B0); PG8_MMA(0, 1, At, B1); PG8_BAR; PG8_SCHED;
            PG8_LDA(At, 1, 1); PG8_STAGE(PG8_SB(1, 0), b3, voffB); PG8_STAGE(PG8_SB(1, 1), b3 + hstep, voffB); PG8_STAGE(PG8_SA(1, 0), a3, voffA);
            PG8_WAIT_V(8); PG8_WAIT_L(0); PG8_BAR; PG8_MMA(1, 0, At, B0); PG8_MMA(1, 1, At, B1); PG8_BAR; PG8_SCHED;
            } else {
            PG8_LDB(B0, 0, 0); PG8_SCHED; PG8_LDA(At, 0, 0); PG8_STAGE(PG8_SA(1, 1), a1 + hstep, voffA);
            PG8_WAIT_L(8); PG8_BAR; PG8_WAIT_L(0); PG8_MMA(0, 0, At, B0); PG8_BAR; PG8_SCHED;
            PG8_LDB(B1, 0, 1); PG8_STAGE(PG8_SB(0, 0), b2, voffB);
            PG8_BAR; PG8_WAIT_L(0); PG8_MMA(0, 1, At, B1); PG8_BAR;
            PG8_LDA(At, 0, 1); PG8_STAGE(PG8_SA(0, 0), a2, voffA);
            PG8_BAR; PG8_WAIT_L(0); PG8_MMA(1, 0, At, B0); PG8_BAR; PG8_SCHED;
            PG8_STAGE(PG8_SB(0, 1), b2 + hstep, voffB);
            PG8_WAIT_V(6); PG8_BAR; PG8_MMA(1, 1, At, B1); PG8_BAR;
            PG8_LDB(B0, 1, 0); PG8_SCHED; PG8_LDA(At, 1, 0); PG8_STAGE(PG8_SA(0, 1), a2 + hstep, voffA);
            PG8_WAIT_L(8); PG8_BAR; PG8_WAIT_L(0); PG8_MMA(0, 0, At, B0); PG8_BAR; PG8_SCHED;
            PG8_LDB(B1, 1, 1); PG8_STAGE(PG8_SB(1, 0), b3, voffB);
            PG8_BAR; PG8_WAIT_L(0); PG8_MMA(0, 1, At, B1); PG8_BAR;
            PG8_LDA(At, 1, 1); PG8_STAGE(PG8_SA(1, 0), a3, voffA);
            PG8_BAR; PG8_WAIT_L(0); PG8_MMA(1, 0, At, B0); PG8_BAR; PG8_SCHED;
            PG8_STAGE(PG8_SB(1, 1), b3 + hstep, voffB);
            PG8_WAIT_V(6); PG8_BAR; PG8_MMA(1, 1, At, B1); PG8_BAR;
            }
        }
        if constexpr (ALIGN_EPI) { if (wr == 0) PG8_BAR; }
        if constexpr (!Epi::AFTER_DRAIN) { E(acc, cur, wr, wc, fr, fq); S.done(cur); }
        if (!has_next) break;
#pragma unroll
        for (int a = 0; a < 2; ++a)
#pragma unroll
            for (int b = 0; b < 2; ++b)
#pragma unroll
                for (int m = 0; m < 4; ++m)
#pragma unroll
                    for (int n = 0; n < 2; ++n) acc[a][b][m][n] = (f32x4){0.f, 0.f, 0.f, 0.f};
        cur = nxt; cA = nA; cB = nB; ++ui;
        if constexpr (ALIGN_EPI) { if (wr == 1) PG8_BAR; }
    }
    PG8_WAIT_V(0);
    if constexpr (!ALIGN_EPI) { if (wr == 0) PG8_BAR; }
    PG8_BAR;
    if constexpr (Epi::AFTER_DRAIN) { E.fused(acc, cur, wr, wc, fr, fq, lds, wid, lane); S.done(cur); }
#undef PG8_SA
#undef PG8_SB
#undef PG8_STAGE
#undef PG8_LDA
#undef PG8_LDB
#undef PG8_MMA
#undef PG8_WAIT_V
#undef PG8_WAIT_L
#undef PG8_BAR
#undef PG8_SCHED
}
}

#define DI __device__ __forceinline__
#define GAS __attribute__((address_space(1)))
#define LAS __attribute__((address_space(3)))
typedef unsigned short bf16;
typedef float f32x4 __attribute__((ext_vector_type(4)));
typedef float f32x16 __attribute__((ext_vector_type(16)));
typedef short bf16x8 __attribute__((ext_vector_type(8)));
typedef short s16x4 __attribute__((ext_vector_type(4)));
typedef unsigned u32x4 __attribute__((ext_vector_type(4)));
typedef unsigned u32x2 __attribute__((ext_vector_type(2)));
typedef GAS unsigned gu32;
#define RLX_AGENT __ATOMIC_RELAXED, __HIP_MEMORY_SCOPE_AGENT
#define LDS_WAIT() asm volatile("s_waitcnt lgkmcnt(0)" ::: "memory")
#define VM_WAIT() asm volatile("s_waitcnt vmcnt(0)" ::: "memory")

constexpr int DM = 2048, SEQ = 8192, NSMP = 256, MR = SEQ + NSMP, DFF = 5632, NUP = 2 * DFF, NINP = 6144, DIN = 6160, NMOD = 6 * DM, PW = 6144;
constexpr int NCH = 128, LCH = 64, NHM = 8, NUNIT = NCH * NHM;
constexpr float ALPHA_RES = 1.4142135623730951f;
constexpr float QSCALE = 0.12751743082459868f;
constexpr float LOG2E = 1.4426950408889634f;
constexpr int NWAVES = 8, NTHR = 512;

constexpr size_t O_XP = 0, O_XS = 16777216, O_KP = 17301504, O_VP = 21495808, O_CP = 25690112, O_NP = 25821184, O_MP = 25822208, O_BP = 25822224,
                 O_KS = 25844752, O_VS = 26369040, O_CS = 26893328, O_NS = 31087632, O_MS = 31120400, O_BS = 31120912, O_END = 31841808;

constexpr size_t al256(size_t x) { return (x + 255) & ~(size_t)255; }
constexpr size_t WS_CTL = 0, CTL_ZERO_BYTES = 1u << 20;
constexpr size_t WS_MOD  = CTL_ZERO_BYTES;
constexpr size_t WS_ROPE = WS_MOD  + al256((size_t)2 * 33 * NMOD * 4);
constexpr size_t WS_WIN  = WS_ROPE + al256((size_t)2 * 8200 * 64 * 4);
constexpr size_t WS_WOUT = WS_WIN  + (size_t)2 * NINP * DM * 2;
constexpr size_t WS_WUP  = WS_WOUT + (size_t)2 * DM * DM * 2;
constexpr size_t WS_WDN  = WS_WUP  + (size_t)2 * NUP * DM * 2;
constexpr size_t WS_U    = WS_WDN  + (size_t)2 * DM * DFF * 2;
constexpr size_t WS_P    = WS_U    + (size_t)MR * DM * 2;
constexpr size_t WS_IG   = WS_P    + (size_t)MR * PW * 2;
constexpr size_t WS_LF   = WS_IG   + al256((size_t)MR * 8 * 4);
constexpr size_t WS_SCAL = WS_LF   + al256((size_t)MR * 8 * 4);
constexpr size_t WS_DCT  = WS_SCAL + (size_t)NUNIT * 192 * 4;
constexpr size_t WS_CST  = WS_DCT  + al256((size_t)NUNIT * 129 * 64 * 4);
constexpr size_t WS_MST  = WS_CST  + (size_t)NUNIT * 160 * 64 * 2;
constexpr size_t WS_OPART= WS_MST  + al256((size_t)NUNIT * 4);
constexpr size_t WS_ML   = WS_OPART+ (size_t)3 * SEQ * 1024 * 2;
constexpr size_t WS_CAT  = WS_ML   + (size_t)3 * SEQ * 8 * 2 * 4;
constexpr size_t WS_Y    = WS_CAT  + (size_t)MR * DM * 2;
constexpr size_t WS_XA   = WS_Y    + (size_t)MR * DM * 4;
constexpr size_t WS_XR   = WS_XA   + (size_t)MR * DM * 4;
constexpr size_t WS_GV   = WS_XR   + (size_t)MR * DM * 4;
constexpr size_t WS_ACT  = WS_GV   + (size_t)MR * NUP * 2;
constexpr size_t WS_SLAB = WS_ACT  + (size_t)MR * DFF * 2;
constexpr size_t WS_END  = WS_SLAB + (size_t)11 * NSMP * DM * 4;
constexpr int CW_BAR = 4096;
constexpr int CW_Q = 131072;

constexpr int RING_BYTES = 131072, LDSCTL_OFF = RING_BYTES, MISC_OFF = LDSCTL_OFF + 320, LDS_BYTES = 147456;

DI unsigned f2bf(float f) { unsigned u = __builtin_bit_cast(unsigned, f); return (u + 0x7fffu + ((u >> 16) & 1u)) >> 16; }
DI unsigned pk2(float lo, float hi) { return f2bf(lo) | (f2bf(hi) << 16); }
DI float bf2f(unsigned b) { return __builtin_bit_cast(float, b << 16); }
DI float bflo(unsigned w) { return __builtin_bit_cast(float, w << 16); }
DI float bfhi(unsigned w) { return __builtin_bit_cast(float, w & 0xffff0000u); }
DI f32x4 ld4(const float* p) { return *(const GAS f32x4*)p; }
DI void st4(float* p, f32x4 v) { *(GAS f32x4*)p = v; }
DI u32x4 ld16(const void* p) { return *(const GAS u32x4*)p; }
DI void st16(void* p, u32x4 v) { *(GAS u32x4*)p = v; }
DI u32x2 ld8(const void* p) { return *(const GAS u32x2*)p; }
DI void st8(void* p, u32x2 v) { *(GAS u32x2*)p = v; }
DI float ldf(const float* p) { return *(const GAS float*)p; }
DI void stf(float* p, float v) { *(GAS float*)p = v; }
DI bf16x8 ldfrag(const bf16* p) { return __builtin_bit_cast(bf16x8, *(const GAS u32x4*)p); }
DI float fexp2(float x) { return __builtin_amdgcn_exp2f(x); }
DI float fexp(float x) { return __builtin_amdgcn_exp2f(x * LOG2E); }
DI float frcp(float x) { return __builtin_amdgcn_rcpf(x); }
DI float sigmoidf_(float x) { return frcp(1.f + fexp(-x)); }
DI float siluf_(float x) { return x * sigmoidf_(x); }
DI float logsigmoidf_(float v) { const float e = fexp(-fabsf(v)); return fminf(v, 0.f) - __logf(1.f + e); }
DI int crow(int reg, int h) { return (reg & 3) + 8 * (reg >> 2) + 4 * h; }
DI f32x16 zero16() { f32x16 z; for (int i = 0; i < 16; ++i) z[i] = 0.f; return z; }
#define MFMA32(a, b, c) __builtin_amdgcn_mfma_f32_32x32x16_bf16((a), (b), (c), 0, 0, 0)
DI float wave_sum(float v) {
#pragma unroll
    for (int o = 1; o < 64; o <<= 1) v += __shfl_xor(v, o);
    return v;
}
DI float wave_max(float v) {
#pragma unroll
    for (int o = 1; o < 64; o <<= 1) v = fmaxf(v, __shfl_xor(v, o));
    return v;
}
DI bf16x8 pack_step(const f32x16& x, int s) {
    u32x4 p; p[0] = pk2(x[8 * s], x[8 * s + 1]); p[1] = pk2(x[8 * s + 2], x[8 * s + 3]); p[2] = pk2(x[8 * s + 4], x[8 * s + 5]); p[3] = pk2(x[8 * s + 6], x[8 * s + 7]);
    return __builtin_bit_cast(bf16x8, p);
}
DI bf16x8 tr_pair(unsigned tile, int pitch, int s0, int s1, int cbase, int lane) {
    const int i = lane & 15, q = i >> 2, p = i & 3, cb = (lane >> 4) & 1;
    const unsigned a0 = tile + (unsigned)((s0 + q) * pitch + (cbase + 16 * cb + 4 * p) * 2);
    const unsigned a1 = tile + (unsigned)((s1 + q) * pitch + (cbase + 16 * cb + 4 * p) * 2);
    s16x4 lo, hi;
    asm volatile("ds_read_b64_tr_b16 %0, %2\n\tds_read_b64_tr_b16 %1, %3\n\ts_waitcnt lgkmcnt(0)" : "=&v"(lo), "=&v"(hi) : "v"(a0), "v"(a1) : "memory");
    return __builtin_shufflevector(lo, hi, 0, 1, 2, 3, 4, 5, 6, 7);
}

DI int mod_row(int row) { return row < SEQ ? 0 : 1 + ((row - SEQ) >> 3); }

DI int win_src_col(int nb) {
    const int n0 = nb * 32;
    if (n0 < 3072) return n0;
    if (n0 < 5120) {
        const int which = (n0 - 3072) / 1024, rel = (n0 - 3072) % 1024, tile = rel / 256, j0 = rel % 256;
        const int bj = j0 / 128, h2 = (j0 % 128) / 64, ib = (j0 % 64) / 32;
        return 3088 + which * 1024 + (2 * tile + h2) * 128 + bj * 64 + 32 * ib;
    }
    return 5136 + (n0 - 5120);
}
DI void transpose_item(const float* W, int N, int K, bf16* WT, int drow0, int scol0, int k0, LAS float* scr, int lane) {
#pragma unroll 8
    for (int i = 0; i < 32; ++i) { const int kk = 2 * i + (lane >> 5); scr[kk * 33 + (lane & 31)] = ldf(W + (size_t)(k0 + kk) * N + scol0 + (lane & 31)); }
    LDS_WAIT();
    const int c = lane & 7;
#pragma unroll
    for (int j = 0; j < 4; ++j) { const int n = (lane >> 3) + 8 * j; const LAS float* s = scr + (8 * c) * 33 + n;
        u32x4 o; o.x = pk2(s[0 * 33], s[1 * 33]); o.y = pk2(s[2 * 33], s[3 * 33]); o.z = pk2(s[4 * 33], s[5 * 33]); o.w = pk2(s[6 * 33], s[7 * 33]);
        st16(WT + (size_t)(drow0 + n) * K + k0 + 8 * c, o); }
    LDS_WAIT();
}
constexpr int IT_IN = 32 * 192, IT_OUT = 32 * 64, IT_UP = 32 * 352, IT_DN = 88 * 64, IT_LAYER = IT_IN + IT_OUT + IT_UP + IT_DN;

DI void p0_weights(const float* w_in, const float* w_out, const float* w_up, const float* w_down, unsigned char* ws, LAS unsigned char* lds, int gw, int ngw, int wave, int lane) {
    LAS float* scr = (LAS float*)(lds + wave * 16384);
    for (int it = gw; it < 2 * IT_LAYER; it += ngw) {
        const int l = it / IT_LAYER; int r = it % IT_LAYER;
        if (r < IT_IN) { const int kb = r / 192, nb = r % 192;
            transpose_item(w_in + (size_t)l * DM * DIN, DIN, DM, (bf16*)(ws + WS_WIN) + (size_t)l * NINP * DM, nb * 32, win_src_col(nb), kb * 64, scr, lane); continue; }
        r -= IT_IN;
        if (r < IT_OUT) { const int kb = r / 64, nb = r % 64;
            transpose_item(w_out + (size_t)l * DM * DM, DM, DM, (bf16*)(ws + WS_WOUT) + (size_t)l * DM * DM, nb * 32, nb * 32, kb * 64, scr, lane); continue; }
        r -= IT_OUT;
        if (r < IT_UP) { const int kb = r / 352, nb = r % 352;
            transpose_item(w_up + (size_t)l * DM * NUP, NUP, DM, (bf16*)(ws + WS_WUP) + (size_t)l * NUP * DM, nb * 32, nb * 32, kb * 64, scr, lane); continue; }
        r -= IT_UP;
        { const int kb = r / 64, nb = r % 64;
            transpose_item(w_down + (size_t)l * DFF * DM, DM, DFF, (bf16*)(ws + WS_WDN) + (size_t)l * DM * DFF, nb * 32, nb * 32, kb * 64, scr, lane); }
    }
}
DI void p0_rope(float* cosT, float* sinT, int gt, int ngt) {
    for (int e = gt; e < 8200 * 64; e += ngt) {
        const int pos = e >> 6, i = e & 63;
        double inv = 1.0;
        if (i & 1) inv *= 0.8659643233600653;
        if (i & 2) inv *= 0.7498942093324559;
        if (i & 4) inv *= 0.5623413251903491;
        if (i & 8) inv *= 0.31622776601683794;
        if (i & 16) inv *= 0.1;
        if (i & 32) inv *= 0.01;
        double rev = (double)pos * inv * 0.15915494309189535;
        rev = rev - __builtin_rint(rev);
        const float fr = (float)rev;
        stf(cosT + e, __builtin_amdgcn_cosf(fr)); stf(sinT + e, __builtin_amdgcn_sinf(fr));
    }
}
DI void p0_mod(const float* c_prompt, const float* c_sample, const float* w_ada, const float* b_ada, float* MOD, LAS unsigned char* lds, int bid, int G, int tid, int wave, int lane) {
    LAS float* cpl = (LAS float*)(lds + 65536);
    LAS float* red = (LAS float*)(lds + 65536 + 8192);
    const int h = lane >> 5, r31 = lane & 31, kbase = 256 * wave;
    for (int i = tid; i < DM; i += NTHR) cpl[i] = siluf_(ldf(c_prompt + i));
    __syncthreads();
    for (int item = bid; item < 768; item += G) {
        const int l = item / 384, n0 = (item % 384) * 32;
        const float* W = w_ada + (size_t)l * DM * NMOD + n0 + r31;
        f32x16 acc = zero16(); float pacc = 0.f;
#pragma unroll 4
        for (int ks = 0; ks < 16; ++ks) { const int k0 = kbase + 16 * ks + 8 * h; float w[8];
#pragma unroll
            for (int j = 0; j < 8; ++j) w[j] = ldf(W + (size_t)(k0 + j) * NMOD);
            const float* cp = c_sample + (size_t)r31 * DM + k0; const f32x4 ca = ld4(cp), cb = ld4(cp + 4);
            u32x4 pa; pa.x = pk2(siluf_(ca.x), siluf_(ca.y)); pa.y = pk2(siluf_(ca.z), siluf_(ca.w)); pa.z = pk2(siluf_(cb.x), siluf_(cb.y)); pa.w = pk2(siluf_(cb.z), siluf_(cb.w));
            u32x4 p; p.x = pk2(w[0], w[1]); p.y = pk2(w[2], w[3]); p.z = pk2(w[4], w[5]); p.w = pk2(w[6], w[7]);
            acc = MFMA32(__builtin_bit_cast(bf16x8, pa), __builtin_bit_cast(bf16x8, p), acc);
            const LAS f32x4* cq = (const LAS f32x4*)(cpl + k0); const f32x4 c0 = cq[0], c1 = cq[1];
            pacc += c0.x * w[0] + c0.y * w[1] + c0.z * w[2] + c0.w * w[3] + c1.x * w[4] + c1.y * w[5] + c1.z * w[6] + c1.w * w[7]; }
        pacc += __shfl_xor(pacc, 32);
#pragma unroll
        for (int reg = 0; reg < 16; ++reg) red[(wave * 33 + 1 + crow(reg, h)) * 32 + r31] = acc[reg];
        if (h == 0) red[(wave * 33) * 32 + r31] = pacc;
        __syncthreads();
        for (int i = tid; i < 33 * 32; i += NTHR) { const int r = i >> 5, c = i & 31; float s = 0.f;
#pragma unroll
            for (int w = 0; w < 8; ++w) s += red[(w * 33 + r) * 32 + c];
            stf(MOD + ((size_t)l * 33 + r) * NMOD + n0 + c, s + ldf(b_ada + (size_t)l * NMOD + n0 + c)); }
        __syncthreads();
    }
}
DI void load_gate_w(const float* w_in_l, LAS float* Wg, int tid) {
    for (int i = tid; i < DM * 16; i += NTHR) { const int k = i >> 4, c = i & 15; Wg[c * DM + k] = ldf(w_in_l + (size_t)k * DIN + 3072 + c); }
}
DI void gate_row(const f32x4 (&v)[8], const LAS float* Wg, const float* bgate, float* IG, float* LF, int row, int lane) {
    float p[16];
#pragma unroll
    for (int c = 0; c < 16; ++c) { float a = 0.f;
#pragma unroll
        for (int j = 0; j < 8; ++j) { const f32x4 w = *(const LAS f32x4*)(Wg + c * DM + 256 * j + 4 * lane); a += v[j].x * w.x + v[j].y * w.y + v[j].z * w.z + v[j].w * w.w; }
        p[c] = a; asm volatile("" ::: "memory"); }
    float q[8], r[4], t2[2], t1;
    { const bool hi = (lane & 32) != 0;
#pragma unroll
      for (int i = 0; i < 8; ++i) { const float keep = hi ? p[8 + i] : p[i], send = hi ? p[i] : p[8 + i]; q[i] = keep + __shfl_xor(send, 32); } }
    { const bool hi = (lane & 16) != 0;
#pragma unroll
      for (int i = 0; i < 4; ++i) { const float keep = hi ? q[4 + i] : q[i], send = hi ? q[i] : q[4 + i]; r[i] = keep + __shfl_xor(send, 16); } }
    { const bool hi = (lane & 8) != 0;
#pragma unroll
      for (int i = 0; i < 2; ++i) { const float keep = hi ? r[2 + i] : r[i], send = hi ? r[i] : r[2 + i]; t2[i] = keep + __shfl_xor(send, 8); } }
    { const bool hi = (lane & 4) != 0; const float keep = hi ? t2[1] : t2[0], send = hi ? t2[0] : t2[1]; t1 = keep + __shfl_xor(send, 4); }
    t1 += __shfl_xor(t1, 2); t1 += __shfl_xor(t1, 1);
    if ((lane & 3) == 0) { const int c = (lane >> 2) & 15;
        const float x = t1 + ldf(bgate + c);
        if (c < 8) stf(IG + (size_t)row * 8 + c, x); else stf(LF + (size_t)row * 8 + (c - 8), logsigmoidf_(x)); }
}
DI void modulate_row(const float* xrow, const float* sh, const float* sc, bf16* urow, const LAS float* Wg, const float* bgate, float* IG, float* LF, int row, int lane) {
    f32x4 u[8];
#pragma unroll
    for (int j = 0; j < 8; ++j) { const int col = 4 * lane + 256 * j; const f32x4 v = ld4(xrow + col), a = ld4(sc + col), b = ld4(sh + col);
        u[j] = v * (a + 1.f) + b; u32x2 o; o.x = pk2(u[j].x, u[j].y); o.y = pk2(u[j].z, u[j].w); st8(urow + col, o); }
    gate_row(u, Wg, bgate, IG, LF, row, lane);
}
DI void ln_row(const float* yrow, const float* slab, int nslab, const float* res, const float* gate, const float* g, const float* b, float* xo, const float* sh, const float* sc, bf16* urow,
               const LAS float* Wg, bool gates, const float* bgate, float* IG, float* LF, int row, int lane) {
    f32x4 v[8]; float s = 0.f;
    if (yrow) {
#pragma unroll
        for (int j = 0; j < 8; ++j) v[j] = ld4(yrow + 4 * lane + 256 * j);
    } else {
#pragma unroll
        for (int j = 0; j < 8; ++j) { const int col = 4 * lane + 256 * j; f32x4 a = ld4(slab + col);
            for (int q = 1; q < nslab; ++q) a += ld4(slab + (size_t)q * NSMP * DM + col);
            v[j] = ld4(res + col) * ALPHA_RES + (ld4(gate + col) + 1.f) * a; }
    }
#pragma unroll
    for (int j = 0; j < 8; ++j) s += (v[j].x + v[j].y) + (v[j].z + v[j].w);
    const float mean = wave_sum(s) * (1.f / DM); float s2 = 0.f;
#pragma unroll
    for (int j = 0; j < 8; ++j) { v[j] = v[j] - mean; s2 += (v[j].x * v[j].x + v[j].y * v[j].y) + (v[j].z * v[j].z + v[j].w * v[j].w); }
    const float rstd = 1.f / sqrtf(wave_sum(s2) * (1.f / DM) + 1e-5f);
#pragma unroll
    for (int j = 0; j < 8; ++j) { const int col = 4 * lane + 256 * j; const f32x4 gg = ld4(g + col), bb = ld4(b + col); const f32x4 o = v[j] * rstd * gg + bb; st4(xo + col, o);
        if (urow) { const f32x4 a = ld4(sc + col), c = ld4(sh + col); v[j] = o * (a + 1.f) + c; u32x2 w; w.x = pk2(v[j].x, v[j].y); w.y = pk2(v[j].z, v[j].w); st8(urow + col, w); } }
    if (gates) gate_row(v, Wg, bgate, IG, LF, row, lane);
}
#define XB_TMO      128
#define XB_XCNT(j)  (256  + 64 * (j))
#define XB_XSUB(j)  (1280 + 64 * (j))
#define XB_XGEN(j)  (2304 + 64 * (j))
#define XB_TOP      3328
#define XB_TOPGEN   3392
#define XCD_BAR_WORDS 3456
#define XB_SPIN_CAP (1u << 18)

__device__ __forceinline__ unsigned xb_ld(unsigned* p)              { return __hip_atomic_load(p, __ATOMIC_RELAXED, __HIP_MEMORY_SCOPE_AGENT); }
__device__ __forceinline__ unsigned xb_add(unsigned* p, unsigned v) { return __hip_atomic_fetch_add(p, v, __ATOMIC_RELAXED, __HIP_MEMORY_SCOPE_AGENT); }
__device__ __forceinline__ unsigned xb_xcc_id() { return (unsigned)__builtin_amdgcn_s_getreg((3 << 11) | 20) & 0xFu; }
#define XB_SPIN(cond, bar) do { unsigned _sp = 0; while (cond) { __builtin_amdgcn_s_sleep(1); \
    if ((++_sp & 255u) == 0u) { if (xb_ld(&(bar)[XB_TMO])) break; if (_sp > XB_SPIN_CAP) { atomicAdd(&(bar)[XB_TMO], 1u); break; } } } } while (0)

struct XcdBarrier {
    unsigned* bar; unsigned x;
    volatile LAS unsigned* st;
};

__device__ __forceinline__ XcdBarrier xcd_barrier_post(unsigned* bar, volatile LAS unsigned* st) {
    XcdBarrier b; b.bar = bar; b.x = xb_xcc_id(); b.st = st;
    if (threadIdx.x == 0) (void)xb_add(&bar[XB_XCNT(b.x)], 1u);
    return b;
}
__device__ __forceinline__ void xcd_barrier_complete(unsigned* bar, unsigned x, unsigned& nloc, unsigned& nx) {
    const unsigned G = gridDim.x * gridDim.y * gridDim.z;
    unsigned sum, cnt, mine, sp = 0u;
    for (;;) {
        sum = 0u; cnt = 0u; mine = 0u;
#pragma unroll
        for (unsigned j = 0; j < 16; ++j) { const unsigned c = xb_ld(&bar[XB_XCNT(j)]); sum += c; cnt += (c > 0u) ? 1u : 0u; mine = (j == x) ? c : mine; }
        if (sum == G) break;
        __builtin_amdgcn_s_sleep(1);
        if ((++sp & 255u) == 0u) { if (xb_ld(&bar[XB_TMO])) break; if (sp > XB_SPIN_CAP) { atomicAdd(&bar[XB_TMO], 1u); break; } }
    }
    nloc = mine > 0u ? mine : 1u; nx = cnt > 0u ? cnt : 1u;
}

__device__ __forceinline__ void xcd_barrier(const XcdBarrier& b) {
    asm volatile("s_waitcnt vmcnt(0)" ::: "memory");
    __syncthreads();
    if (threadIdx.x == 0) {
        unsigned* bar = b.bar;
        __builtin_amdgcn_s_waitcnt(0);
        unsigned nloc = b.st[0], nx = b.st[1];
        if (nloc == 0u) { xcd_barrier_complete(bar, b.x, nloc, nx); b.st[0] = nloc; b.st[1] = nx; }
        const unsigned old = xb_add(&bar[XB_XSUB(b.x)], 1u);
        const unsigned gen = old / nloc;
        if (old + 1u == (gen + 1u) * nloc) {
            __builtin_amdgcn_fence(__ATOMIC_RELEASE, "agent");
            asm volatile("s_waitcnt vmcnt(0)" ::: "memory");
            const unsigned og = xb_add(&bar[XB_TOP], 1u);
            const unsigned tg = og / nx;
            if (og + 1u == (tg + 1u) * nx) xb_add(&bar[XB_TOPGEN], 1u);
            else XB_SPIN(xb_ld(&bar[XB_TOPGEN]) == tg, bar);
            __builtin_amdgcn_fence(__ATOMIC_ACQUIRE, "agent");
            xb_add(&bar[XB_XGEN(b.x)], 1u);
            asm volatile("s_waitcnt vmcnt(0)" ::: "memory");
        } else {
            XB_SPIN(xb_ld(&bar[XB_XGEN(b.x)]) == gen, bar);
            __builtin_amdgcn_fence(__ATOMIC_ACQUIRE, "agent");
            asm volatile("s_waitcnt vmcnt(0)" ::: "memory");
        }
    }
    __syncthreads();
}

DI u32x4 pack8(f32x4 a, f32x4 b) { u32x4 w; w.x = pg8::cvt_pk_bf16(a[0], a[1]); w.y = pg8::cvt_pk_bf16(a[2], a[3]); w.z = pg8::cvt_pk_bf16(b[0], b[1]); w.w = pg8::cvt_pk_bf16(b[2], b[3]); return w; }

struct EpiIn {
    static constexpr bool PERM = true, AFTER_DRAIN = false;
    unsigned char* wsb; float* outb; int l;
    DI void operator()(const f32x4 (&acc)[2][2][4][2], const pg8::Unit& u, int wr, int wc, int fr, int fq) const {
        bf16* P = (bf16*)(wsb + WS_P); const float* cosT = (const float*)(wsb + WS_ROPE); const float* sinT = cosT + 8200 * 64;
        float* kp = outb + O_KP + (size_t)l * 2048 * 1024; float* vp = outb + O_VP + (size_t)l * 2048 * 1024; float* ks = outb + O_KS + (size_t)l * NSMP * 1024; float* vs = outb + O_VS + (size_t)l * NSMP * 1024;
        const int pn = u.pn, rowb = u.pm * 256 + wr * 64 + fr;
        if (pn < 12 || pn >= 20) {
            const float sc = (pn == 2 || pn == 3) ? 0.125f : 1.f;
            const int colP = (pn < 12 ? pn * 256 : 5120 + (pn - 20) * 256) + wc * 32 + 8 * fq;
#pragma unroll
            for (int ai = 0; ai < 2; ++ai)
#pragma unroll
                for (int m = 0; m < 4; ++m) { const int row = rowb + ai * 128 + m * 16; bf16* rp = P + (size_t)row * PW + colP;
                    float* o = nullptr;
                    if (pn >= 20) { if (row >= SEQ) o = vs + (size_t)(row - SEQ) * 1024; else if (row >= SEQ - 2048) o = vp + (size_t)(row - (SEQ - 2048)) * 1024; }
#pragma unroll
                    for (int bj = 0; bj < 2; ++bj) { st16(rp + bj * 128, pack8(acc[ai][bj][m][0] * sc, acc[ai][bj][m][1] * sc));
                        if (o) { float* oc = o + (pn - 20) * 256 + bj * 128 + wc * 32 + 8 * fq; st4(oc, acc[ai][bj][m][0]); st4(oc + 4, acc[ai][bj][m][1]); } } }
        } else {
            const bool isq = pn < 16; const int tile = (pn - 12) & 3, head = 2 * tile + (wc >> 1), i0 = 32 * (wc & 1) + 8 * fq;
            const float qs = isq ? QSCALE : 1.f;
            const int colP = (isq ? 3072 : 4096) + head * 128 + i0;
#pragma unroll
            for (int ai = 0; ai < 2; ++ai)
#pragma unroll
                for (int m = 0; m < 4; ++m) { const int row = rowb + ai * 128 + m * 16; const int pos = row < SEQ ? row : SEQ + ((row - SEQ) & 7);
                    const f32x4 c0 = ld4(cosT + pos * 64 + i0), c1 = ld4(cosT + pos * 64 + i0 + 4), s0 = ld4(sinT + pos * 64 + i0), s1 = ld4(sinT + pos * 64 + i0 + 4);
                    const f32x4 x1a = acc[ai][0][m][0], x1b = acc[ai][0][m][1], x2a = acc[ai][1][m][0], x2b = acc[ai][1][m][1];
                    const f32x4 o1a = (x1a * c0 - x2a * s0) * qs, o1b = (x1b * c1 - x2b * s1) * qs, o2a = (x2a * c0 + x1a * s0) * qs, o2b = (x2b * c1 + x1b * s1) * qs;
                    bf16* rp = P + (size_t)row * PW + colP; st16(rp, pack8(o1a, o1b)); st16(rp + 64, pack8(o2a, o2b));
                    if (!isq) { float* o = nullptr; if (row >= SEQ) o = ks + (size_t)(row - SEQ) * 1024; else if (row >= SEQ - 2048) o = kp + (size_t)(row - (SEQ - 2048)) * 1024;
                        if (o) { o += head * 128 + i0; st4(o, o1a); st4(o + 4, o1b); st4(o + 64, o2a); st4(o + 68, o2b); } }
                    asm volatile("" ::: "memory"); }
        }
    }
};
struct EpiRes {
    static constexpr bool PERM = false, AFTER_DRAIN = false;
    float* Y; const float* resP; const float* gate; float* slab;
    DI void operator()(const f32x4 (&acc)[2][2][4][2], const pg8::Unit& u, int wr, int wc, int fr, int fq) const {
        const int rowb = u.pm * 256 + wr * 64 + fr, col0 = u.pn * 256 + wc * 32 + 4 * fq;
        if (u.pm >= 32) {
#pragma unroll
            for (int ai = 0; ai < 2; ++ai)
#pragma unroll
                for (int m = 0; m < 4; ++m) { float* sp = slab + ((size_t)u.ks * NSMP + (wr * 64 + fr + ai * 128 + m * 16)) * DM + col0;
#pragma unroll
                    for (int bj = 0; bj < 2; ++bj)
#pragma unroll
                        for (int n = 0; n < 2; ++n) st4(sp + bj * 128 + n * 16, acc[ai][bj][m][n]); }
            return;
        }
#pragma unroll
        for (int ai = 0; ai < 2; ++ai)
#pragma unroll
            for (int m = 0; m < 4; ++m) { const int row = rowb + ai * 128 + m * 16;
                const float* res = resP + (size_t)row * DM; const float* gp = gate; float* yp = Y + (size_t)row * DM;
#pragma unroll
                for (int bj = 0; bj < 2; ++bj)
#pragma unroll
                    for (int n = 0; n < 2; ++n) { const int col = col0 + bj * 128 + n * 16; const f32x4 r = ld4(res + col), g = ld4(gp + col);
                        st4(yp + col, r * ALPHA_RES + (g + 1.f) * acc[ai][bj][m][n]); }
                asm volatile("" ::: "memory"); }
    }
};
struct EpiUp {
    static constexpr bool PERM = true, AFTER_DRAIN = false;
    bf16* GV; float* bp; float* bs;
    DI void operator()(const f32x4 (&acc)[2][2][4][2], const pg8::Unit& u, int wr, int wc, int fr, int fq) const {
        const int rowb = u.pm * 256 + wr * 64 + fr, colb = u.pn * 256 + wc * 32 + 8 * fq;
#pragma unroll
        for (int ai = 0; ai < 2; ++ai)
#pragma unroll
            for (int m = 0; m < 4; ++m) { const int row = rowb + ai * 128 + m * 16; bf16* rp = GV + (size_t)row * NUP + colb;
                float* o = nullptr;
                if (u.pn < 22) { if (row < SEQ) { if (row >= SEQ - 2) o = bp + (size_t)(row - (SEQ - 2)) * DFF; } else { const int t = (row - SEQ) & 7; if (t >= 6) o = bs + ((size_t)((row - SEQ) >> 3) * 2 + (t - 6)) * DFF; } }
#pragma unroll
                for (int bj = 0; bj < 2; ++bj) { st16(rp + bj * 128, pack8(acc[ai][bj][m][0], acc[ai][bj][m][1]));
                    if (o) { st4(o + colb + bj * 128, acc[ai][bj][m][0]); st4(o + colb + bj * 128 + 4, acc[ai][bj][m][1]); } } }
    }
};

constexpr int VPITCH = 272, KPITCH = 144;

DI void attn_prompt_unit(const bf16* P, bf16* OP, float* ML, int u, LAS unsigned char* lds, unsigned ldsbase, int wave, int lane) {
    const int br = u >> 8, rem = u & 255, head = rem >> 5, blk = rem & 31;
    const int ld = 2 * br;
    const int sb = blk * 8 + wave, nbl = 8 - ld;
    const int r = sb >> nbl, u0 = (sb & ((1 << nbl) - 1)) << 5;
    const int r31 = lane & 31, h = lane >> 5;
    const unsigned vt = ldsbase + (unsigned)wave * (32 * VPITCH); LAS unsigned char* vtp = lds + wave * (32 * VPITCH);
    const int tokq = ((u0 + r31) << ld) + r;
    bf16x8 Qf[8];
    { const bf16* qp = P + (size_t)tokq * PW + 3072 + head * 128 + 8 * h;
#pragma unroll
      for (int ks = 0; ks < 8; ++ks) Qf[ks] = ldfrag(qp + 16 * ks); }
    f32x16 O[4];
#pragma unroll
    for (int d = 0; d < 4; ++d) O[d] = zero16();
    float mrun = -1e30f, lrun = 0.f;
    for (int jt = 0; jt < 5; ++jt) {
        const int ub = u0 - 128 + 32 * jt;
        if (ub < 0) continue;
        const bf16* kp = P + (size_t)(((ub + r31) << ld) + r) * PW + 4096 + head * 128 + 8 * h;
        bf16x8 Kf[8];
#pragma unroll
        for (int ks = 0; ks < 8; ++ks) Kf[ks] = ldfrag(kp + 16 * ks);
        u32x4 vst[8];
#pragma unroll
        for (int i = 0; i < 8; ++i) { const int row = 4 * i + (lane >> 4), ch = lane & 15; vst[i] = ld16(P + (size_t)(((ub + row) << ld) + r) * PW + 5120 + head * 128 + ch * 8); }
        f32x16 S = zero16();
#pragma unroll
        for (int ks = 0; ks < 8; ++ks) S = MFMA32(Kf[ks], Qf[ks], S);
#pragma unroll
        for (int i = 0; i < 8; ++i) { const int row = 4 * i + (lane >> 4), ch = lane & 15; *(LAS u32x4*)(vtp + row * VPITCH + ch * 16) = vst[i]; }
        float tmax = -INFINITY;
#pragma unroll
        for (int reg = 0; reg < 16; ++reg) { const int kk = crow(reg, h); const bool ok = (jt == 0) ? (kk >= r31) : ((jt == 4) ? (kk <= r31) : true);
            S[reg] = ok ? S[reg] : -INFINITY; tmax = fmaxf(tmax, S[reg]); }
        tmax = fmaxf(tmax, __shfl_xor(tmax, 32));
        const float mnew = fmaxf(mrun, tmax), alpha = fexp2(mrun - mnew); mrun = mnew;
        float psum = 0.f;
#pragma unroll
        for (int reg = 0; reg < 16; ++reg) { S[reg] = fexp2(S[reg] - mnew); psum += S[reg]; }
        psum += __shfl_xor(psum, 32);
        lrun = lrun * alpha + psum;
#pragma unroll
        for (int d = 0; d < 4; ++d) O[d] = O[d] * alpha;
        const bf16x8 P0 = pack_step(S, 0), P1 = pack_step(S, 1);
        LDS_WAIT();
#pragma unroll
        for (int d = 0; d < 4; ++d) {
            const bf16x8 A0 = tr_pair(vt, VPITCH, 4 * h, 8 + 4 * h, 32 * d, lane);
            O[d] = MFMA32(A0, P0, O[d]);
            const bf16x8 A1 = tr_pair(vt, VPITCH, 16 + 4 * h, 24 + 4 * h, 32 * d, lane);
            O[d] = MFMA32(A1, P1, O[d]);
        }
    }
    const float inv = 1.f / lrun;
    bf16* op = OP + ((size_t)br * SEQ + tokq) * 1024 + head * 128;
#pragma unroll
    for (int d = 0; d < 4; ++d)
#pragma unroll
        for (int g = 0; g < 4; ++g) { u32x2 w; w.x = pk2(O[d][4 * g] * inv, O[d][4 * g + 1] * inv); w.y = pk2(O[d][4 * g + 2] * inv, O[d][4 * g + 3] * inv); st8(op + 32 * d + 8 * g + 4 * h, w); }
    if (h == 0) { float* mp = ML + (((size_t)br * SEQ + tokq) * 8 + head) * 2; stf(mp, mrun); stf(mp + 1, lrun); }
}

DI void mlstm_m1_item(const bf16* P, const float* IG, const float* LF, float* SCAL, float* DCT, int it, LAS unsigned char* lds, unsigned ldsbase, int wave, int lane) {
    const int half = wave >> 2, wq = wave & 3, unit = it * 2 + half, c = unit >> 3, hd = unit & 7, row0 = c * LCH;
    const int hoff = half * 32768;
    LAS unsigned char* Vt = lds + hoff; LAS unsigned char* Kt = lds + hoff + 64 * VPITCH; LAS float* sc = (LAS float*)(lds + hoff + 64 * VPITCH + 64 * KPITCH);
    const int r31 = lane & 31, h = lane >> 5, t256 = wq * 64 + lane;
    if (wq == 0) {
        const float lf = ldf(LF + (size_t)(row0 + lane) * 8 + hd), ig = ldf(IG + (size_t)(row0 + lane) * 8 + hd);
        float b = lf;
#pragma unroll
        for (int o = 1; o < 64; o <<= 1) { const float t = __shfl_up(b, o); if (lane >= o) b += t; }
        const float d = ig - b; float pm = d;
#pragma unroll
        for (int o = 1; o < 64; o <<= 1) { const float t = __shfl_up(pm, o); if (lane >= o) pm = fmaxf(pm, t); }
        const float pm63 = __shfl(pm, 63);
        sc[lane] = fexp(d - pm63);
        float* sp = SCAL + (size_t)unit * 192; stf(sp + lane, b); stf(sp + 64 + lane, d); stf(sp + 128 + lane, pm);
    }
#pragma unroll
    for (int i = 0; i < 4; ++i) { const int id = i * 256 + t256, row = id >> 4, ch = id & 15;
        *(LAS u32x4*)(Vt + row * VPITCH + ch * 16) = ld16(P + (size_t)(row0 + row) * PW + 1024 + hd * 128 + ch * 8); }
    __syncthreads();
#pragma unroll
    for (int i = 0; i < 2; ++i) { const int id = i * 256 + t256, row = id >> 3, ch = id & 7; const float w = sc[row];
        const u32x4 kv = ld16(P + (size_t)(row0 + row) * PW + 512 + hd * 64 + ch * 8); u32x4 o;
        o.x = pk2(bflo(kv.x) * w, bfhi(kv.x) * w); o.y = pk2(bflo(kv.y) * w, bfhi(kv.y) * w); o.z = pk2(bflo(kv.z) * w, bfhi(kv.z) * w); o.w = pk2(bflo(kv.w) * w, bfhi(kv.w) * w);
        *(LAS u32x4*)(Kt + row * KPITCH + ch * 16) = o; }
    __syncthreads();
    f32x16 a0 = zero16(), a1 = zero16();
    const unsigned vtb = ldsbase + hoff, ktb = ldsbase + hoff + 64 * VPITCH;
#pragma unroll
    for (int ks = 0; ks < 4; ++ks) {
        const bf16x8 A = tr_pair(vtb, VPITCH, 16 * ks + 8 * h, 16 * ks + 8 * h + 4, 32 * wq, lane);
        const bf16x8 B0 = tr_pair(ktb, KPITCH, 16 * ks + 8 * h, 16 * ks + 8 * h + 4, 0, lane);
        const bf16x8 B1 = tr_pair(ktb, KPITCH, 16 * ks + 8 * h, 16 * ks + 8 * h + 4, 32, lane);
        a0 = MFMA32(A, B0, a0); a1 = MFMA32(A, B1, a1);
    }
    float* dp = DCT + (size_t)unit * (129 * 64);
#pragma unroll
    for (int reg = 0; reg < 16; ++reg) { const int dv = 32 * wq + crow(reg, h); stf(dp + dv * 64 + r31, a0[reg]); stf(dp + dv * 64 + 32 + r31, a1[reg]); }
    if (wq == 1) { float s = 0.f;
#pragma unroll 8
        for (int r = 0; r < 64; ++r) s += bf2f(*(const LAS unsigned short*)(Kt + r * KPITCH + lane * 2));
        stf(dp + 128 * 64 + lane, s); }
    __syncthreads();
}

DI void mlstm_m2(const float* SCAL, const float* DCT, bf16* CST, float* MST, float* outC, float* outN, float* outM, int e) {
    const int hd = e / 8256, idx = e % 8256;
    float C = 0.f, m = 0.f;
#pragma unroll 4
    for (int c = 0; c < NCH; ++c) {
        const int unit = c * 8 + hd;
        const float Bc = ldf(SCAL + (size_t)unit * 192 + 63), pmc = ldf(SCAL + (size_t)unit * 192 + 191), Ac = Bc + pmc;
        const float dc = ldf(DCT + (size_t)unit * 8256 + idx);
        const float mn = fmaxf(Bc + m, Ac), f1 = fexp(Bc + m - mn), f2 = fexp(Ac - mn);
        *(GAS unsigned short*)(CST + (size_t)unit * (160 * 64) + idx) = (unsigned short)f2bf(C);
        if (idx == 0) stf(MST + unit, m);
        C = f1 * C + f2 * dc; m = mn;
    }
    const int row = idx >> 6, dk = idx & 63;
    if (row < 128) stf(outC + (size_t)hd * 8192 + dk * 128 + row, C); else stf(outN + hd * 64 + dk, C);
    if (idx == 0) stf(outM + hd, m);
}
DI void attn_combine(const bf16* OP, const float* ML, bf16* CAT, int e) {
    const int tok = e >> 7, c8 = e & 127, head = c8 >> 4;
    float m[3], l[3];
#pragma unroll
    for (int b = 0; b < 3; ++b) { const float* mp = ML + (((size_t)b * SEQ + tok) * 8 + head) * 2; m[b] = ldf(mp); l[b] = ldf(mp + 1); }
    const float M = fmaxf(m[0], fmaxf(m[1], m[2]));
    float w[3], ws = 0.f;
#pragma unroll
    for (int b = 0; b < 3; ++b) { w[b] = fexp2(m[b] - M) * l[b]; ws += w[b]; }
    const float inv = 1.f / ws; float o[8];
#pragma unroll
    for (int j = 0; j < 8; ++j) o[j] = 0.f;
#pragma unroll
    for (int b = 0; b < 3; ++b) { const u32x4 v = ld16(OP + ((size_t)b * SEQ + tok) * 1024 + c8 * 8); const float wb = w[b] * inv;
        o[0] += wb * bflo(v.x); o[1] += wb * bfhi(v.x); o[2] += wb * bflo(v.y); o[3] += wb * bfhi(v.y); o[4] += wb * bflo(v.z); o[5] += wb * bfhi(v.z); o[6] += wb * bflo(v.w); o[7] += wb * bfhi(v.w); }
    u32x4 r; r.x = pk2(o[0], o[1]); r.y = pk2(o[2], o[3]); r.z = pk2(o[4], o[5]); r.w = pk2(o[6], o[7]);
    st16(CAT + (size_t)tok * DM + 1024 + c8 * 8, r);
}

DI void mlstm_m3_item(const bf16* P, const float* SCAL, const bf16* CST, const float* MST, const float* ghead, bf16* CAT, int it, LAS unsigned char* lds, unsigned ldsbase, int wave, int lane) {
    const int slot = wave >> 1, tw = wave & 1, unit = it * 4 + slot, c = unit >> 3, hd = unit & 7, row0 = c * LCH;
    const int r31 = lane & 31, h = lane >> 5, t = 32 * tw + r31;
    LAS unsigned char* Vt = lds + slot * (64 * VPITCH); const unsigned vtb = ldsbase + slot * (64 * VPITCH);
    { const int t128 = tw * 64 + lane;
#pragma unroll
      for (int i = 0; i < 8; ++i) { const int id = i * 128 + t128, row = id >> 4, ch = id & 15;
          *(LAS u32x4*)(Vt + row * VPITCH + ch * 16) = ld16(P + (size_t)(row0 + row) * PW + 1024 + hd * 128 + ch * 8); } }
    const float* sp = SCAL + (size_t)unit * 192;
    const float mc = ldf(MST + unit), bt = ldf(sp + t), pmt = ldf(sp + 128 + t);
    const float Mt = fmaxf(mc, pmt), gt = fexp(mc - Mt);
    bf16x8 Qf[4], Qg[4];
    { const bf16* qp = P + (size_t)(row0 + t) * PW + hd * 64 + 8 * h;
#pragma unroll
      for (int ks = 0; ks < 4; ++ks) { const u32x4 q = ld16(qp + 16 * ks); Qf[ks] = __builtin_bit_cast(bf16x8, q); u32x4 g;
          g.x = pk2(bflo(q.x) * gt, bfhi(q.x) * gt); g.y = pk2(bflo(q.y) * gt, bfhi(q.y) * gt); g.z = pk2(bflo(q.z) * gt, bfhi(q.z) * gt); g.w = pk2(bflo(q.w) * gt, bfhi(q.w) * gt); Qg[ks] = __builtin_bit_cast(bf16x8, g); } }
    f32x16 acc[5];
#pragma unroll
    for (int d = 0; d < 5; ++d) acc[d] = zero16();
    { const bf16* cp = CST + (size_t)unit * (160 * 64) + (size_t)r31 * 64 + 8 * h;
#pragma unroll
      for (int d = 0; d < 5; ++d)
#pragma unroll
          for (int ks = 0; ks < 4; ++ks) acc[d] = MFMA32(ldfrag(cp + d * 32 * 64 + 16 * ks), Qg[ks], acc[d]); }
    __syncthreads();
    float rowsum = 0.f;
    for (int st = 0; st <= tw; ++st) {
        const bf16* kp = P + (size_t)(row0 + 32 * st + r31) * PW + 512 + hd * 64 + 8 * h;
        f32x16 S = zero16();
#pragma unroll
        for (int ks = 0; ks < 4; ++ks) S = MFMA32(ldfrag(kp + 16 * ks), Qf[ks], S);
#pragma unroll
        for (int g = 0; g < 4; ++g) { const f32x4 dv = ld4(sp + 64 + 32 * st + 8 * g + 4 * h);
#pragma unroll
            for (int e = 0; e < 4; ++e) { const int kk = 8 * g + 4 * h + e; const bool ok = (st < tw) || (kk <= r31);
                const float p = ok ? S[4 * g + e] * fexp(dv[e] - Mt) : 0.f; S[4 * g + e] = p; rowsum += p; } }
        const bf16x8 P0 = pack_step(S, 0), P1 = pack_step(S, 1);
#pragma unroll
        for (int d = 0; d < 4; ++d) {
            const bf16x8 A0 = tr_pair(vtb, VPITCH, 32 * st + 4 * h, 32 * st + 8 + 4 * h, 32 * d, lane);
            acc[d] = MFMA32(A0, P0, acc[d]);
            const bf16x8 A1 = tr_pair(vtb, VPITCH, 32 * st + 16 + 4 * h, 32 * st + 24 + 4 * h, 32 * d, lane);
            acc[d] = MFMA32(A1, P1, acc[d]);
        }
    }
    rowsum += __shfl_xor(rowsum, 32);
    const float qn = __shfl(acc[4][0], r31);
    const float den = qn + rowsum, dn = fmaxf(fabsf(den), fexp(-(bt + Mt))), inv = 1.f / dn;
    float ss = 0.f;
#pragma unroll
    for (int d = 0; d < 4; ++d)
#pragma unroll
        for (int reg = 0; reg < 16; ++reg) { acc[d][reg] *= inv; ss += acc[d][reg] * acc[d][reg]; }
    ss += __shfl_xor(ss, 32);
    const float rn = 1.f / sqrtf(ss * (1.f / 128.f) + 1e-6f);
    const bf16* omp = P + (size_t)(row0 + t) * PW + 2048 + hd * 128; bf16* cp = CAT + (size_t)(row0 + t) * DM + hd * 128;
#pragma unroll
    for (int d = 0; d < 4; ++d)
#pragma unroll
        for (int g = 0; g < 4; ++g) { const int dv0 = 32 * d + 8 * g + 4 * h; const f32x4 gh = ld4(ghead + hd * 128 + dv0); const u32x2 om = ld8(omp + dv0);
            const float o0 = acc[d][4 * g] * rn * gh.x * sigmoidf_(bflo(om.x)), o1 = acc[d][4 * g + 1] * rn * gh.y * sigmoidf_(bfhi(om.x));
            const float o2 = acc[d][4 * g + 2] * rn * gh.z * sigmoidf_(bflo(om.y)), o3 = acc[d][4 * g + 3] * rn * gh.w * sigmoidf_(bfhi(om.y));
            u32x2 w; w.x = pk2(o0, o1); w.y = pk2(o2, o3); st8(cp + dv0, w); }
    __syncthreads();
}

DI void sample_mlstm_unit(const bf16* P, const float* IG, const float* LF, const float* C0g, const float* n0g, const float* m0g, const float* ghead, bf16* CAT,
                          float* outC, float* outN, float* outM, int b, int hd, LAS unsigned char* lds, int tid, int wave, int lane) {
    LAS float* q = (LAS float*)lds;
    LAS float* k = q + 512;
    LAS float* v = k + 512;
    LAS float* S = v + 1024;
    LAS float* sb = S + 64;
    LAS float* sd = sb + 8;
    LAS float* sM = sd + 8;
    LAS float* sg = sM + 8;
    LAS float* sqn = sg + 8;
    LAS float* sdi = sqn + 8;
    LAS float* sss = sdi + 8;
    LAS float* skw = sss + 16;
    const int R0 = SEQ + 8 * b;
    { const int t = tid >> 6, dk = tid & 63;
      q[tid] = bf2f(*(const GAS unsigned short*)(P + (size_t)(R0 + t) * PW + hd * 64 + dk));
      k[tid] = bf2f(*(const GAS unsigned short*)(P + (size_t)(R0 + t) * PW + 512 + hd * 64 + dk));
#pragma unroll
      for (int i = 0; i < 2; ++i) { const int e = tid + 512 * i, tt = e >> 7, dv = e & 127; v[e] = bf2f(*(const GAS unsigned short*)(P + (size_t)(R0 + tt) * PW + 1024 + hd * 128 + dv)); } }
    const float m0 = ldf(m0g);
    if (wave == 0) {
        const int tt = lane & 7;
        const float lf = ldf(LF + (size_t)(R0 + tt) * 8 + hd), ig = ldf(IG + (size_t)(R0 + tt) * 8 + hd);
        float bb = lf;
#pragma unroll
        for (int o = 1; o < 8; o <<= 1) { const float x = __shfl_up(bb, o, 8); if (tt >= o) bb += x; }
        const float d = ig - bb; float pm = d;
#pragma unroll
        for (int o = 1; o < 8; o <<= 1) { const float x = __shfl_up(pm, o, 8); if (tt >= o) pm = fmaxf(pm, x); }
        if (lane < 8) { const float M = fmaxf(m0, pm); sb[tt] = bb; sd[tt] = d; sM[tt] = M; sg[tt] = fexp(m0 - M); }
    }
    __syncthreads();
    if (tid < 64) { const int t = tid >> 3, s = tid & 7; float a = 0.f;
#pragma unroll 8
        for (int dk = 0; dk < 64; ++dk) a += q[t * 64 + dk] * k[s * 64 + dk];
        S[tid] = (s <= t) ? a * fexp(sd[s] - sM[t]) : 0.f;
    } else if (tid < 128) { const int i = tid - 64, t = i >> 3, part = i & 7; float a = 0.f;
#pragma unroll
        for (int j = 0; j < 8; ++j) a += q[t * 64 + part * 8 + j] * ldf(n0g + part * 8 + j);
        a += __shfl_xor(a, 1); a += __shfl_xor(a, 2); a += __shfl_xor(a, 4);
        if (part == 0) sqn[t] = a;
    }
    { const int s = tid >> 6, dk = tid & 63; skw[tid] = fexp(sd[s] - sM[7]) * k[s * 64 + dk]; }
    __syncthreads();
    if (tid < 8) { float rs = 0.f;
#pragma unroll
        for (int s = 0; s < 8; ++s) rs += S[tid * 8 + s];
        const float den = sg[tid] * sqn[tid] + rs; sdi[tid] = 1.f / fmaxf(fabsf(den), fexp(-(sb[tid] + sM[tid]))); }
    __syncthreads();
    const int dv = tid & 127, tq = tid >> 7;
    float a0 = 0.f, a1 = 0.f;
#pragma unroll 8
    for (int dk = 0; dk < 64; ++dk) { const float c = ldf(C0g + dk * 128 + dv); a0 += q[tq * 64 + dk] * c; a1 += q[(tq + 4) * 64 + dk] * c; }
    float vv[8];
#pragma unroll
    for (int s = 0; s < 8; ++s) vv[s] = v[s * 128 + dv];
    float n0_ = sg[tq] * a0, n1_ = sg[tq + 4] * a1;
#pragma unroll
    for (int s = 0; s < 8; ++s) { n0_ += S[tq * 8 + s] * vv[s]; n1_ += S[(tq + 4) * 8 + s] * vv[s]; }
    const float h0 = n0_ * sdi[tq], h1 = n1_ * sdi[tq + 4];
    const float p0 = wave_sum(h0 * h0), p1 = wave_sum(h1 * h1);
    if (lane == 0) { sss[tq * 2 + (wave & 1)] = p0; sss[(tq + 4) * 2 + (wave & 1)] = p1; }
    __syncthreads();
    { const float r0 = 1.f / sqrtf((sss[tq * 2] + sss[tq * 2 + 1]) * (1.f / 128.f) + 1e-6f), r1 = 1.f / sqrtf((sss[(tq + 4) * 2] + sss[(tq + 4) * 2 + 1]) * (1.f / 128.f) + 1e-6f);
      const float gh = ldf(ghead + hd * 128 + dv);
      const float om0 = bf2f(*(const GAS unsigned short*)(P + (size_t)(R0 + tq) * PW + 2048 + hd * 128 + dv)), om1 = bf2f(*(const GAS unsigned short*)(P + (size_t)(R0 + tq + 4) * PW + 2048 + hd * 128 + dv));
      *(GAS unsigned short*)(CAT + (size_t)(R0 + tq) * DM + hd * 128 + dv) = (unsigned short)f2bf(h0 * r0 * gh * sigmoidf_(om0));
      *(GAS unsigned short*)(CAT + (size_t)(R0 + tq + 4) * DM + hd * 128 + dv) = (unsigned short)f2bf(h1 * r1 * gh * sigmoidf_(om1)); }
    const float gend = sg[7];
#pragma unroll 4
    for (int j = 0; j < 16; ++j) { const int dk = 16 * tq + j; float c = gend * ldf(C0g + dk * 128 + dv);
#pragma unroll
        for (int s = 0; s < 8; ++s) c += skw[s * 64 + dk] * vv[s];
        stf(outC + dk * 128 + dv, c); }
    if (tid < 64) { float n = gend * ldf(n0g + tid);
#pragma unroll
        for (int s = 0; s < 8; ++s) n += skw[s * 64 + tid];
        stf(outN + tid, n); }
    if (tid == 0) stf(outM, sb[7] + sM[7]);
    __syncthreads();
}

DI int sa_slot_idx(int tile, int s) {
    if (tile < 24) { const int sl = tile * 32 + s; return (sl >> 3) * 16 + (sl & 7); }
    if (tile < 40) return 1536 + (tile - 24) * 32 + s;
    return s < 8 ? 2048 + s : -1;
}
DI void sample_attn_unit(const bf16* P, const float* ck, const float* cv, bf16* CAT, int b, int head, LAS unsigned char* lds, unsigned ldsbase, int tid, int wave, int lane0) {
    const int lane = lane0, r31 = lane & 31, h = lane >> 5, R0 = SEQ + 8 * b;
    LAS unsigned char* vtp = lds + wave * (32 * VPITCH); const unsigned vt = ldsbase + (unsigned)wave * (32 * VPITCH);
    LAS float* Ow = (LAS float*)(lds + 73728);
    LAS float* Mw = (LAS float*)(lds + 73728 + 32768);
    LAS float* Lw = Mw + 64;
    bf16x8 Qf[8];
    { const bf16* qp = P + (size_t)(R0 + (r31 & 7)) * PW + 3072 + head * 128 + 8 * h;
#pragma unroll
      for (int ks = 0; ks < 8; ++ks) { u32x4 q = ld16(qp + 16 * ks); if (r31 >= 8) q = (u32x4){0u, 0u, 0u, 0u}; Qf[ks] = __builtin_bit_cast(bf16x8, q); } }
    f32x16 O[4];
#pragma unroll
    for (int d = 0; d < 4; ++d) O[d] = zero16();
    float mrun = -1e30f, lrun = 0.f;
    const float* ckb = ck + (size_t)b * 2048 * 1024 + head * 128; const float* cvb = cv + (size_t)b * 2048 * 1024 + head * 128;
    for (int tile = wave; tile < 41; tile += 8) {
        int lq = lane; asm volatile("" : "+v"(lq));
        const int r31 = lq & 31, h = lq >> 5, lane = lq;
        f32x16 S = zero16();
        if (tile < 40) {
            const float* kp = ckb + (size_t)sa_slot_idx(tile, r31) * 1024 + 8 * h;
#pragma unroll
            for (int ks = 0; ks < 8; ++ks) { const f32x4 a = ld4(kp + 16 * ks), c = ld4(kp + 16 * ks + 4);
                u32x4 w; w.x = pk2(a.x, a.y); w.y = pk2(a.z, a.w); w.z = pk2(c.x, c.y); w.w = pk2(c.z, c.w); S = MFMA32(__builtin_bit_cast(bf16x8, w), Qf[ks], S);
                if (ks == 3) asm volatile("" ::: "memory"); }
            asm volatile("" ::: "memory");
#pragma unroll
            for (int i = 0; i < 16; ++i) { const int id = i * 64 + lane, row = id >> 5, c4 = id & 31; const f32x4 v = ld4(cvb + (size_t)sa_slot_idx(tile, row) * 1024 + 4 * c4);
                u32x2 w; w.x = pk2(v.x, v.y); w.y = pk2(v.z, v.w); *(LAS u32x2*)(vtp + row * VPITCH + c4 * 8) = w;
                if ((i & 7) == 7) asm volatile("" ::: "memory"); }
        } else {
            const bf16* kp = P + (size_t)(R0 + (r31 & 7)) * PW + 4096 + head * 128 + 8 * h;
#pragma unroll
            for (int ks = 0; ks < 8; ++ks) { u32x4 w = ld16(kp + 16 * ks); if (r31 >= 8) w = (u32x4){0u, 0u, 0u, 0u}; S = MFMA32(__builtin_bit_cast(bf16x8, w), Qf[ks], S); }
#pragma unroll
            for (int i = 0; i < 8; ++i) { const int id = i * 64 + lane, row = id >> 4, ch = id & 15; u32x4 w = ld16(P + (size_t)(R0 + (row & 7)) * PW + 5120 + head * 128 + ch * 8); if (row >= 8) w = (u32x4){0u, 0u, 0u, 0u};
                *(LAS u32x4*)(vtp + row * VPITCH + ch * 16) = w; }
        }
        float tmax = -INFINITY;
#pragma unroll
        for (int reg = 0; reg < 16; ++reg) { const int idx = sa_slot_idx(tile, crow(reg, h)); const int dist = 2048 + r31 - idx;
            int mult = 0;
            if (idx >= 0 && r31 < 8 && dist >= 0) mult = (dist <= 128 ? 1 : 0) + (((dist & 3) == 0 && dist <= 512) ? 1 : 0) + (((dist & 15) == 0 && dist <= 2048) ? 1 : 0);
            if (mult) tmax = fmaxf(tmax, S[reg]);
            const float lm = mult == 3 ? 1.5849625f : (mult == 2 ? 1.f : 0.f);
            S[reg] = mult ? S[reg] + lm : -INFINITY; }
        tmax = fmaxf(tmax, __shfl_xor(tmax, 32));
        const float mnew = fmaxf(mrun, tmax), alpha = fexp2(mrun - mnew); mrun = mnew;
        float psum = 0.f;
#pragma unroll
        for (int reg = 0; reg < 16; ++reg) { S[reg] = fexp2(S[reg] - mnew); psum += S[reg]; }
        psum += __shfl_xor(psum, 32);
        lrun = lrun * alpha + psum;
#pragma unroll
        for (int d = 0; d < 4; ++d) O[d] = O[d] * alpha;
        const bf16x8 P0 = pack_step(S, 0), P1 = pack_step(S, 1);
        LDS_WAIT();
#pragma unroll
        for (int d = 0; d < 4; ++d) {
            const bf16x8 A0 = tr_pair(vt, VPITCH, 4 * h, 8 + 4 * h, 32 * d, lane);
            O[d] = MFMA32(A0, P0, O[d]);
            const bf16x8 A1 = tr_pair(vt, VPITCH, 16 + 4 * h, 24 + 4 * h, 32 * d, lane);
            O[d] = MFMA32(A1, P1, O[d]);
        }
    }
    if (r31 < 8) {
#pragma unroll
        for (int d = 0; d < 4; ++d)
#pragma unroll
            for (int reg = 0; reg < 16; ++reg) Ow[(wave * 8 + r31) * 128 + 32 * d + crow(reg, h)] = O[d][reg];
        if (h == 0) { Mw[wave * 8 + r31] = mrun; Lw[wave * 8 + r31] = lrun; }
    }
    __syncthreads();
#pragma unroll
    for (int i = 0; i < 2; ++i) { const int e = tid + 512 * i, t = e >> 7, d = e & 127; float M = -1e30f;
#pragma unroll
        for (int w = 0; w < 8; ++w) M = fmaxf(M, Mw[w * 8 + t]);
        float num = 0.f, den = 0.f;
#pragma unroll
        for (int w = 0; w < 8; ++w) { const float f = fexp2(Mw[w * 8 + t] - M); num += f * Ow[(w * 8 + t) * 128 + d]; den += f * Lw[w * 8 + t]; }
        *(GAS unsigned short*)(CAT + (size_t)(R0 + t) * DM + 1024 + head * 128 + d) = (unsigned short)f2bf(num / den); }
    __syncthreads();
}

DI void sample_attn_unit_v1(const bf16* P, const float* ck, const float* cv, bf16* CAT, int b, int head, LAS unsigned char* lds, int wave, int lane) {
    LAS float* sc = (LAS float*)lds + wave * 136;
    const int t = wave, half = lane >> 5, r31 = lane & 31, R0 = SEQ + 8 * b;
    f32x4 q;
    { const u32x2 w = ld8(P + (size_t)(R0 + t) * PW + 3072 + head * 128 + 4 * r31); q.x = bflo(w.x); q.y = bfhi(w.x); q.z = bflo(w.y); q.w = bfhi(w.y); }
    float Mr = -1e30f, Lr = 0.f; f32x4 Ar = {0.f, 0.f, 0.f, 0.f};
    const float* ckb = ck + (size_t)b * 2048 * 1024 + head * 128 + 4 * r31; const float* cvb = cv + (size_t)b * 2048 * 1024 + head * 128 + 4 * r31;
    for (int br = 0; br < 3; ++br) {
        const int ld = 2 * br;
#pragma unroll 5
        for (int jj = 0; jj < 65; ++jj) { const int j = 2 * jj + half; const bool ok = j <= 128; const int idx = 2048 + t - ((ok ? j : 0) << ld);
            f32x4 kv;
            if (idx >= 2048) { const u32x2 w = ld8(P + (size_t)(R0 + idx - 2048) * PW + 4096 + head * 128 + 4 * r31); kv.x = bflo(w.x); kv.y = bfhi(w.x); kv.z = bflo(w.y); kv.w = bfhi(w.y); }
            else kv = ld4(ckb + (size_t)idx * 1024);
            float s = q.x * kv.x + q.y * kv.y + q.z * kv.z + q.w * kv.w;
            s += __shfl_xor(s, 1); s += __shfl_xor(s, 2); s += __shfl_xor(s, 4); s += __shfl_xor(s, 8); s += __shfl_xor(s, 16);
            if (r31 == 0 && ok) sc[j] = s; }
        LDS_WAIT();
        float s0 = sc[lane], s1 = sc[64 + lane], s2 = (lane == 0) ? sc[128] : -INFINITY;
        const float m = wave_max(fmaxf(s0, fmaxf(s1, s2)));
        s0 = fexp2(s0 - m); s1 = fexp2(s1 - m); s2 = fexp2(s2 - m);
        const float l = wave_sum(s0 + s1 + s2);
        sc[lane] = s0; sc[64 + lane] = s1; if (lane == 0) sc[128] = s2;
        LDS_WAIT();
        f32x4 acc = {0.f, 0.f, 0.f, 0.f};
#pragma unroll 5
        for (int jj = 0; jj < 65; ++jj) { const int j = 2 * jj + half; const bool ok = j <= 128; const int idx = 2048 + t - ((ok ? j : 0) << ld);
            f32x4 vv;
            if (idx >= 2048) { const u32x2 w = ld8(P + (size_t)(R0 + idx - 2048) * PW + 5120 + head * 128 + 4 * r31); vv.x = bflo(w.x); vv.y = bfhi(w.x); vv.z = bflo(w.y); vv.w = bfhi(w.y); }
            else vv = ld4(cvb + (size_t)idx * 1024);
            const float p = ok ? sc[ok ? j : 0] : 0.f;
            acc += vv * p; }
        acc.x += __shfl_xor(acc.x, 32); acc.y += __shfl_xor(acc.y, 32); acc.z += __shfl_xor(acc.z, 32); acc.w += __shfl_xor(acc.w, 32);
        const float Mn = fmaxf(Mr, m), fa = fexp2(Mr - Mn), fb = fexp2(m - Mn);
        Ar = Ar * fa + acc * fb; Lr = Lr * fa + l * fb; Mr = Mn;
        LDS_WAIT();
    }
    if (half == 0) { const float inv = 1.f / Lr; u32x2 w; w.x = pk2(Ar.x * inv, Ar.y * inv); w.y = pk2(Ar.z * inv, Ar.w * inv);
        st8(CAT + (size_t)(R0 + t) * DM + 1024 + head * 128 + 4 * r31, w); }
}

DI void conv_task(const bf16* GV, bf16* ACT, const float* cw, const float* cb, const float* sconv, int e) {
    int row0, nrows, cg; f32x4 gm2[2], gm1[2];
    if (e < 256 * 704) { const int rc = e / 704; cg = e % 704; row0 = rc * 32; nrows = 32;
        if (rc == 0) { gm2[0] = gm2[1] = gm1[0] = gm1[1] = (f32x4){0.f, 0.f, 0.f, 0.f}; }
        else { const u32x4 a = ld16(GV + (size_t)(row0 - 2) * NUP + cg * 8), b = ld16(GV + (size_t)(row0 - 1) * NUP + cg * 8);
            gm2[0] = (f32x4){bflo(a.x), bfhi(a.x), bflo(a.y), bfhi(a.y)}; gm2[1] = (f32x4){bflo(a.z), bfhi(a.z), bflo(a.w), bfhi(a.w)};
            gm1[0] = (f32x4){bflo(b.x), bfhi(b.x), bflo(b.y), bfhi(b.y)}; gm1[1] = (f32x4){bflo(b.z), bfhi(b.z), bflo(b.w), bfhi(b.w)}; }
    } else { const int e2 = e - 256 * 704, bb = e2 / 704; cg = e2 % 704; row0 = SEQ + 8 * bb; nrows = 8;
        const float* s0 = sconv + ((size_t)bb * 2) * DFF + cg * 8;
        gm2[0] = ld4(s0); gm2[1] = ld4(s0 + 4); gm1[0] = ld4(s0 + DFF); gm1[1] = ld4(s0 + DFF + 4); }
    const int c0 = cg * 8;
    const f32x4 w0a = ld4(cw + c0), w0b = ld4(cw + c0 + 4), w1a = ld4(cw + DFF + c0), w1b = ld4(cw + DFF + c0 + 4), w2a = ld4(cw + 2 * DFF + c0), w2b = ld4(cw + 2 * DFF + c0 + 4);
    const f32x4 ba = ld4(cb + c0), bb4 = ld4(cb + c0 + 4);
    for (int r = 0; r < nrows; ++r) { const size_t ro = (size_t)(row0 + r) * NUP + c0;
        const u32x4 gw = ld16(GV + ro), vw = ld16(GV + ro + DFF);
        const f32x4 g0 = {bflo(gw.x), bfhi(gw.x), bflo(gw.y), bfhi(gw.y)}, g1 = {bflo(gw.z), bfhi(gw.z), bflo(gw.w), bfhi(gw.w)};
        const f32x4 v0 = {bflo(vw.x), bfhi(vw.x), bflo(vw.y), bfhi(vw.y)}, v1 = {bflo(vw.z), bfhi(vw.z), bflo(vw.w), bfhi(vw.w)};
        const f32x4 x0 = gm2[0] * w0a + gm1[0] * w1a + g0 * w2a + ba, x1 = gm2[1] * w0b + gm1[1] * w1b + g1 * w2b + bb4;
        u32x4 o; o.x = pk2(siluf_(x0.x) * v0.x, siluf_(x0.y) * v0.y); o.y = pk2(siluf_(x0.z) * v0.z, siluf_(x0.w) * v0.w);
        o.z = pk2(siluf_(x1.x) * v1.x, siluf_(x1.y) * v1.y); o.w = pk2(siluf_(x1.z) * v1.z, siluf_(x1.w) * v1.w);
        st16(ACT + (size_t)(row0 + r) * DFF + c0, o);
        gm2[0] = gm1[0]; gm2[1] = gm1[1]; gm1[0] = g0; gm1[1] = g1; }
}

#ifndef MK_SPLIT
#define MK_SPLIT 0
#endif
constexpr int N_PHASES = 22;
struct Args { const float* in[24]; float* out; unsigned char* ws; int ph_lo, ph_hi, li, pad; };

typedef const Args __attribute__((address_space(4)))* KArgs;
struct GOrder {
    pg8::StaticOrder so; int mode, nS, nUnits, G, c; pg8::Unit one;
    DI bool next(int i, pg8::Unit& u) const {
        if (mode == 0) return so.next(i, u);
        if (mode == 1) { const int L = i * G + c; if (L >= nUnits) return false; u.pm = 32; u.pn = L / nS; u.ks = L % nS; return true; }
        if (i) return false; u = one; return true;
    }
    DI void a_ready(const pg8::Unit&) const {}
    DI void done(const pg8::Unit&) const {}
};
DI GOrder order_static(int M, int N, int G, int c) { GOrder o; o.so.init(M, N, G, c); o.mode = 0; o.nS = 1; o.nUnits = 0; o.G = G; o.c = c; o.one = pg8::Unit{0, 0, 0}; return o; }
DI GOrder order_split(int nN, int nS, int G, int c) { GOrder o; o.so.init(256, 256, G, c); o.mode = 1; o.nS = nS; o.nUnits = nN * nS; o.G = G; o.c = c; o.one = pg8::Unit{0, 0, 0}; return o; }
DI GOrder order_one(int pm, int pn) { GOrder o; o.so.init(256, 256, 1, 0); o.mode = 2; o.nS = 1; o.nUnits = 1; o.G = 1; o.c = 0; o.one = pg8::Unit{pm, pn, 0}; return o; }
DI int dequeue(gu32* qw, volatile LAS unsigned* slot, int tid) {
    __syncthreads();
    if (tid == 0) *slot = __hip_atomic_fetch_add(qw, 1u, RLX_AGENT);
    __syncthreads();
    return (int)*slot;
}

__global__ void __launch_bounds__(NTHR, 2) mk_fwd(Args a) {
    extern __shared__ __attribute__((aligned(16))) unsigned char lds_raw[];
    LAS unsigned char* lds = (LAS unsigned char*)lds_raw;
    const unsigned ldsbase = (unsigned)(size_t)lds_raw;
    const int tid = threadIdx.x, lane = tid & 63, wave = __builtin_amdgcn_readfirstlane(tid >> 6);
    const int G = gridDim.x, bid = blockIdx.x;
    volatile LAS unsigned* MISC = (volatile LAS unsigned*)(lds + MISC_OFF);
    for (int u = tid; u < (LDS_BYTES - LDSCTL_OFF) / 4; u += NTHR) ((LAS unsigned*)(lds + LDSCTL_OFF))[u] = 0u;
    __syncthreads();
    unsigned char* const ws = a.ws; float* const out0 = a.out;
    const KArgs ka0 = (KArgs)__builtin_amdgcn_kernarg_segment_ptr();
    XcdBarrier bar = xcd_barrier_post((unsigned*)ws + CW_BAR + a.li * XCD_BAR_WORDS, MISC + 8);
    const int lo = a.ph_lo, hi = a.ph_hi;
#ifndef MK_MASK
#define MK_MASK 0xFFFFFFFFu
#endif
#ifndef MK_DBL
#define MK_DBL 0u
#endif
#ifndef MK_C
#define MK_C 15
#endif
#define RUN(k) (lo <= (k) && (k) < hi)
#define EN(j) ((MK_MASK >> (j)) & 1u)
#define REPS(j) (((MK_DBL >> (j)) & 1u) ? 2 : 1)
#define SEAM(k) do { if (RUN(k) && RUN((k) + 1)) xcd_barrier(bar); } while (0)
#define PH() int ln = lane, td = tid; unsigned char* wsl = ws; float* out = out0; KArgs ka = ka0; asm volatile("" : "+v"(ln), "+v"(td), "+s"(wsl), "+s"(out), "+s"(ka)); \
             const int gw = bid * NWAVES + wave, ngw = G * NWAVES, gt = bid * NTHR + td, ngt = G * NTHR; (void)ln; (void)td; (void)gw; (void)ngw; (void)gt; (void)ngt; (void)out; (void)ka
#define W_(T, off) ((T*)(wsl + (off)))
#define IN_(k) (ka->in[k])
#define QW_(q) ((gu32*)wsl + CW_Q + 64 * (q))
#define PHQ() ln = lane; td = tid; wsl = ws; out = out0; ka = ka0; asm volatile("" : "+v"(ln), "+v"(td), "+s"(wsl), "+s"(out), "+s"(ka))

    if (EN(0) && RUN(0)) for (int rep_ = 0; rep_ < REPS(0); ++rep_) {
        { PH(); p0_mod(IN_(8), IN_(9), IN_(10), IN_(11), W_(float, WS_MOD), lds, bid, G, td, wave, ln); }
        { PH(); p0_rope(W_(float, WS_ROPE), W_(float, WS_ROPE) + 8200 * 64, gt, ngt); }
        { PH(); p0_weights(IN_(12), IN_(15), IN_(18), IN_(21), wsl, lds, gw, ngw, wave, ln); }
        __syncthreads();
    }
    SEAM(0);
    if (EN(1) && RUN(1)) for (int rep_ = 0; rep_ < REPS(1); ++rep_) { PH(); const float* xp = IN_(0); const float* xs = IN_(1);
        load_gate_w(IN_(12), (LAS float*)lds, td); __syncthreads();
        for (int row = gw; row < MR; row += ngw) { const float* x = row < SEQ ? xp + (size_t)row * DM : xs + (size_t)(row - SEQ) * DM; const float* mr = W_(float, WS_MOD) + (size_t)mod_row(row) * NMOD;
            modulate_row(x, mr, mr + DM, W_(bf16, WS_U) + (size_t)row * DM, (const LAS float*)lds, IN_(13), W_(float, WS_IG), W_(float, WS_LF), row, ln); }
        __syncthreads();
    }
    SEAM(1);
    for (int l = 0; l < 2; ++l) {
        const int pb = 2 + 10 * l;
        if (EN(2) && RUN(pb + 0)) for (int rep_ = 0; rep_ < REPS(2); ++rep_) { PH();
            pg8::Gemm g{W_(bf16, WS_U), W_(bf16, WS_WIN) + (size_t)l * NINP * DM, SEQ, NINP, DM, DM}; const GOrder S = order_static(SEQ, NINP, G, bid);
            EpiIn E{wsl, out, l};
            pg8::gemm_phase<EpiIn, GOrder, true, true>(lds, g, S, E);
        }
        SEAM(pb + 0);
        if (EN(3) && RUN(pb + 1)) for (int rep_ = 0; rep_ < REPS(3); ++rep_) { PH();
            for (;;) { const int it = dequeue(QW_(4 * l + 2 * rep_), MISC + 16, td); PHQ();
                if (it < 24) { pg8::Gemm g{W_(bf16, WS_U), W_(bf16, WS_WIN) + (size_t)l * NINP * DM, MR, NINP, DM, DM}; const GOrder S = order_one(32, it); EpiIn E{wsl, out, l};
                    pg8::gemm_phase<EpiIn, GOrder, true, true>(lds, g, S, E); }
                else if (it < 24 + 768) attn_prompt_unit(W_(bf16, WS_P), W_(bf16, WS_OPART), W_(float, WS_ML), it - 24, lds, ldsbase, wave, ln);
                else if (it < 24 + 768 + NUNIT / 2) mlstm_m1_item(W_(bf16, WS_P), W_(float, WS_IG), W_(float, WS_LF), W_(float, WS_SCAL), W_(float, WS_DCT), it - (24 + 768), lds, ldsbase, wave, ln);
                else break; }
            __syncthreads();
        }
        SEAM(pb + 1);
        if (EN(4) && RUN(pb + 2)) for (int rep_ = 0; rep_ < REPS(4); ++rep_) { PH();
            for (;;) { const int it = dequeue(QW_(4 * l + 2 * rep_ + 1), MISC + 16, td); PHQ();
                if (it < 129) { if (MK_C & 1) mlstm_m2(W_(float, WS_SCAL), W_(float, WS_DCT), W_(bf16, WS_CST), W_(float, WS_MST), out + O_CP + (size_t)l * 65536, out + O_NP + (size_t)l * 512, out + O_MP + (size_t)l * 8, it * NTHR + td); }
                else if (it < 129 + 256) { const int u = it - 129, b = u >> 3, hd = u & 7;
#ifdef MK_SA_V1
                    sample_attn_unit_v1(W_(bf16, WS_P), IN_(2) + (size_t)l * 32 * 2048 * 1024, IN_(3) + (size_t)l * 32 * 2048 * 1024, W_(bf16, WS_CAT), b, hd, lds, wave, ln); }
#else
                    if (MK_C & 2) sample_attn_unit(W_(bf16, WS_P), IN_(2) + (size_t)l * 32 * 2048 * 1024, IN_(3) + (size_t)l * 32 * 2048 * 1024, W_(bf16, WS_CAT), b, hd, lds, ldsbase, td, wave, ln); }
#endif
                else if (it < 129 + 512) { const int u = it - (129 + 256), b = u >> 3, hd = u & 7; const size_t so = ((size_t)(l * 32 + b) * 8 + hd);
                    if (MK_C & 4) sample_mlstm_unit(W_(bf16, WS_P), W_(float, WS_IG), W_(float, WS_LF), IN_(4) + so * 8192, IN_(5) + so * 64, IN_(6) + so, IN_(14) + l * 1024, W_(bf16, WS_CAT), out + O_CS + so * 8192, out + O_NS + so * 64, out + O_MS + so, b, hd, lds, td, wave, ln); }
                else if (it < 129 + 512 + 256) { const int ch = it - (129 + 512); if (MK_C & 8) for (int e = ch * 4096 + td; e < (ch + 1) * 4096; e += NTHR) attn_combine(W_(bf16, WS_OPART), W_(float, WS_ML), W_(bf16, WS_CAT), e); }
                else break; }
            __syncthreads();
        }
        SEAM(pb + 2);
        if (EN(5) && RUN(pb + 3)) for (int rep_ = 0; rep_ < REPS(5); ++rep_) { PH(); for (int it = bid; it < NUNIT / 4; it += G) mlstm_m3_item(W_(bf16, WS_P), W_(float, WS_SCAL), W_(bf16, WS_CST), W_(float, WS_MST), IN_(14) + l * 1024, W_(bf16, WS_CAT), it, lds, ldsbase, wave, ln); }
        SEAM(pb + 3);
        if (EN(6) && RUN(pb + 4)) for (int rep_ = 0; rep_ < REPS(6); ++rep_) { PH();
            EpiRes E{W_(float, WS_Y), l == 0 ? IN_(0) : W_(float, WS_XR), W_(float, WS_MOD) + (size_t)l * 33 * NMOD + 2 * DM, W_(float, WS_SLAB)};
#pragma nounroll
            for (int pass = 0; pass < 2; ++pass) {
                pg8::Gemm g{W_(bf16, WS_CAT), W_(bf16, WS_WOUT) + (size_t)l * DM * DM, MR, DM, pass ? 512 : DM, DM};
                const GOrder S = pass ? order_split(8, 4, G, bid) : order_static(SEQ, DM, G, bid);
                pg8::gemm_phase<EpiRes, GOrder, true, true>(lds, g, S, E); }
        }
        SEAM(pb + 4);
        if (EN(7) && RUN(pb + 5)) for (int rep_ = 0; rep_ < REPS(7); ++rep_) { PH(); const float* lg = IN_(16) + l * DM; const float* lb = IN_(17) + l * DM; const float* xs = l == 0 ? IN_(1) : W_(float, WS_XR) + (size_t)SEQ * DM;
            for (int row = gw; row < MR; row += ngw) { const float* mr = W_(float, WS_MOD) + ((size_t)l * 33 + mod_row(row)) * NMOD; const bool smp = row >= SEQ;
                ln_row(smp ? (const float*)nullptr : W_(float, WS_Y) + (size_t)row * DM, W_(float, WS_SLAB) + (size_t)(row - SEQ) * DM, 4, xs + (size_t)(row - SEQ) * DM, mr + 2 * DM,
                       lg, lb, W_(float, WS_XA) + (size_t)row * DM, mr + 3 * DM, mr + 4 * DM, W_(bf16, WS_U) + (size_t)row * DM, (const LAS float*)lds, false, nullptr, nullptr, nullptr, row, ln); }
        }
        SEAM(pb + 5);
        if (EN(8) && RUN(pb + 6)) for (int rep_ = 0; rep_ < REPS(8); ++rep_) { PH();
            pg8::Gemm g{W_(bf16, WS_U), W_(bf16, WS_WUP) + (size_t)l * NUP * DM, MR, NUP, DM, DM}; const GOrder S = order_static(MR, NUP, G, bid);
            EpiUp E{W_(bf16, WS_GV), out + O_BP + (size_t)l * 2 * DFF, out + O_BS + (size_t)l * 32 * 2 * DFF};
            pg8::gemm_phase<EpiUp, GOrder, true, true>(lds, g, S, E);
        }
        SEAM(pb + 6);
        if (EN(9) && RUN(pb + 7)) for (int rep_ = 0; rep_ < REPS(9); ++rep_) { PH(); const float* cw = IN_(19) + (size_t)l * 3 * DFF; const float* cb = IN_(20) + (size_t)l * DFF; const float* sc = IN_(7) + (size_t)l * 32 * 2 * DFF;
            for (int e = gt; e < (256 + 32) * 704; e += ngt) conv_task(W_(bf16, WS_GV), W_(bf16, WS_ACT), cw, cb, sc, e); }
        SEAM(pb + 7);
        if (EN(10) && RUN(pb + 8)) for (int rep_ = 0; rep_ < REPS(10); ++rep_) { PH();
            EpiRes E{W_(float, WS_Y), W_(float, WS_XA), W_(float, WS_MOD) + (size_t)l * 33 * NMOD + 5 * DM, W_(float, WS_SLAB)};
#pragma nounroll
            for (int pass = 0; pass < 2; ++pass) {
                pg8::Gemm g{W_(bf16, WS_ACT), W_(bf16, WS_WDN) + (size_t)l * DM * DFF, MR, DM, pass ? 512 : DFF, DFF};
                const GOrder S = pass ? order_split(8, 11, G, bid) : order_static(SEQ, DM, G, bid);
                pg8::gemm_phase<EpiRes, GOrder, true, true>(lds, g, S, E); }
        }
        SEAM(pb + 8);
        if (EN(11) && RUN(pb + 9)) for (int rep_ = 0; rep_ < REPS(11); ++rep_) { PH(); const float* lg = IN_(22) + l * DM; const float* lb = IN_(23) + l * DM; float* xo = l == 0 ? W_(float, WS_XR) : out + O_XP;
            if (l == 0) { load_gate_w(IN_(12) + (size_t)DM * DIN, (LAS float*)lds, td); __syncthreads(); }
            for (int row = gw; row < MR; row += ngw) { const float* mr = W_(float, WS_MOD) + (size_t)(33 + mod_row(row)) * NMOD;
                const float* mr0 = W_(float, WS_MOD) + ((size_t)l * 33 + mod_row(row)) * NMOD; const bool smp = row >= SEQ;
                ln_row(smp ? (const float*)nullptr : W_(float, WS_Y) + (size_t)row * DM, W_(float, WS_SLAB) + (size_t)(row - SEQ) * DM, 11, W_(float, WS_XA) + (size_t)row * DM, mr0 + 5 * DM,
                       lg, lb, xo + (size_t)row * DM, mr, mr + DM, l == 0 ? W_(bf16, WS_U) + (size_t)row * DM : (bf16*)nullptr, (const LAS float*)lds, l == 0, IN_(13) + 16, W_(float, WS_IG), W_(float, WS_LF), row, ln); }
            __syncthreads();
        }
        SEAM(pb + 9);
    }
#undef RUN
#undef SEAM
}

extern "C" void kernel_launch(void* const* d_in, const int* in_sizes, int n_in, void* d_out, int out_size, void* d_ws, size_t ws_size, hipStream_t stream) {
    static int grid = 0;
    if (grid == 0) {
        if (n_in != 24 || out_size != (int)O_END || ws_size < WS_END) { fprintf(stderr, "kernel_launch: unexpected shapes: n_in %d out %d ws %zu (need %zu)\n", n_in, out_size, ws_size, (size_t)WS_END); grid = -1; return; }
        int dev = 0, cus = 0, per_cu = 0;
        if (hipGetDevice(&dev) != hipSuccess || hipDeviceGetAttribute(&cus, hipDeviceAttributeMultiprocessorCount, dev) != hipSuccess) { fprintf(stderr, "kernel_launch: device query failed\n"); grid = -1; return; }
        if (hipFuncSetAttribute((const void*)mk_fwd, hipFuncAttributeMaxDynamicSharedMemorySize, LDS_BYTES) != hipSuccess) { fprintf(stderr, "kernel_launch: hipFuncSetAttribute failed\n"); grid = -1; return; }
        if (hipOccupancyMaxActiveBlocksPerMultiprocessor(&per_cu, (const void*)mk_fwd, NTHR, LDS_BYTES) != hipSuccess || per_cu < 1) fprintf(stderr, "kernel_launch: note: occupancy query reports %d blocks per CU\n", per_cu);
        (void)hipGetLastError();
        grid = cus;
    }
    if (grid < 0) return;
    (void)in_sizes;
    if (hipMemsetAsync((char*)d_ws + WS_CTL, 0, CTL_ZERO_BYTES, stream) != hipSuccess) { fprintf(stderr, "kernel_launch: memset failed\n"); return; }
    Args a{};
    for (int i = 0; i < 24; ++i) a.in[i] = (const float*)d_in[i];
    a.out = (float*)d_out; a.ws = (unsigned char*)d_ws; a.pad = 0;
#if MK_SPLIT
    for (int p = 0; p < N_PHASES; ++p) { a.ph_lo = p; a.ph_hi = p + 1; a.li = p; hipLaunchKernelGGL(mk_fwd, dim3(grid), dim3(NTHR), LDS_BYTES, stream, a); }
#else
    a.ph_lo = 0; a.ph_hi = N_PHASES; a.li = 0;
    hipLaunchKernelGGL(mk_fwd, dim3(grid), dim3(NTHR), LDS_BYTES, stream, a);
#endif
    const hipError_t le = hipPeekAtLastError();
    if (le != hipSuccess) fprintf(stderr, "kernel_launch: launch failed: %s\n", hipGetErrorName(le));
}
```

```cpp
#include <hip/hip_runtime.h>
#include <cstdio>
#include <cstdint>
namespace pg8 {
#define PG8_LAS __attribute__((address_space(3)))
typedef unsigned short bf16_t;
typedef short bf16x8 __attribute__((ext_vector_type(8)));
typedef float f32x4 __attribute__((ext_vector_type(4)));
typedef unsigned u32x4 __attribute__((ext_vector_type(4)));
constexpr int BM = 256, BK = 64, HALF = 128, HTB = HALF * BK * 2  , STAGE_BYTES = 8 * HTB, NXCD = 8, WGM = 8;

__host__ __device__ __forceinline__ int lds_byte(int r, int c) { const int st = (r >> 4) * 2 + (c >> 5), rr = r & 15, cc = c & 31, ob = rr * 64 + cc * 2; return st * 1024 + (ob ^ (((ob >> 9) & 1) << 5)); }
__host__ __device__ __forceinline__ void stage_rc(int b, int& R, int& C) { const int st = b / 1024, sb = b % 1024, swz = sb ^ (((sb >> 9) & 1) << 5); R = (st >> 1) * 16 + swz / 64; C = (st & 1) * 32 + (swz % 64) / 2; }
__host__ __device__ __forceinline__ int perm32(int rho) { const int n = rho >> 4, i = rho & 15; return 8 * (i >> 2) + 4 * n + (i & 3); }

struct Unit { int pm, pn, ks; };
struct Gemm { const bf16_t* A; const bf16_t* Bt; int M, N, K, ld; };

struct StaticOrder {
    int nM, nN, nwg, G, c;
    __host__ __device__ void init(int M, int N, int G_, int c_) { nM = M / BM; nN = N / BM; nwg = nM * nN; G = G_; c = c_; }
    __host__ __device__ bool next(int i, Unit& u) const {
        const long L = (long)i * G + c; if (L >= nwg) return false;
        int wgid = (int)L; { const int q = nwg / NXCD, r = nwg % NXCD, xcd = wgid % NXCD, off = wgid / NXCD; wgid = (xcd < r ? xcd * (q + 1) : r * (q + 1) + (xcd - r) * q) + off; }
        const int nig = WGM * nN, gid = wgid / nig, fm = gid * WGM, gsz = (nM - fm) < WGM ? (nM - fm) : WGM;
        u.pm = fm + ((wgid % nig) % gsz); u.pn = (wgid % nig) / gsz; u.ks = 0; return true;
    }
    __device__ __forceinline__ void a_ready(const Unit&) const {}
    __device__ __forceinline__ void done(const Unit&) const {}
};

__device__ __forceinline__ unsigned cvt_pk_bf16(float lo, float hi) { unsigned r; asm volatile("v_cvt_pk_bf16_f32 %0, %1, %2" : "=v"(r) : "v"(lo), "v"(hi)); return r; }
template <class Epi, class Sched, bool ALIGN_EPI = false, bool SP2 = false>
__device__ __forceinline__ void gemm_phase(PG8_LAS unsigned char* lds, const Gemm g, const Sched& S, const Epi& E) {
    int tid_ = threadIdx.x; asm volatile("" : "+v"(tid_));
    const int tid = tid_, wid = __builtin_amdgcn_readfirstlane(tid >> 6), lane = tid & 63, wr = wid >> 2, wc = wid & 3, fr = lane & 15, fq = lane >> 4;
    const int K = g.K, nt = K / BK;
    unsigned voffA[2], voffB[2];
#pragma unroll
    for (int i = 0; i < 2; ++i) { int R, C; stage_rc(tid * 16 + i * 8192, R, C); const int Rb = Epi::PERM ? ((R & ~31) + perm32(R & 31)) : R;
        voffA[i] = (unsigned)(R * g.ld + C) * 2u; voffB[i] = (unsigned)(Rb * g.ld + C) * 2u; }
    const size_t kstep = (size_t)(BK * 2);
    const size_t hstep = (size_t)HALF * g.ld * 2;
    const size_t tstep = 2 * hstep;
    const unsigned ldsw = (unsigned)wid * 1024u;
    const int aoff = lds_byte(wr * 64 + fr, fq * 8), boff = lds_byte(wc * 32 + fr, fq * 8);
#define PG8_SA(b, h) (((b) * 2 + (h)) * HTB)
#define PG8_SB(b, h) ((4 + (b) * 2 + (h)) * HTB)
#define PG8_STAGE(bufoff, gbase, voff) do { _Pragma("unroll") for (int _i = 0; _i < 2; ++_i) \
        __builtin_amdgcn_global_load_lds((const unsigned*)((const char*)(gbase) + (voff)[_i]), (PG8_LAS unsigned*)(lds + (bufoff) + ldsw + _i * 8192), 16, 0, 0); } while (0)
#define PG8_LDA(dst, b, h) do { _Pragma("unroll") for (int m = 0; m < 4; ++m) _Pragma("unroll") for (int k = 0; k < 2; ++k) dst[m][k] = *(const PG8_LAS bf16x8*)(lds + PG8_SA(b, h) + aoff + m * 2048 + k * 1024); } while (0)
#define PG8_LDB(dst, b, h) do { _Pragma("unroll") for (int n = 0; n < 2; ++n) _Pragma("unroll") for (int k = 0; k < 2; ++k) dst[n][k] = *(const PG8_LAS bf16x8*)(lds + PG8_SB(b, h) + boff + n * 2048 + k * 1024); } while (0)
#define PG8_MMA(ai, bj, At, Bt) do { __builtin_amdgcn_s_setprio(1); _Pragma("unroll") for (int m = 0; m < 4; ++m) _Pragma("unroll") for (int n = 0; n < 2; ++n) _Pragma("unroll") for (int k = 0; k < 2; ++k) \
        acc[ai][bj][m][n] = __builtin_amdgcn_mfma_f32_16x16x32_bf16(Bt[n][k], At[m][k], acc[ai][bj][m][n], 0, 0, 0); __builtin_amdgcn_s_setprio(0); } while (0)
#define PG8_WAIT_V(n) asm volatile("s_waitcnt vmcnt(" #n ")" ::: "memory")
#define PG8_WAIT_L(n) asm volatile("s_waitcnt lgkmcnt(" #n ")" ::: "memory")
#define PG8_BAR __builtin_amdgcn_s_barrier()
#define PG8_SCHED __builtin_amdgcn_sched_barrier(0)
    Unit cur, nxt; int ui = 0;
    if (!S.next(0, cur)) return;
    f32x4 acc[2][2][4][2];
#pragma unroll
    for (int a = 0; a < 2; ++a)
#pragma unroll
        for (int b = 0; b < 2; ++b)
#pragma unroll
            for (int m = 0; m < 4; ++m)
#pragma unroll
                for (int n = 0; n < 2; ++n) acc[a][b][m][n] = (f32x4){0.f, 0.f, 0.f, 0.f};
    bf16x8 At[4][2], B0[2][2], B1[2][2];
    const char* cA = (const char*)g.A + (size_t)cur.pm * tstep + (size_t)cur.ks * K * 2; const char* cB = (const char*)g.Bt + (size_t)cur.pn * tstep + (size_t)cur.ks * K * 2;
    S.a_ready(cur);
    if constexpr (SP2) {
        PG8_STAGE(PG8_SB(0, 0), cB, voffB); PG8_STAGE(PG8_SB(0, 1), cB + hstep, voffB); PG8_STAGE(PG8_SA(0, 0), cA, voffA); PG8_STAGE(PG8_SA(0, 1), cA + hstep, voffA);
        if (wr == 1) PG8_BAR;
        PG8_WAIT_V(2); PG8_BAR;
        PG8_STAGE(PG8_SB(1, 0), cB + kstep, voffB); PG8_STAGE(PG8_SA(1, 0), cA + kstep, voffA); PG8_STAGE(PG8_SB(1, 1), cB + hstep + kstep, voffB);
        PG8_WAIT_V(6); PG8_BAR;
    } else {
        PG8_STAGE(PG8_SB(0, 0), cB, voffB); PG8_STAGE(PG8_SA(0, 0), cA, voffA); PG8_STAGE(PG8_SB(0, 1), cB + hstep, voffB); PG8_STAGE(PG8_SA(0, 1), cA + hstep, voffA);
        if (wr == 1) PG8_BAR;
        PG8_WAIT_V(4); PG8_BAR;
        PG8_STAGE(PG8_SB(1, 0), cB + kstep, voffB); PG8_STAGE(PG8_SA(1, 0), cA + kstep, voffA); PG8_STAGE(PG8_SB(1, 1), cB + hstep + kstep, voffB);
        PG8_WAIT_V(6); PG8_BAR;
    }
    for (;;) {
        const bool has_next = S.next(ui + 1, nxt);
        const char* nA = has_next ? (const char*)g.A + (size_t)nxt.pm * tstep + (size_t)nxt.ks * K * 2 : cA; const char* nB = has_next ? (const char*)g.Bt + (size_t)nxt.pn * tstep + (size_t)nxt.ks * K * 2 : cB;
        for (int t = 0; t < nt; t += 2) {
            const bool last = (t == nt - 2);
            const char* a1 = cA + (size_t)(t + 1) * kstep;
            const char* a2 = last ? nA : cA + (size_t)(t + 2) * kstep; const char* b2 = last ? nB : cB + (size_t)(t + 2) * kstep;
            const char* a3 = a2 + kstep; const char* b3 = b2 + kstep;
            if (last && has_next) S.a_ready(nxt);
            if constexpr (SP2) {
            PG8_LDB(B0, 0, 0); PG8_LDB(B1, 0, 1); PG8_SCHED; PG8_LDA(At, 0, 0); PG8_STAGE(PG8_SA(1, 1), a1 + hstep, voffA);
            PG8_WAIT_V(8); PG8_WAIT_L(0); PG8_BAR; PG8_MMA(0, 0, At, B0); PG8_MMA(0, 1, At, B1); PG8_BAR; PG8_SCHED;
            PG8_LDA(At, 0, 1); PG8_STAGE(PG8_SB(0, 0), b2, voffB); PG8_STAGE(PG8_SB(0, 1), b2 + hstep, voffB); PG8_STAGE(PG8_SA(0, 0), a2, voffA);
            PG8_WAIT_V(8); PG8_WAIT_L(0); PG8_BAR; PG8_MMA(1, 0, At, B0); PG8_MMA(1, 1, At, B1); PG8_BAR; PG8_SCHED;
            PG8_LDB(B0, 1, 0); PG8_LDB(B1, 1, 1); PG8_SCHED; PG8_LDA(At, 1, 0); PG8_STAGE(PG8_SA(0, 1), a2 + hstep, voffA);
            PG8_WAIT_V(8); PG8_WAIT_L(0); PG8_BAR; PG8_MMA(0, 0, At, B0); PG8_MMA(0, 1, At, B1); PG8_BAR; PG8_SCHED;
            PG8_LDA(At, 1, 1); PG8_STAGE(PG8_SB(1, 0), b3, voffB); PG8_STAGE(PG8_SB(1, 1), b3 + hstep, voffB); PG8_STAGE(PG8_SA(1, 0), a3, voffA);
            PG8_WAIT_V(8); PG8_WAIT_L(0); PG8_BAR; PG8_MMA(1, 0, At, B0); PG8_MMA(1, 1, At, B1); PG8_BAR; PG8_SCHED;
            } else {
            PG8_LDB(B0, 0, 0); PG8_SCHED; PG8_LDA(At, 0, 0); PG8_STAGE(PG8_SA(1, 1), a1 + hstep, voffA);
            PG8_WAIT_L(8); PG8_BAR; PG8_WAIT_L(0); PG8_MMA(0, 0, At, B0); PG8_BAR; PG8_SCHED;
            PG8_LDB(B1, 0, 1); PG8_STAGE(PG8_SB(0, 0), b2, voffB);
            PG8_BAR; PG8_WAIT_L(0); PG8_MMA(0, 1, At, B1); PG8_BAR;
            PG8_LDA(At, 0, 1); PG8_STAGE(PG8_SA(0, 0), a2, voffA);
            PG8_BAR; PG8_WAIT_L(0); PG8_MMA(1, 0, At, B0); PG8_BAR; PG8_SCHED;
            PG8_STAGE(PG8_SB(0, 1), b2 + hstep, voffB);
            PG8_WAIT_V(6); PG8_BAR; PG8_MMA(1, 1, At, B1); PG8_BAR;
            PG8_LDB(B0, 1, 0); PG8_SCHED; PG8_LDA(At, 1, 0); PG8_STAGE(PG8_SA(0, 1), a2 + hstep, voffA);
            PG8_WAIT_L(8); PG8_BAR; PG8_WAIT_L(0); PG8_MMA(0, 0, At, B0); PG8_BAR; PG8_SCHED;
            PG8_LDB(B1, 1, 1); PG8_STAGE(PG8_SB(1, 0), b3, voffB);
            PG8_BAR; PG8_WAIT_L(0); PG8_MMA(0, 1, At, B1); PG8_BAR;
            PG8_LDA(At, 1, 1); PG8_STAGE(PG8_SA(1, 0), a3, voffA);
            PG8_BAR; PG8_WAIT_L(0); PG8_MMA(1, 0, At, B0); PG8_BAR; PG8_SCHED;
            PG8_STAGE(PG8_SB(1, 1), b3 + hstep, voffB);
            PG8_WAIT_V(6); PG8_BAR; PG8_MMA(1, 1, At, B1); PG8_BAR;
            }
        }
        if constexpr (ALIGN_EPI) { if (wr == 0) PG8_BAR; }
        if constexpr (!Epi::AFTER_DRAIN) { E(acc, cur, wr, wc, fr, fq); S.done(cur); }
        if (!has_next) break;
#pragma unroll
        for (int a = 0; a < 2; ++a)
#pragma unroll
            for (int b = 0; b < 2; ++b)
#pragma unroll
                for (int m = 0; m < 4; ++m)
#pragma unroll
                    for (int n = 0; n < 2; ++n) acc[a][b][m][n] = (f32x4){0.f, 0.f, 0.f, 0.f};
        cur = nxt; cA = nA; cB = nB; ++ui;
        if constexpr (ALIGN_EPI) { if (wr == 1) PG8_BAR; }
    }
    PG8_WAIT_V(0);
    if constexpr (!ALIGN_EPI) { if (wr == 0) PG8_BAR; }
    PG8_BAR;
    if constexpr (Epi::AFTER_DRAIN) { E.fused(acc, cur, wr, wc, fr, fq, lds, wid, lane); S.done(cur); }
#undef PG8_SA
#undef PG8_SB
#undef PG8_STAGE
#undef PG8_LDA
#undef PG8_LDB
#undef PG8_MMA
#undef PG8_WAIT_V
#undef PG8_WAIT_L
#undef PG8_BAR
#undef PG8_SCHED
}
}

#define DI __device__ __forceinline__
#define GAS __attribute__((address_space(1)))
#define LAS __attribute__((address_space(3)))
typedef unsigned short bf16;
typedef float f32x4 __attribute__((ext_vector_type(4)));
typedef float f32x16 __attribute__((ext_vector_type(16)));
typedef short bf16x8 __attribute__((ext_vector_type(8)));
typedef short s16x4 __attribute__((ext_vector_type(4)));
typedef unsigned u32x4 __attribute__((ext_vector_type(4)));
typedef unsigned u32x2 __attribute__((ext_vector_type(2)));
typedef GAS unsigned gu32;
#define RLX_AGENT __ATOMIC_RELAXED, __HIP_MEMORY_SCOPE_AGENT
#define LDS_WAIT() asm volatile("s_waitcnt lgkmcnt(0)" ::: "memory")
#define VM_WAIT() asm volatile("s_waitcnt vmcnt(0)" ::: "memory")

constexpr int DM = 2048, SEQ = 8192, NSMP = 256, MR = SEQ + NSMP, DFF = 5632, NUP = 2 * DFF, NINP = 6144, DIN = 6160, NMOD = 6 * DM, PW = 6144;
constexpr int NCH = 128, LCH = 64, NHM = 8, NUNIT = NCH * NHM;
constexpr float ALPHA_RES = 1.4142135623730951f;
constexpr float QSCALE = 0.12751743082459868f;
constexpr float LOG2E = 1.4426950408889634f;
constexpr int NWAVES = 8, NTHR = 512;

constexpr size_t O_XP = 0, O_XS = 16777216, O_KP = 17301504, O_VP = 21495808, O_CP = 25690112, O_NP = 25821184, O_MP = 25822208, O_BP = 25822224,
                 O_KS = 25844752, O_VS = 26369040, O_CS = 26893328, O_NS = 31087632, O_MS = 31120400, O_BS = 31120912, O_END = 31841808;

constexpr size_t al256(size_t x) { return (x + 255) & ~(size_t)255; }
constexpr size_t WS_CTL = 0, CTL_ZERO_BYTES = 1u << 20;
constexpr size_t WS_MOD  = CTL_ZERO_BYTES;
constexpr size_t WS_ROPE = WS_MOD  + al256((size_t)2 * 33 * NMOD * 4);
constexpr size_t WS_WIN  = WS_ROPE + al256((size_t)2 * 8200 * 64 * 4);
constexpr size_t WS_WOUT = WS_WIN  + (size_t)2 * NINP * DM * 2;
constexpr size_t WS_WUP  = WS_WOUT + (size_t)2 * DM * DM * 2;
constexpr size_t WS_WDN  = WS_WUP  + (size_t)2 * NUP * DM * 2;
constexpr size_t WS_U    = WS_WDN  + (size_t)2 * DM * DFF * 2;
constexpr size_t WS_P    = WS_U    + (size_t)MR * DM * 2;
constexpr size_t WS_IG   = WS_P    + (size_t)MR * PW * 2;
constexpr size_t WS_LF   = WS_IG   + al256((size_t)MR * 8 * 4);
constexpr size_t WS_SCAL = WS_LF   + al256((size_t)MR * 8 * 4);
constexpr size_t WS_DCT  = WS_SCAL + (size_t)NUNIT * 192 * 4;
constexpr size_t WS_CST  = WS_DCT  + al256((size_t)NUNIT * 129 * 64 * 4);
constexpr size_t WS_MST  = WS_CST  + (size_t)NUNIT * 160 * 64 * 2;
constexpr size_t WS_OPART= WS_MST  + al256((size_t)NUNIT * 4);
constexpr size_t WS_ML   = WS_OPART+ (size_t)3 * SEQ * 1024 * 2;
constexpr size_t WS_CAT  = WS_ML   + (size_t)3 * SEQ * 8 * 2 * 4;
constexpr size_t WS_Y    = WS_CAT  + (size_t)MR * DM * 2;
constexpr size_t WS_XA   = WS_Y    + (size_t)MR * DM * 4;
constexpr size_t WS_XR   = WS_XA   + (size_t)MR * DM * 4;
constexpr size_t WS_GV   = WS_XR   + (size_t)MR * DM * 4;
constexpr size_t WS_ACT  = WS_GV   + (size_t)MR * NUP * 2;
constexpr size_t WS_SLAB = WS_ACT  + (size_t)MR * DFF * 2;
constexpr size_t WS_END  = WS_SLAB + (size_t)11 * NSMP * DM * 4;
constexpr int CW_BAR = 4096;
constexpr int CW_Q = 131072;

constexpr int RING_BYTES = 131072, LDSCTL_OFF = RING_BYTES, MISC_OFF = LDSCTL_OFF + 320, LDS_BYTES = 147456;

DI unsigned f2bf(float f) { unsigned u = __builtin_bit_cast(unsigned, f); return (u + 0x7fffu + ((u >> 16) & 1u)) >> 16; }
DI unsigned pk2(float lo, float hi) { return f2bf(lo) | (f2bf(hi) << 16); }
DI float bf2f(unsigned b) { return __builtin_bit_cast(float, b << 16); }
DI float bflo(unsigned w) { return __builtin_bit_cast(float, w << 16); }
DI float bfhi(unsigned w) { return __builtin_bit_cast(float, w & 0xffff0000u); }
DI f32x4 ld4(const float* p) { return *(const GAS f32x4*)p; }
DI void st4(float* p, f32x4 v) { *(GAS f32x4*)p = v; }
DI u32x4 ld16(const void* p) { return *(const GAS u32x4*)p; }
DI void st16(void* p, u32x4 v) { *(GAS u32x4*)p = v; }
DI u32x2 ld8(const void* p) { return *(const GAS u32x2*)p; }
DI void st8(void* p, u32x2 v) { *(GAS u32x2*)p = v; }
DI float ldf(const float* p) { return *(const GAS float*)p; }
DI void stf(float* p, float v) { *(GAS float*)p = v; }
DI bf16x8 ldfrag(const bf16* p) { return __builtin_bit_cast(bf16x8, *(const GAS u32x4*)p); }
DI float fexp2(float x) { return __builtin_amdgcn_exp2f(x); }
DI float fexp(float x) { return __builtin_amdgcn_exp2f(x * LOG2E); }
DI float frcp(float x) { return __builtin_amdgcn_rcpf(x); }
DI float sigmoidf_(float x) { return frcp(1.f + fexp(-x)); }
DI float siluf_(float x) { return x * sigmoidf_(x); }
DI float logsigmoidf_(float v) { const float e = fexp(-fabsf(v)); return fminf(v, 0.f) - __logf(1.f + e); }
DI int crow(int reg, int h) { return (reg & 3) + 8 * (reg >> 2) + 4 * h; }
DI f32x16 zero16() { f32x16 z; for (int i = 0; i < 16; ++i) z[i] = 0.f; return z; }
#define MFMA32(a, b, c) __builtin_amdgcn_mfma_f32_32x32x16_bf16((a), (b), (c), 0, 0, 0)
DI float wave_sum(float v) {
#pragma unroll
    for (int o = 1; o < 64; o <<= 1) v += __shfl_xor(v, o);
    return v;
}
DI float wave_max(float v) {
#pragma unroll
    for (int o = 1; o < 64; o <<= 1) v = fmaxf(v, __shfl_xor(v, o));
    return v;
}
DI bf16x8 pack_step(const f32x16& x, int s) {
    u32x4 p; p[0] = pk2(x[8 * s], x[8 * s + 1]); p[1] = pk2(x[8 * s + 2], x[8 * s + 3]); p[2] = pk2(x[8 * s + 4], x[8 * s + 5]); p[3] = pk2(x[8 * s + 6], x[8 * s + 7]);
    return __builtin_bit_cast(bf16x8, p);
}
DI bf16x8 tr_pair(unsigned tile, int pitch, int s0, int s1, int cbase, int lane) {
    const int i = lane & 15, q = i >> 2, p = i & 3, cb = (lane >> 4) & 1;
    const unsigned a0 = tile + (unsigned)((s0 + q) * pitch + (cbase + 16 * cb + 4 * p) * 2);
    const unsigned a1 = tile + (unsigned)((s1 + q) * pitch + (cbase + 16 * cb + 4 * p) * 2);
    s16x4 lo, hi;
    asm volatile("ds_read_b64_tr_b16 %0, %2\n\tds_read_b64_tr_b16 %1, %3\n\ts_waitcnt lgkmcnt(0)" : "=&v"(lo), "=&v"(hi) : "v"(a0), "v"(a1) : "memory");
    return __builtin_shufflevector(lo, hi, 0, 1, 2, 3, 4, 5, 6, 7);
}

DI int mod_row(int row) { return row < SEQ ? 0 : 1 + ((row - SEQ) >> 3); }

DI int win_src_col(int nb) {
    const int n0 = nb * 32;
    if (n0 < 3072) return n0;
    if (n0 < 5120) {
        const int which = (n0 - 3072) / 1024, rel = (n0 - 3072) % 1024, tile = rel / 256, j0 = rel % 256;
        const int bj = j0 / 128, h2 = (j0 % 128) / 64, ib = (j0 % 64) / 32;
        return 3088 + which * 1024 + (2 * tile + h2) * 128 + bj * 64 + 32 * ib;
    }
    return 5136 + (n0 - 5120);
}
DI void transpose_item(const float* W, int N, int K, bf16* WT, int drow0, int scol0, int k0, LAS float* scr, int lane) {
#pragma unroll 8
    for (int i = 0; i < 32; ++i) { const int kk = 2 * i + (lane >> 5); scr[kk * 33 + (lane & 31)] = ldf(W + (size_t)(k0 + kk) * N + scol0 + (lane & 31)); }
    LDS_WAIT();
    const int c = lane & 7;
#pragma unroll
    for (int j = 0; j < 4; ++j) { const int n = (lane >> 3) + 8 * j; const LAS float* s = scr + (8 * c) * 33 + n;
        u32x4 o; o.x = pk2(s[0 * 33], s[1 * 33]); o.y = pk2(s[2 * 33], s[3 * 33]); o.z = pk2(s[4 * 33], s[5 * 33]); o.w = pk2(s[6 * 33], s[7 * 33]);
        st16(WT + (size_t)(drow0 + n) * K + k0 + 8 * c, o); }
    LDS_WAIT();
}
constexpr int IT_IN = 32 * 192, IT_OUT = 32 * 64, IT_UP = 32 * 352, IT_DN = 88 * 64, IT_LAYER = IT_IN + IT_OUT + IT_UP + IT_DN;

DI void p0_weights(const float* w_in, const float* w_out, const float* w_up, const float* w_down, unsigned char* ws, LAS unsigned char* lds, int gw, int ngw, int wave, int lane) {
    LAS float* scr = (LAS float*)(lds + wave * 16384);
    for (int it = gw; it < 2 * IT_LAYER; it += ngw) {
        const int l = it / IT_LAYER; int r = it % IT_LAYER;
        if (r < IT_IN) { const int kb = r / 192, nb = r % 192;
            transpose_item(w_in + (size_t)l * DM * DIN, DIN, DM, (bf16*)(ws + WS_WIN) + (size_t)l * NINP * DM, nb * 32, win_src_col(nb), kb * 64, scr, lane); continue; }
        r -= IT_IN;
        if (r < IT_OUT) { const int kb = r / 64, nb = r % 64;
            transpose_item(w_out + (size_t)l * DM * DM, DM, DM, (bf16*)(ws + WS_WOUT) + (size_t)l * DM * DM, nb * 32, nb * 32, kb * 64, scr, lane); continue; }
        r -= IT_OUT;
        if (r < IT_UP) { const int kb = r / 352, nb = r % 352;
            transpose_item(w_up + (size_t)l * DM * NUP, NUP, DM, (bf16*)(ws + WS_WUP) + (size_t)l * NUP * DM, nb * 32, nb * 32, kb * 64, scr, lane); continue; }
        r -= IT_UP;
        { const int kb = r / 64, nb = r % 64;
            transpose_item(w_down + (size_t)l * DFF * DM, DM, DFF, (bf16*)(ws + WS_WDN) + (size_t)l * DM * DFF, nb * 32, nb * 32, kb * 64, scr, lane); }
    }
}
DI void p0_rope(float* cosT, float* sinT, int gt, int ngt) {
    for (int e = gt; e < 8200 * 64; e += ngt) {
        const int pos = e >> 6, i = e & 63;
        double inv = 1.0;
        if (i & 1) inv *= 0.8659643233600653;
        if (i & 2) inv *= 0.7498942093324559;
        if (i & 4) inv *= 0.5623413251903491;
        if (i & 8) inv *= 0.31622776601683794;
        if (i & 16) inv *= 0.1;
        if (i & 32) inv *= 0.01;
        double rev = (double)pos * inv * 0.15915494309189535;
        rev = rev - __builtin_rint(rev);
        const float fr = (float)rev;
        stf(cosT + e, __builtin_amdgcn_cosf(fr)); stf(sinT + e, __builtin_amdgcn_sinf(fr));
    }
}
DI void p0_mod(const float* c_prompt, const float* c_sample, const float* w_ada, const float* b_ada, float* MOD, LAS unsigned char* lds, int bid, int G, int tid, int wave, int lane) {
    LAS float* cpl = (LAS float*)(lds + 65536);
    LAS float* red = (LAS float*)(lds + 65536 + 8192);
    const int h = lane >> 5, r31 = lane & 31, kbase = 256 * wave;
    for (int i = tid; i < DM; i += NTHR) cpl[i] = siluf_(ldf(c_prompt + i));
    __syncthreads();
    for (int item = bid; item < 768; item += G) {
        const int l = item / 384, n0 = (item % 384) * 32;
        const float* W = w_ada + (size_t)l * DM * NMOD + n0 + r31;
        f32x16 acc = zero16(); float pacc = 0.f;
#pragma unroll 4
        for (int ks = 0; ks < 16; ++ks) { const int k0 = kbase + 16 * ks + 8 * h; float w[8];
#pragma unroll
            for (int j = 0; j < 8; ++j) w[j] = ldf(W + (size_t)(k0 + j) * NMOD);
            const float* cp = c_sample + (size_t)r31 * DM + k0; const f32x4 ca = ld4(cp), cb = ld4(cp + 4);
            u32x4 pa; pa.x = pk2(siluf_(ca.x), siluf_(ca.y)); pa.y = pk2(siluf_(ca.z), siluf_(ca.w)); pa.z = pk2(siluf_(cb.x), siluf_(cb.y)); pa.w = pk2(siluf_(cb.z), siluf_(cb.w));
            u32x4 p; p.x = pk2(w[0], w[1]); p.y = pk2(w[2], w[3]); p.z = pk2(w[4], w[5]); p.w = pk2(w[6], w[7]);
            acc = MFMA32(__builtin_bit_cast(bf16x8, pa), __builtin_bit_cast(bf16x8, p), acc);
            const LAS f32x4* cq = (const LAS f32x4*)(cpl + k0); const f32x4 c0 = cq[0], c1 = cq[1];
            pacc += c0.x * w[0] + c0.y * w[1] + c0.z * w[2] + c0.w * w[3] + c1.x * w[4] + c1.y * w[5] + c1.z * w[6] + c1.w * w[7]; }
        pacc += __shfl_xor(pacc, 32);
#pragma unroll
        for (int reg = 0; reg < 16; ++reg) red[(wave * 33 + 1 + crow(reg, h)) * 32 + r31] = acc[reg];
        if (h == 0) red[(wave * 33) * 32 + r31] = pacc;
        __syncthreads();
        for (int i = tid; i < 33 * 32; i += NTHR) { const int r = i >> 5, c = i & 31; float s = 0.f;
#pragma unroll
            for (int w = 0; w < 8; ++w) s += red[(w * 33 + r) * 32 + c];
            stf(MOD + ((size_t)l * 33 + r) * NMOD + n0 + c, s + ldf(b_ada + (size_t)l * NMOD + n0 + c)); }
        __syncthreads();
    }
}
DI void load_gate_w(const float* w_in_l, LAS float* Wg, int tid) {
    for (int i = tid; i < DM * 16; i += NTHR) { const int k = i >> 4, c = i & 15; Wg[c * DM + k] = ldf(w_in_l + (size_t)k * DIN + 3072 + c); }
}
DI void gate_row(const f32x4 (&v)[8], const LAS float* Wg, const float* bgate, float* IG, float* LF, int row, int lane) {
    float p[16];
#pragma unroll
    for (int c = 0; c < 16; ++c) { float a = 0.f;
#pragma unroll
        for (int j = 0; j < 8; ++j) { const f32x4 w = *(const LAS f32x4*)(Wg + c * DM + 256 * j + 4 * lane); a += v[j].x * w.x + v[j].y * w.y + v[j].z * w.z + v[j].w * w.w; }
        p[c] = a; asm volatile("" ::: "memory"); }
    float q[8], r[4], t2[2], t1;
    { const bool hi = (lane & 32) != 0;
#pragma unroll
      for (int i = 0; i < 8; ++i) { const float keep = hi ? p[8 + i] : p[i], send = hi ? p[i] : p[8 + i]; q[i] = keep + __shfl_xor(send, 32); } }
    { const bool hi = (lane & 16) != 0;
#pragma unroll
      for (int i = 0; i < 4; ++i) { const float keep = hi ? q[4 + i] : q[i], send = hi ? q[i] : q[4 + i]; r[i] = keep + __shfl_xor(send, 16); } }
    { const bool hi = (lane & 8) != 0;
#pragma unroll
      for (int i = 0; i < 2; ++i) { const float keep = hi ? r[2 + i] : r[i], send = hi ? r[i] : r[2 + i]; t2[i] = keep + __shfl_xor(send, 8); } }
    { const bool hi = (lane & 4) != 0; const float keep = hi ? t2[1] : t2[0], send = hi ? t2[0] : t2[1]; t1 = keep + __shfl_xor(send, 4); }
    t1 += __shfl_xor(t1, 2); t1 += __shfl_xor(t1, 1);
    if ((lane & 3) == 0) { const int c = (lane >> 2) & 15;
        const float x = t1 + ldf(bgate + c);
        if (c < 8) stf(IG + (size_t)row * 8 + c, x); else stf(LF + (size_t)row * 8 + (c - 8), logsigmoidf_(x)); }
}
DI void row_load(const float* p, f32x4 (&v)[8], int lane) {
#pragma unroll
    for (int j = 0; j < 8; ++j) v[j] = ld4(p + 4 * lane + 256 * j);
}
DI void modulate_fin(f32x4 (&v)[8], const float* sh, const float* sc, bf16* urow, const LAS float* Wg, const float* bgate, float* IG, float* LF, int row, int lane) {
#pragma unroll
    for (int j = 0; j < 8; ++j) { const int col = 4 * lane + 256 * j; const f32x4 a = ld4(sc + col), b = ld4(sh + col);
        v[j] = v[j] * (a + 1.f) + b; u32x2 o; o.x = pk2(v[j].x, v[j].y); o.y = pk2(v[j].z, v[j].w); st8(urow + col, o); }
    gate_row(v, Wg, bgate, IG, LF, row, lane);
}
DI void ln_fin(f32x4 (&v)[8], const float* g, const float* b, float* xo, const float* sh, const float* sc, bf16* urow,
               const LAS float* Wg, bool gates, const float* bgate, float* IG, float* LF, int row, int lane) {
    float s = 0.f;
#pragma unroll
    for (int j = 0; j < 8; ++j) s += (v[j].x + v[j].y) + (v[j].z + v[j].w);
    const float mean = wave_sum(s) * (1.f / DM); float s2 = 0.f;
#pragma unroll
    for (int j = 0; j < 8; ++j) { v[j] = v[j] - mean; s2 += (v[j].x * v[j].x + v[j].y * v[j].y) + (v[j].z * v[j].z + v[j].w * v[j].w); }
    const float rstd = 1.f / sqrtf(wave_sum(s2) * (1.f / DM) + 1e-5f);
#pragma unroll
    for (int j = 0; j < 8; ++j) { const int col = 4 * lane + 256 * j; const f32x4 gg = ld4(g + col), bb = ld4(b + col); const f32x4 o = v[j] * rstd * gg + bb; st4(xo + col, o);
        if (urow) { const f32x4 a = ld4(sc + col), c = ld4(sh + col); v[j] = o * (a + 1.f) + c; u32x2 w; w.x = pk2(v[j].x, v[j].y); w.y = pk2(v[j].z, v[j].w); st8(urow + col, w); } }
    if (gates) gate_row(v, Wg, bgate, IG, LF, row, lane);
}
DI void slab_row_load(const float* slab, int nslab, const float* res, const float* gate, f32x4 (&v)[8], int lane) {
#pragma unroll
    for (int j = 0; j < 8; ++j) { const int col = 4 * lane + 256 * j; f32x4 a = ld4(slab + col);
        for (int q = 1; q < nslab; ++q) a += ld4(slab + (size_t)q * NSMP * DM + col);
        v[j] = ld4(res + col) * ALPHA_RES + (ld4(gate + col) + 1.f) * a; }
}
#define XB_TMO      128
#define XB_XCNT(j)  (256  + 64 * (j))
#define XB_XSUB(j)  (1280 + 64 * (j))
#define XB_XGEN(j)  (2304 + 64 * (j))
#define XB_TOP      3328
#define XB_TOPGEN   3392
#define XCD_BAR_WORDS 3456
#define XB_SPIN_CAP (1u << 18)

__device__ __forceinline__ unsigned xb_ld(unsigned* p)              { return __hip_atomic_load(p, __ATOMIC_RELAXED, __HIP_MEMORY_SCOPE_AGENT); }
__device__ __forceinline__ unsigned xb_add(unsigned* p, unsigned v) { return __hip_atomic_fetch_add(p, v, __ATOMIC_RELAXED, __HIP_MEMORY_SCOPE_AGENT); }
__device__ __forceinline__ unsigned xb_xcc_id() { return (unsigned)__builtin_amdgcn_s_getreg((3 << 11) | 20) & 0xFu; }
#define XB_SPIN(cond, bar) do { unsigned _sp = 0; while (cond) { __builtin_amdgcn_s_sleep(1); \
    if ((++_sp & 255u) == 0u) { if (xb_ld(&(bar)[XB_TMO])) break; if (_sp > XB_SPIN_CAP) { atomicAdd(&(bar)[XB_TMO], 1u); break; } } } } while (0)

struct XcdBarrier {
    unsigned* bar; unsigned x;
    volatile LAS unsigned* st;
};

__device__ __forceinline__ XcdBarrier xcd_barrier_post(unsigned* bar, volatile LAS unsigned* st) {
    XcdBarrier b; b.bar = bar; b.x = xb_xcc_id(); b.st = st;
    if (threadIdx.x == 0) (void)xb_add(&bar[XB_XCNT(b.x)], 1u);
    return b;
}
__device__ __forceinline__ void xcd_barrier_complete(unsigned* bar, unsigned x, unsigned& nloc, unsigned& nx) {
    const unsigned G = gridDim.x * gridDim.y * gridDim.z;
    unsigned sum, cnt, mine, sp = 0u;
    for (;;) {
        sum = 0u; cnt = 0u; mine = 0u;
#pragma unroll
        for (unsigned j = 0; j < 16; ++j) { const unsigned c = xb_ld(&bar[XB_XCNT(j)]); sum += c; cnt += (c > 0u) ? 1u : 0u; mine = (j == x) ? c : mine; }
        if (sum == G) break;
        __builtin_amdgcn_s_sleep(1);
        if ((++sp & 255u) == 0u) { if (xb_ld(&bar[XB_TMO])) break; if (sp > XB_SPIN_CAP) { atomicAdd(&bar[XB_TMO], 1u); break; } }
    }
    nloc = mine > 0u ? mine : 1u; nx = cnt > 0u ? cnt : 1u;
}

__device__ __forceinline__ void xcd_barrier(const XcdBarrier& b) {
    asm volatile("s_waitcnt vmcnt(0)" ::: "memory");
    __syncthreads();
    if (threadIdx.x == 0) {
        unsigned* bar = b.bar;
        __builtin_amdgcn_s_waitcnt(0);
        unsigned nloc = b.st[0], nx = b.st[1];
        if (nloc == 0u) { xcd_barrier_complete(bar, b.x, nloc, nx); b.st[0] = nloc; b.st[1] = nx; }
        const unsigned old = xb_add(&bar[XB_XSUB(b.x)], 1u);
        const unsigned gen = old / nloc;
        if (old + 1u == (gen + 1u) * nloc) {
            __builtin_amdgcn_fence(__ATOMIC_RELEASE, "agent");
            asm volatile("s_waitcnt vmcnt(0)" ::: "memory");
            const unsigned og = xb_add(&bar[XB_TOP], 1u);
            const unsigned tg = og / nx;
            if (og + 1u == (tg + 1u) * nx) xb_add(&bar[XB_TOPGEN], 1u);
            else XB_SPIN(xb_ld(&bar[XB_TOPGEN]) == tg, bar);
            __builtin_amdgcn_fence(__ATOMIC_ACQUIRE, "agent");
            xb_add(&bar[XB_XGEN(b.x)], 1u);
            asm volatile("s_waitcnt vmcnt(0)" ::: "memory");
        } else {
            XB_SPIN(xb_ld(&bar[XB_XGEN(b.x)]) == gen, bar);
            __builtin_amdgcn_fence(__ATOMIC_ACQUIRE, "agent");
            asm volatile("s_waitcnt vmcnt(0)" ::: "memory");
        }
    }
    __syncthreads();
}

DI u32x4 pack8(f32x4 a, f32x4 b) { u32x4 w; w.x = pg8::cvt_pk_bf16(a[0], a[1]); w.y = pg8::cvt_pk_bf16(a[2], a[3]); w.z = pg8::cvt_pk_bf16(b[0], b[1]); w.w = pg8::cvt_pk_bf16(b[2], b[3]); return w; }

struct EpiIn {
    static constexpr bool PERM = true, AFTER_DRAIN = false;
    unsigned char* wsb; float* outb; int l;
    DI void operator()(const f32x4 (&acc)[2][2][4][2], const pg8::Unit& u, int wr, int wc, int fr, int fq) const {
        bf16* P = (bf16*)(wsb + WS_P); const float* cosT = (const float*)(wsb + WS_ROPE); const float* sinT = cosT + 8200 * 64;
        float* kp = outb + O_KP + (size_t)l * 2048 * 1024; float* vp = outb + O_VP + (size_t)l * 2048 * 1024; float* ks = outb + O_KS + (size_t)l * NSMP * 1024; float* vs = outb + O_VS + (size_t)l * NSMP * 1024;
        const int pn = u.pn, rowb = u.pm * 256 + wr * 64 + fr;
        if (pn < 12 || pn >= 20) {
            const float sc = (pn == 2 || pn == 3) ? 0.125f : 1.f;
            const int colP = (pn < 12 ? pn * 256 : 5120 + (pn - 20) * 256) + wc * 32 + 8 * fq;
#pragma unroll
            for (int ai = 0; ai < 2; ++ai)
#pragma unroll
                for (int m = 0; m < 4; ++m) { const int row = rowb + ai * 128 + m * 16; bf16* rp = P + (size_t)row * PW + colP;
                    float* o = nullptr;
                    if (pn >= 20) { if (row >= SEQ) o = vs + (size_t)(row - SEQ) * 1024; else if (row >= SEQ - 2048) o = vp + (size_t)(row - (SEQ - 2048)) * 1024; }
#pragma unroll
                    for (int bj = 0; bj < 2; ++bj) { st16(rp + bj * 128, pack8(acc[ai][bj][m][0] * sc, acc[ai][bj][m][1] * sc));
                        if (o) { float* oc = o + (pn - 20) * 256 + bj * 128 + wc * 32 + 8 * fq; st4(oc, acc[ai][bj][m][0]); st4(oc + 4, acc[ai][bj][m][1]); } } }
        } else {
            const bool isq = pn < 16; const int tile = (pn - 12) & 3, head = 2 * tile + (wc >> 1), i0 = 32 * (wc & 1) + 8 * fq;
            const float qs = isq ? QSCALE : 1.f;
            const int colP = (isq ? 3072 : 4096) + head * 128 + i0;
#pragma unroll
            for (int ai = 0; ai < 2; ++ai)
#pragma unroll
                for (int m = 0; m < 4; ++m) { const int row = rowb + ai * 128 + m * 16; const int pos = row < SEQ ? row : SEQ + ((row - SEQ) & 7);
                    const f32x4 c0 = ld4(cosT + pos * 64 + i0), c1 = ld4(cosT + pos * 64 + i0 + 4), s0 = ld4(sinT + pos * 64 + i0), s1 = ld4(sinT + pos * 64 + i0 + 4);
                    const f32x4 x1a = acc[ai][0][m][0], x1b = acc[ai][0][m][1], x2a = acc[ai][1][m][0], x2b = acc[ai][1][m][1];
                    const f32x4 o1a = (x1a * c0 - x2a * s0) * qs, o1b = (x1b * c1 - x2b * s1) * qs, o2a = (x2a * c0 + x1a * s0) * qs, o2b = (x2b * c1 + x1b * s1) * qs;
                    bf16* rp = P + (size_t)row * PW + colP; st16(rp, pack8(o1a, o1b)); st16(rp + 64, pack8(o2a, o2b));
                    if (!isq) { float* o = nullptr; if (row >= SEQ) o = ks + (size_t)(row - SEQ) * 1024; else if (row >= SEQ - 2048) o = kp + (size_t)(row - (SEQ - 2048)) * 1024;
                        if (o) { o += head * 128 + i0; st4(o, o1a); st4(o + 4, o1b); st4(o + 64, o2a); st4(o + 68, o2b); } }
                    asm volatile("" ::: "memory"); }
        }
    }
};
struct EpiRes {
    static constexpr bool PERM = false, AFTER_DRAIN = false;
    float* Y; const float* resP; const float* gate; float* slab;
    DI void operator()(const f32x4 (&acc)[2][2][4][2], const pg8::Unit& u, int wr, int wc, int fr, int fq) const {
        const int rowb = u.pm * 256 + wr * 64 + fr, col0 = u.pn * 256 + wc * 32 + 4 * fq;
        if (u.pm >= 32) {
#pragma unroll
            for (int ai = 0; ai < 2; ++ai)
#pragma unroll
                for (int m = 0; m < 4; ++m) { float* sp = slab + ((size_t)u.ks * NSMP + (wr * 64 + fr + ai * 128 + m * 16)) * DM + col0;
#pragma unroll
                    for (int bj = 0; bj < 2; ++bj)
#pragma unroll
                        for (int n = 0; n < 2; ++n) st4(sp + bj * 128 + n * 16, acc[ai][bj][m][n]); }
            return;
        }
#pragma unroll
        for (int ai = 0; ai < 2; ++ai)
#pragma unroll
            for (int m = 0; m < 4; ++m) { const int row = rowb + ai * 128 + m * 16;
                const float* res = resP + (size_t)row * DM; const float* gp = gate; float* yp = Y + (size_t)row * DM;
#pragma unroll
                for (int bj = 0; bj < 2; ++bj)
#pragma unroll
                    for (int n = 0; n < 2; ++n) { const int col = col0 + bj * 128 + n * 16; const f32x4 r = ld4(res + col), g = ld4(gp + col);
                        st4(yp + col, r * ALPHA_RES + (g + 1.f) * acc[ai][bj][m][n]); }
                asm volatile("" ::: "memory"); }
    }
};
struct EpiUp {
    static constexpr bool PERM = true, AFTER_DRAIN = false;
    bf16* GV; float* bp; float* bs;
    DI void operator()(const f32x4 (&acc)[2][2][4][2], const pg8::Unit& u, int wr, int wc, int fr, int fq) const {
        const int rowb = u.pm * 256 + wr * 64 + fr, colb = u.pn * 256 + wc * 32 + 8 * fq;
#pragma unroll
        for (int ai = 0; ai < 2; ++ai)
#pragma unroll
            for (int m = 0; m < 4; ++m) { const int row = rowb + ai * 128 + m * 16; bf16* rp = GV + (size_t)row * NUP + colb;
                float* o = nullptr;
                if (u.pn < 22) { if (row < SEQ) { if (row >= SEQ - 2) o = bp + (size_t)(row - (SEQ - 2)) * DFF; } else { const int t = (row - SEQ) & 7; if (t >= 6) o = bs + ((size_t)((row - SEQ) >> 3) * 2 + (t - 6)) * DFF; } }
#pragma unroll
                for (int bj = 0; bj < 2; ++bj) { st16(rp + bj * 128, pack8(acc[ai][bj][m][0], acc[ai][bj][m][1]));
                    if (o) { st4(o + colb + bj * 128, acc[ai][bj][m][0]); st4(o + colb + bj * 128 + 4, acc[ai][bj][m][1]); } } }
    }
};

constexpr int VPITCH = 272, KPITCH = 144;

DI void attn_prompt_unit(const bf16* P, bf16* OP, float* ML, int u, LAS unsigned char* lds, unsigned ldsbase, int wave, int lane) {
    const int br = u >> 8, rem = u & 255, head = rem >> 5, blk = rem & 31;
    const int ld = 2 * br;
    const int sb = blk * 8 + wave, nbl = 8 - ld;
    const int r = sb >> nbl, u0 = (sb & ((1 << nbl) - 1)) << 5;
    const int r31 = lane & 31, h = lane >> 5;
    const unsigned vt = ldsbase + (unsigned)wave * (32 * VPITCH); LAS unsigned char* vtp = lds + wave * (32 * VPITCH);
    const int tokq = ((u0 + r31) << ld) + r;
    bf16x8 Qf[8];
    { const bf16* qp = P + (size_t)tokq * PW + 3072 + head * 128 + 8 * h;
#pragma unroll
      for (int ks = 0; ks < 8; ++ks) Qf[ks] = ldfrag(qp + 16 * ks); }
    f32x16 O[4];
#pragma unroll
    for (int d = 0; d < 4; ++d) O[d] = zero16();
    float mrun = -1e30f, lrun = 0.f;
    for (int jt = 0; jt < 5; ++jt) {
        const int ub = u0 - 128 + 32 * jt;
        if (ub < 0) continue;
        const bf16* kp = P + (size_t)(((ub + r31) << ld) + r) * PW + 4096 + head * 128 + 8 * h;
        bf16x8 Kf[8];
#pragma unroll
        for (int ks = 0; ks < 8; ++ks) Kf[ks] = ldfrag(kp + 16 * ks);
        u32x4 vst[8];
#pragma unroll
        for (int i = 0; i < 8; ++i) { const int row = 4 * i + (lane >> 4), ch = lane & 15; vst[i] = ld16(P + (size_t)(((ub + row) << ld) + r) * PW + 5120 + head * 128 + ch * 8); }
        f32x16 S = zero16();
#pragma unroll
        for (int ks = 0; ks < 8; ++ks) S = MFMA32(Kf[ks], Qf[ks], S);
#pragma unroll
        for (int i = 0; i < 8; ++i) { const int row = 4 * i + (lane >> 4), ch = lane & 15; *(LAS u32x4*)(vtp + row * VPITCH + ch * 16) = vst[i]; }
        float tmax = -INFINITY;
#pragma unroll
        for (int reg = 0; reg < 16; ++reg) { const int kk = crow(reg, h); const bool ok = (jt == 0) ? (kk >= r31) : ((jt == 4) ? (kk <= r31) : true);
            S[reg] = ok ? S[reg] : -INFINITY; tmax = fmaxf(tmax, S[reg]); }
        tmax = fmaxf(tmax, __shfl_xor(tmax, 32));
        const float mnew = fmaxf(mrun, tmax), alpha = fexp2(mrun - mnew); mrun = mnew;
        float psum = 0.f;
#pragma unroll
        for (int reg = 0; reg < 16; ++reg) { S[reg] = fexp2(S[reg] - mnew); psum += S[reg]; }
        psum += __shfl_xor(psum, 32);
        lrun = lrun * alpha + psum;
#pragma unroll
        for (int d = 0; d < 4; ++d) O[d] = O[d] * alpha;
        const bf16x8 P0 = pack_step(S, 0), P1 = pack_step(S, 1);
        LDS_WAIT();
#pragma unroll
        for (int d = 0; d < 4; ++d) {
            const bf16x8 A0 = tr_pair(vt, VPITCH, 4 * h, 8 + 4 * h, 32 * d, lane);
            O[d] = MFMA32(A0, P0, O[d]);
            const bf16x8 A1 = tr_pair(vt, VPITCH, 16 + 4 * h, 24 + 4 * h, 32 * d, lane);
            O[d] = MFMA32(A1, P1, O[d]);
        }
    }
    const float inv = 1.f / lrun;
    bf16* op = OP + ((size_t)br * SEQ + tokq) * 1024 + head * 128;
#pragma unroll
    for (int d = 0; d < 4; ++d)
#pragma unroll
        for (int g = 0; g < 4; ++g) { u32x2 w; w.x = pk2(O[d][4 * g] * inv, O[d][4 * g + 1] * inv); w.y = pk2(O[d][4 * g + 2] * inv, O[d][4 * g + 3] * inv); st8(op + 32 * d + 8 * g + 4 * h, w); }
    if (h == 0) { float* mp = ML + (((size_t)br * SEQ + tokq) * 8 + head) * 2; stf(mp, mrun); stf(mp + 1, lrun); }
}

DI void mlstm_m1_item(const bf16* P, const float* IG, const float* LF, float* SCAL, float* DCT, int it, LAS unsigned char* lds, unsigned ldsbase, int wave, int lane) {
    const int half = wave >> 2, wq = wave & 3, unit = it * 2 + half, c = unit >> 3, hd = unit & 7, row0 = c * LCH;
    const int hoff = half * 32768;
    LAS unsigned char* Vt = lds + hoff; LAS unsigned char* Kt = lds + hoff + 64 * VPITCH; LAS float* sc = (LAS float*)(lds + hoff + 64 * VPITCH + 64 * KPITCH);
    const int r31 = lane & 31, h = lane >> 5, t256 = wq * 64 + lane;
    if (wq == 0) {
        const float lf = ldf(LF + (size_t)(row0 + lane) * 8 + hd), ig = ldf(IG + (size_t)(row0 + lane) * 8 + hd);
        float b = lf;
#pragma unroll
        for (int o = 1; o < 64; o <<= 1) { const float t = __shfl_up(b, o); if (lane >= o) b += t; }
        const float d = ig - b; float pm = d;
#pragma unroll
        for (int o = 1; o < 64; o <<= 1) { const float t = __shfl_up(pm, o); if (lane >= o) pm = fmaxf(pm, t); }
        const float pm63 = __shfl(pm, 63);
        sc[lane] = fexp(d - pm63);
        float* sp = SCAL + (size_t)unit * 192; stf(sp + lane, b); stf(sp + 64 + lane, d); stf(sp + 128 + lane, pm);
    }
#pragma unroll
    for (int i = 0; i < 4; ++i) { const int id = i * 256 + t256, row = id >> 4, ch = id & 15;
        *(LAS u32x4*)(Vt + row * VPITCH + ch * 16) = ld16(P + (size_t)(row0 + row) * PW + 1024 + hd * 128 + ch * 8); }
    __syncthreads();
#pragma unroll
    for (int i = 0; i < 2; ++i) { const int id = i * 256 + t256, row = id >> 3, ch = id & 7; const float w = sc[row];
        const u32x4 kv = ld16(P + (size_t)(row0 + row) * PW + 512 + hd * 64 + ch * 8); u32x4 o;
        o.x = pk2(bflo(kv.x) * w, bfhi(kv.x) * w); o.y = pk2(bflo(kv.y) * w, bfhi(kv.y) * w); o.z = pk2(bflo(kv.z) * w, bfhi(kv.z) * w); o.w = pk2(bflo(kv.w) * w, bfhi(kv.w) * w);
        *(LAS u32x4*)(Kt + row * KPITCH + ch * 16) = o; }
    __syncthreads();
    f32x16 a0 = zero16(), a1 = zero16();
    const unsigned vtb = ldsbase + hoff, ktb = ldsbase + hoff + 64 * VPITCH;
#pragma unroll
    for (int ks = 0; ks < 4; ++ks) {
        const bf16x8 A = tr_pair(vtb, VPITCH, 16 * ks + 8 * h, 16 * ks + 8 * h + 4, 32 * wq, lane);
        const bf16x8 B0 = tr_pair(ktb, KPITCH, 16 * ks + 8 * h, 16 * ks + 8 * h + 4, 0, lane);
        const bf16x8 B1 = tr_pair(ktb, KPITCH, 16 * ks + 8 * h, 16 * ks + 8 * h + 4, 32, lane);
        a0 = MFMA32(A, B0, a0); a1 = MFMA32(A, B1, a1);
    }
    float* dp = DCT + (size_t)unit * (129 * 64);
#pragma unroll
    for (int reg = 0; reg < 16; ++reg) { const int dv = 32 * wq + crow(reg, h); stf(dp + dv * 64 + r31, a0[reg]); stf(dp + dv * 64 + 32 + r31, a1[reg]); }
    if (wq == 1) { float s = 0.f;
#pragma unroll 8
        for (int r = 0; r < 64; ++r) s += bf2f(*(const LAS unsigned short*)(Kt + r * KPITCH + lane * 2));
        stf(dp + 128 * 64 + lane, s); }
    __syncthreads();
}

DI void mlstm_m2(const float* SCAL, const float* DCT, bf16* CST, float* MST, float* outC, float* outN, float* outM, int e) {
    const int hd = e / 8256, idx = e % 8256;
    float C = 0.f, m = 0.f;
#pragma unroll 4
    for (int c = 0; c < NCH; ++c) {
        const int unit = c * 8 + hd;
        const float Bc = ldf(SCAL + (size_t)unit * 192 + 63), pmc = ldf(SCAL + (size_t)unit * 192 + 191), Ac = Bc + pmc;
        const float dc = ldf(DCT + (size_t)unit * 8256 + idx);
        const float mn = fmaxf(Bc + m, Ac), f1 = fexp(Bc + m - mn), f2 = fexp(Ac - mn);
        *(GAS unsigned short*)(CST + (size_t)unit * (160 * 64) + idx) = (unsigned short)f2bf(C);
        if (idx == 0) stf(MST + unit, m);
        C = f1 * C + f2 * dc; m = mn;
    }
    const int row = idx >> 6, dk = idx & 63;
    if (row < 128) stf(outC + (size_t)hd * 8192 + dk * 128 + row, C); else stf(outN + hd * 64 + dk, C);
    if (idx == 0) stf(outM + hd, m);
}
DI void attn_combine(const bf16* OP, const float* ML, bf16* CAT, int e) {
    const int tok = e >> 7, c8 = e & 127, head = c8 >> 4;
    float m[3], l[3];
#pragma unroll
    for (int b = 0; b < 3; ++b) { const float* mp = ML + (((size_t)b * SEQ + tok) * 8 + head) * 2; m[b] = ldf(mp); l[b] = ldf(mp + 1); }
    const float M = fmaxf(m[0], fmaxf(m[1], m[2]));
    float w[3], ws = 0.f;
#pragma unroll
    for (int b = 0; b < 3; ++b) { w[b] = fexp2(m[b] - M) * l[b]; ws += w[b]; }
    const float inv = 1.f / ws; float o[8];
#pragma unroll
    for (int j = 0; j < 8; ++j) o[j] = 0.f;
#pragma unroll
    for (int b = 0; b < 3; ++b) { const u32x4 v = ld16(OP + ((size_t)b * SEQ + tok) * 1024 + c8 * 8); const float wb = w[b] * inv;
        o[0] += wb * bflo(v.x); o[1] += wb * bfhi(v.x); o[2] += wb * bflo(v.y); o[3] += wb * bfhi(v.y); o[4] += wb * bflo(v.z); o[5] += wb * bfhi(v.z); o[6] += wb * bflo(v.w); o[7] += wb * bfhi(v.w); }
    u32x4 r; r.x = pk2(o[0], o[1]); r.y = pk2(o[2], o[3]); r.z = pk2(o[4], o[5]); r.w = pk2(o[6], o[7]);
    st16(CAT + (size_t)tok * DM + 1024 + c8 * 8, r);
}

DI void mlstm_m3_item(const bf16* P, const float* SCAL, const bf16* CST, const float* MST, const float* ghead, bf16* CAT, int it, LAS unsigned char* lds, unsigned ldsbase, int wave, int lane) {
    const int slot = wave >> 1, tw = wave & 1, unit = it * 4 + slot, c = unit >> 3, hd = unit & 7, row0 = c * LCH;
    const int r31 = lane & 31, h = lane >> 5, t = 32 * tw + r31;
    LAS unsigned char* Vt = lds + slot * (64 * VPITCH); const unsigned vtb = ldsbase + slot * (64 * VPITCH);
    { const int t128 = tw * 64 + lane;
#pragma unroll
      for (int i = 0; i < 8; ++i) { const int id = i * 128 + t128, row = id >> 4, ch = id & 15;
          *(LAS u32x4*)(Vt + row * VPITCH + ch * 16) = ld16(P + (size_t)(row0 + row) * PW + 1024 + hd * 128 + ch * 8); } }
    const float* sp = SCAL + (size_t)unit * 192;
    const float mc = ldf(MST + unit), bt = ldf(sp + t), pmt = ldf(sp + 128 + t);
    const float Mt = fmaxf(mc, pmt), gt = fexp(mc - Mt);
    bf16x8 Qf[4], Qg[4];
    { const bf16* qp = P + (size_t)(row0 + t) * PW + hd * 64 + 8 * h;
#pragma unroll
      for (int ks = 0; ks < 4; ++ks) { const u32x4 q = ld16(qp + 16 * ks); Qf[ks] = __builtin_bit_cast(bf16x8, q); u32x4 g;
          g.x = pk2(bflo(q.x) * gt, bfhi(q.x) * gt); g.y = pk2(bflo(q.y) * gt, bfhi(q.y) * gt); g.z = pk2(bflo(q.z) * gt, bfhi(q.z) * gt); g.w = pk2(bflo(q.w) * gt, bfhi(q.w) * gt); Qg[ks] = __builtin_bit_cast(bf16x8, g); } }
    f32x16 acc[5];
#pragma unroll
    for (int d = 0; d < 5; ++d) acc[d] = zero16();
    { const bf16* cp = CST + (size_t)unit * (160 * 64) + (size_t)r31 * 64 + 8 * h;
#pragma unroll
      for (int d = 0; d < 5; ++d)
#pragma unroll
          for (int ks = 0; ks < 4; ++ks) acc[d] = MFMA32(ldfrag(cp + d * 32 * 64 + 16 * ks), Qg[ks], acc[d]); }
    __syncthreads();
    float rowsum = 0.f;
    for (int st = 0; st <= tw; ++st) {
        const bf16* kp = P + (size_t)(row0 + 32 * st + r31) * PW + 512 + hd * 64 + 8 * h;
        f32x16 S = zero16();
#pragma unroll
        for (int ks = 0; ks < 4; ++ks) S = MFMA32(ldfrag(kp + 16 * ks), Qf[ks], S);
#pragma unroll
        for (int g = 0; g < 4; ++g) { const f32x4 dv = ld4(sp + 64 + 32 * st + 8 * g + 4 * h);
#pragma unroll
            for (int e = 0; e < 4; ++e) { const int kk = 8 * g + 4 * h + e; const bool ok = (st < tw) || (kk <= r31);
                const float p = ok ? S[4 * g + e] * fexp(dv[e] - Mt) : 0.f; S[4 * g + e] = p; rowsum += p; } }
        const bf16x8 P0 = pack_step(S, 0), P1 = pack_step(S, 1);
#pragma unroll
        for (int d = 0; d < 4; ++d) {
            const bf16x8 A0 = tr_pair(vtb, VPITCH, 32 * st + 4 * h, 32 * st + 8 + 4 * h, 32 * d, lane);
            acc[d] = MFMA32(A0, P0, acc[d]);
            const bf16x8 A1 = tr_pair(vtb, VPITCH, 32 * st + 16 + 4 * h, 32 * st + 24 + 4 * h, 32 * d, lane);
            acc[d] = MFMA32(A1, P1, acc[d]);
        }
    }
    rowsum += __shfl_xor(rowsum, 32);
    const float qn = __shfl(acc[4][0], r31);
    const float den = qn + rowsum, dn = fmaxf(fabsf(den), fexp(-(bt + Mt))), inv = 1.f / dn;
    float ss = 0.f;
#pragma unroll
    for (int d = 0; d < 4; ++d)
#pragma unroll
        for (int reg = 0; reg < 16; ++reg) { acc[d][reg] *= inv; ss += acc[d][reg] * acc[d][reg]; }
    ss += __shfl_xor(ss, 32);
    const float rn = 1.f / sqrtf(ss * (1.f / 128.f) + 1e-6f);
    const bf16* omp = P + (size_t)(row0 + t) * PW + 2048 + hd * 128; bf16* cp = CAT + (size_t)(row0 + t) * DM + hd * 128;
#pragma unroll
    for (int d = 0; d < 4; ++d)
#pragma unroll
        for (int g = 0; g < 4; ++g) { const int dv0 = 32 * d + 8 * g + 4 * h; const f32x4 gh = ld4(ghead + hd * 128 + dv0); const u32x2 om = ld8(omp + dv0);
            const float o0 = acc[d][4 * g] * rn * gh.x * sigmoidf_(bflo(om.x)), o1 = acc[d][4 * g + 1] * rn * gh.y * sigmoidf_(bfhi(om.x));
            const float o2 = acc[d][4 * g + 2] * rn * gh.z * sigmoidf_(bflo(om.y)), o3 = acc[d][4 * g + 3] * rn * gh.w * sigmoidf_(bfhi(om.y));
            u32x2 w; w.x = pk2(o0, o1); w.y = pk2(o2, o3); st8(cp + dv0, w); }
    __syncthreads();
}

DI void sample_mlstm_unit(const bf16* P, const float* IG, const float* LF, const float* C0g, const float* n0g, const float* m0g, const float* ghead, bf16* CAT,
                          float* outC, float* outN, float* outM, int b, int hd, LAS unsigned char* lds, int tid, int wave, int lane) {
    LAS float* q = (LAS float*)lds;
    LAS float* k = q + 512;
    LAS float* v = k + 512;
    LAS float* S = v + 1024;
    LAS float* sb = S + 64;
    LAS float* sd = sb + 8;
    LAS float* sM = sd + 8;
    LAS float* sg = sM + 8;
    LAS float* sqn = sg + 8;
    LAS float* sdi = sqn + 8;
    LAS float* sss = sdi + 8;
    LAS float* skw = sss + 16;
    const int R0 = SEQ + 8 * b;
    { const int t = tid >> 6, dk = tid & 63;
      q[tid] = bf2f(*(const GAS unsigned short*)(P + (size_t)(R0 + t) * PW + hd * 64 + dk));
      k[tid] = bf2f(*(const GAS unsigned short*)(P + (size_t)(R0 + t) * PW + 512 + hd * 64 + dk));
#pragma unroll
      for (int i = 0; i < 2; ++i) { const int e = tid + 512 * i, tt = e >> 7, dv = e & 127; v[e] = bf2f(*(const GAS unsigned short*)(P + (size_t)(R0 + tt) * PW + 1024 + hd * 128 + dv)); } }
    const float m0 = ldf(m0g);
    if (wave == 0) {
        const int tt = lane & 7;
        const float lf = ldf(LF + (size_t)(R0 + tt) * 8 + hd), ig = ldf(IG + (size_t)(R0 + tt) * 8 + hd);
        float bb = lf;
#pragma unroll
        for (int o = 1; o < 8; o <<= 1) { const float x = __shfl_up(bb, o, 8); if (tt >= o) bb += x; }
        const float d = ig - bb; float pm = d;
#pragma unroll
        for (int o = 1; o < 8; o <<= 1) { const float x = __shfl_up(pm, o, 8); if (tt >= o) pm = fmaxf(pm, x); }
        if (lane < 8) { const float M = fmaxf(m0, pm); sb[tt] = bb; sd[tt] = d; sM[tt] = M; sg[tt] = fexp(m0 - M); }
    }
    __syncthreads();
    if (tid < 64) { const int t = tid >> 3, s = tid & 7; float a = 0.f;
#pragma unroll 8
        for (int dk = 0; dk < 64; ++dk) a += q[t * 64 + dk] * k[s * 64 + dk];
        S[tid] = (s <= t) ? a * fexp(sd[s] - sM[t]) : 0.f;
    } else if (tid < 128) { const int i = tid - 64, t = i >> 3, part = i & 7; float a = 0.f;
#pragma unroll
        for (int j = 0; j < 8; ++j) a += q[t * 64 + part * 8 + j] * ldf(n0g + part * 8 + j);
        a += __shfl_xor(a, 1); a += __shfl_xor(a, 2); a += __shfl_xor(a, 4);
        if (part == 0) sqn[t] = a;
    }
    { const int s = tid >> 6, dk = tid & 63; skw[tid] = fexp(sd[s] - sM[7]) * k[s * 64 + dk]; }
    __syncthreads();
    if (tid < 8) { float rs = 0.f;
#pragma unroll
        for (int s = 0; s < 8; ++s) rs += S[tid * 8 + s];
        const float den = sg[tid] * sqn[tid] + rs; sdi[tid] = 1.f / fmaxf(fabsf(den), fexp(-(sb[tid] + sM[tid]))); }
    __syncthreads();
    const int dv = tid & 127, tq = tid >> 7;
    float a0 = 0.f, a1 = 0.f;
#pragma unroll 8
    for (int dk = 0; dk < 64; ++dk) { const float c = ldf(C0g + dk * 128 + dv); a0 += q[tq * 64 + dk] * c; a1 += q[(tq + 4) * 64 + dk] * c; }
    float vv[8];
#pragma unroll
    for (int s = 0; s < 8; ++s) vv[s] = v[s * 128 + dv];
    float n0_ = sg[tq] * a0, n1_ = sg[tq + 4] * a1;
#pragma unroll
    for (int s = 0; s < 8; ++s) { n0_ += S[tq * 8 + s] * vv[s]; n1_ += S[(tq + 4) * 8 + s] * vv[s]; }
    const float h0 = n0_ * sdi[tq], h1 = n1_ * sdi[tq + 4];
    const float p0 = wave_sum(h0 * h0), p1 = wave_sum(h1 * h1);
    if (lane == 0) { sss[tq * 2 + (wave & 1)] = p0; sss[(tq + 4) * 2 + (wave & 1)] = p1; }
    __syncthreads();
    { const float r0 = 1.f / sqrtf((sss[tq * 2] + sss[tq * 2 + 1]) * (1.f / 128.f) + 1e-6f), r1 = 1.f / sqrtf((sss[(tq + 4) * 2] + sss[(tq + 4) * 2 + 1]) * (1.f / 128.f) + 1e-6f);
      const float gh = ldf(ghead + hd * 128 + dv);
      const float om0 = bf2f(*(const GAS unsigned short*)(P + (size_t)(R0 + tq) * PW + 2048 + hd * 128 + dv)), om1 = bf2f(*(const GAS unsigned short*)(P + (size_t)(R0 + tq + 4) * PW + 2048 + hd * 128 + dv));
      *(GAS unsigned short*)(CAT + (size_t)(R0 + tq) * DM + hd * 128 + dv) = (unsigned short)f2bf(h0 * r0 * gh * sigmoidf_(om0));
      *(GAS unsigned short*)(CAT + (size_t)(R0 + tq + 4) * DM + hd * 128 + dv) = (unsigned short)f2bf(h1 * r1 * gh * sigmoidf_(om1)); }
    const float gend = sg[7];
#pragma unroll 4
    for (int j = 0; j < 16; ++j) { const int dk = 16 * tq + j; float c = gend * ldf(C0g + dk * 128 + dv);
#pragma unroll
        for (int s = 0; s < 8; ++s) c += skw[s * 64 + dk] * vv[s];
        stf(outC + dk * 128 + dv, c); }
    if (tid < 64) { float n = gend * ldf(n0g + tid);
#pragma unroll
        for (int s = 0; s < 8; ++s) n += skw[s * 64 + tid];
        stf(outN + tid, n); }
    if (tid == 0) stf(outM, sb[7] + sM[7]);
    __syncthreads();
}

DI int sa_slot_idx(int tile, int s) {
    if (tile < 24) { const int sl = tile * 32 + s; return (sl >> 3) * 16 + (sl & 7); }
    if (tile < 40) return 1536 + (tile - 24) * 32 + s;
    return s < 8 ? 2048 + s : -1;
}
DI void sample_attn_unit(const bf16* P, const float* ck, const float* cv, bf16* CAT, int b, int head, LAS unsigned char* lds, unsigned ldsbase, int tid, int wave, int lane0) {
    const int lane = lane0, r31 = lane & 31, h = lane >> 5, R0 = SEQ + 8 * b;
    LAS unsigned char* vtp = lds + wave * (32 * VPITCH); const unsigned vt = ldsbase + (unsigned)wave * (32 * VPITCH);
    LAS float* Ow = (LAS float*)(lds + 73728);
    LAS float* Mw = (LAS float*)(lds + 73728 + 32768);
    LAS float* Lw = Mw + 64;
    bf16x8 Qf[8];
    { const bf16* qp = P + (size_t)(R0 + (r31 & 7)) * PW + 3072 + head * 128 + 8 * h;
#pragma unroll
      for (int ks = 0; ks < 8; ++ks) { u32x4 q = ld16(qp + 16 * ks); if (r31 >= 8) q = (u32x4){0u, 0u, 0u, 0u}; Qf[ks] = __builtin_bit_cast(bf16x8, q); } }
    f32x16 O[4];
#pragma unroll
    for (int d = 0; d < 4; ++d) O[d] = zero16();
    float mrun = -1e30f, lrun = 0.f;
    const float* ckb = ck + (size_t)b * 2048 * 1024 + head * 128; const float* cvb = cv + (size_t)b * 2048 * 1024 + head * 128;
    for (int tile = wave; tile < 41; tile += 8) {
        int lq = lane; asm volatile("" : "+v"(lq));
        const int r31 = lq & 31, h = lq >> 5, lane = lq;
        f32x16 S = zero16();
        if (tile < 40) {
            const float* kp = ckb + (size_t)sa_slot_idx(tile, r31) * 1024 + 8 * h;
#pragma unroll
            for (int ks = 0; ks < 8; ++ks) { const f32x4 a = ld4(kp + 16 * ks), c = ld4(kp + 16 * ks + 4);
                u32x4 w; w.x = pk2(a.x, a.y); w.y = pk2(a.z, a.w); w.z = pk2(c.x, c.y); w.w = pk2(c.z, c.w); S = MFMA32(__builtin_bit_cast(bf16x8, w), Qf[ks], S);
                if (ks == 3) asm volatile("" ::: "memory"); }
            asm volatile("" ::: "memory");
#pragma unroll
            for (int i = 0; i < 16; ++i) { const int id = i * 64 + lane, row = id >> 5, c4 = id & 31; const f32x4 v = ld4(cvb + (size_t)sa_slot_idx(tile, row) * 1024 + 4 * c4);
                u32x2 w; w.x = pk2(v.x, v.y); w.y = pk2(v.z, v.w); *(LAS u32x2*)(vtp + row * VPITCH + c4 * 8) = w;
                if ((i & 7) == 7) asm volatile("" ::: "memory"); }
        } else {
            const bf16* kp = P + (size_t)(R0 + (r31 & 7)) * PW + 4096 + head * 128 + 8 * h;
#pragma unroll
            for (int ks = 0; ks < 8; ++ks) { u32x4 w = ld16(kp + 16 * ks); if (r31 >= 8) w = (u32x4){0u, 0u, 0u, 0u}; S = MFMA32(__builtin_bit_cast(bf16x8, w), Qf[ks], S); }
#pragma unroll
            for (int i = 0; i < 8; ++i) { const int id = i * 64 + lane, row = id >> 4, ch = id & 15; u32x4 w = ld16(P + (size_t)(R0 + (row & 7)) * PW + 5120 + head * 128 + ch * 8); if (row >= 8) w = (u32x4){0u, 0u, 0u, 0u};
                *(LAS u32x4*)(vtp + row * VPITCH + ch * 16) = w; }
        }
        float tmax = -INFINITY;
#pragma unroll
        for (int reg = 0; reg < 16; ++reg) { const int idx = sa_slot_idx(tile, crow(reg, h)); const int dist = 2048 + r31 - idx;
            int mult = 0;
            if (idx >= 0 && r31 < 8 && dist >= 0) mult = (dist <= 128 ? 1 : 0) + (((dist & 3) == 0 && dist <= 512) ? 1 : 0) + (((dist & 15) == 0 && dist <= 2048) ? 1 : 0);
            if (mult) tmax = fmaxf(tmax, S[reg]);
            const float lm = mult == 3 ? 1.5849625f : (mult == 2 ? 1.f : 0.f);
            S[reg] = mult ? S[reg] + lm : -INFINITY; }
        tmax = fmaxf(tmax, __shfl_xor(tmax, 32));
        const float mnew = fmaxf(mrun, tmax), alpha = fexp2(mrun - mnew); mrun = mnew;
        float psum = 0.f;
#pragma unroll
        for (int reg = 0; reg < 16; ++reg) { S[reg] = fexp2(S[reg] - mnew); psum += S[reg]; }
        psum += __shfl_xor(psum, 32);
        lrun = lrun * alpha + psum;
#pragma unroll
        for (int d = 0; d < 4; ++d) O[d] = O[d] * alpha;
        const bf16x8 P0 = pack_step(S, 0), P1 = pack_step(S, 1);
        LDS_WAIT();
#pragma unroll
        for (int d = 0; d < 4; ++d) {
            const bf16x8 A0 = tr_pair(vt, VPITCH, 4 * h, 8 + 4 * h, 32 * d, lane);
            O[d] = MFMA32(A0, P0, O[d]);
            const bf16x8 A1 = tr_pair(vt, VPITCH, 16 + 4 * h, 24 + 4 * h, 32 * d, lane);
            O[d] = MFMA32(A1, P1, O[d]);
        }
    }
    if (r31 < 8) {
#pragma unroll
        for (int d = 0; d < 4; ++d)
#pragma unroll
            for (int reg = 0; reg < 16; ++reg) Ow[(wave * 8 + r31) * 128 + 32 * d + crow(reg, h)] = O[d][reg];
        if (h == 0) { Mw[wave * 8 + r31] = mrun; Lw[wave * 8 + r31] = lrun; }
    }
    __syncthreads();
#pragma unroll
    for (int i = 0; i < 2; ++i) { const int e = tid + 512 * i, t = e >> 7, d = e & 127; float M = -1e30f;
#pragma unroll
        for (int w = 0; w < 8; ++w) M = fmaxf(M, Mw[w * 8 + t]);
        float num = 0.f, den = 0.f;
#pragma unroll
        for (int w = 0; w < 8; ++w) { const float f = fexp2(Mw[w * 8 + t] - M); num += f * Ow[(w * 8 + t) * 128 + d]; den += f * Lw[w * 8 + t]; }
        *(GAS unsigned short*)(CAT + (size_t)(R0 + t) * DM + 1024 + head * 128 + d) = (unsigned short)f2bf(num / den); }
    __syncthreads();
}

DI void sample_attn_unit_v1(const bf16* P, const float* ck, const float* cv, bf16* CAT, int b, int head, LAS unsigned char* lds, int wave, int lane) {
    LAS float* sc = (LAS float*)lds + wave * 136;
    const int t = wave, half = lane >> 5, r31 = lane & 31, R0 = SEQ + 8 * b;
    f32x4 q;
    { const u32x2 w = ld8(P + (size_t)(R0 + t) * PW + 3072 + head * 128 + 4 * r31); q.x = bflo(w.x); q.y = bfhi(w.x); q.z = bflo(w.y); q.w = bfhi(w.y); }
    float Mr = -1e30f, Lr = 0.f; f32x4 Ar = {0.f, 0.f, 0.f, 0.f};
    const float* ckb = ck + (size_t)b * 2048 * 1024 + head * 128 + 4 * r31; const float* cvb = cv + (size_t)b * 2048 * 1024 + head * 128 + 4 * r31;
    for (int br = 0; br < 3; ++br) {
        const int ld = 2 * br;
#pragma unroll 5
        for (int jj = 0; jj < 65; ++jj) { const int j = 2 * jj + half; const bool ok = j <= 128; const int idx = 2048 + t - ((ok ? j : 0) << ld);
            f32x4 kv;
            if (idx >= 2048) { const u32x2 w = ld8(P + (size_t)(R0 + idx - 2048) * PW + 4096 + head * 128 + 4 * r31); kv.x = bflo(w.x); kv.y = bfhi(w.x); kv.z = bflo(w.y); kv.w = bfhi(w.y); }
            else kv = ld4(ckb + (size_t)idx * 1024);
            float s = q.x * kv.x + q.y * kv.y + q.z * kv.z + q.w * kv.w;
            s += __shfl_xor(s, 1); s += __shfl_xor(s, 2); s += __shfl_xor(s, 4); s += __shfl_xor(s, 8); s += __shfl_xor(s, 16);
            if (r31 == 0 && ok) sc[j] = s; }
        LDS_WAIT();
        float s0 = sc[lane], s1 = sc[64 + lane], s2 = (lane == 0) ? sc[128] : -INFINITY;
        const float m = wave_max(fmaxf(s0, fmaxf(s1, s2)));
        s0 = fexp2(s0 - m); s1 = fexp2(s1 - m); s2 = fexp2(s2 - m);
        const float l = wave_sum(s0 + s1 + s2);
        sc[lane] = s0; sc[64 + lane] = s1; if (lane == 0) sc[128] = s2;
        LDS_WAIT();
        f32x4 acc = {0.f, 0.f, 0.f, 0.f};
#pragma unroll 5
        for (int jj = 0; jj < 65; ++jj) { const int j = 2 * jj + half; const bool ok = j <= 128; const int idx = 2048 + t - ((ok ? j : 0) << ld);
            f32x4 vv;
            if (idx >= 2048) { const u32x2 w = ld8(P + (size_t)(R0 + idx - 2048) * PW + 5120 + head * 128 + 4 * r31); vv.x = bflo(w.x); vv.y = bfhi(w.x); vv.z = bflo(w.y); vv.w = bfhi(w.y); }
            else vv = ld4(cvb + (size_t)idx * 1024);
            const float p = ok ? sc[ok ? j : 0] : 0.f;
            acc += vv * p; }
        acc.x += __shfl_xor(acc.x, 32); acc.y += __shfl_xor(acc.y, 32); acc.z += __shfl_xor(acc.z, 32); acc.w += __shfl_xor(acc.w, 32);
        const float Mn = fmaxf(Mr, m), fa = fexp2(Mr - Mn), fb = fexp2(m - Mn);
        Ar = Ar * fa + acc * fb; Lr = Lr * fa + l * fb; Mr = Mn;
        LDS_WAIT();
    }
    if (half == 0) { const float inv = 1.f / Lr; u32x2 w; w.x = pk2(Ar.x * inv, Ar.y * inv); w.y = pk2(Ar.z * inv, Ar.w * inv);
        st8(CAT + (size_t)(R0 + t) * DM + 1024 + head * 128 + 4 * r31, w); }
}

DI f32x4 bf4lo(u32x4 w) { return (f32x4){bflo(w.x), bfhi(w.x), bflo(w.y), bfhi(w.y)}; }
DI f32x4 bf4hi(u32x4 w) { return (f32x4){bflo(w.z), bfhi(w.z), bflo(w.w), bfhi(w.w)}; }
constexpr int CONV_ROWS = 64, CONV_PT = (SEQ / CONV_ROWS) * 704, CONV_TASKS = CONV_PT + 32 * 704;
DI void conv_task(const bf16* GV, bf16* ACT, const float* cw, const float* cb, const float* sconv, int e) {
    int row0, nb, cg; f32x4 gm2[2], gm1[2];
    if (e < CONV_PT) { const int rc = e / 704; cg = e % 704; row0 = rc * CONV_ROWS; nb = CONV_ROWS / 8;
        if (rc == 0) { gm2[0] = gm2[1] = gm1[0] = gm1[1] = (f32x4){0.f, 0.f, 0.f, 0.f}; }
        else { const u32x4 a = ld16(GV + (size_t)(row0 - 2) * NUP + cg * 8), b = ld16(GV + (size_t)(row0 - 1) * NUP + cg * 8);
            gm2[0] = bf4lo(a); gm2[1] = bf4hi(a); gm1[0] = bf4lo(b); gm1[1] = bf4hi(b); }
    } else { const int e2 = e - CONV_PT, bb = e2 / 704; cg = e2 % 704; row0 = SEQ + 8 * bb; nb = 1;
        const float* s0 = sconv + ((size_t)bb * 2) * DFF + cg * 8;
        gm2[0] = ld4(s0); gm2[1] = ld4(s0 + 4); gm1[0] = ld4(s0 + DFF); gm1[1] = ld4(s0 + DFF + 4); }
    const int c0 = cg * 8;
    const f32x4 w0a = ld4(cw + c0), w0b = ld4(cw + c0 + 4), w1a = ld4(cw + DFF + c0), w1b = ld4(cw + DFF + c0 + 4), w2a = ld4(cw + 2 * DFF + c0), w2b = ld4(cw + 2 * DFF + c0 + 4);
    const f32x4 ba = ld4(cb + c0), bb4 = ld4(cb + c0 + 4);
    for (int b8 = 0; b8 < nb; ++b8) {
        u32x4 gw[8], vw[8];
#pragma unroll
        for (int r = 0; r < 8; ++r) { const size_t ro = (size_t)(row0 + 8 * b8 + r) * NUP + c0; gw[r] = ld16(GV + ro); vw[r] = ld16(GV + ro + DFF); }
#pragma unroll
        for (int r = 0; r < 8; ++r) {
            const f32x4 g0 = bf4lo(gw[r]), g1 = bf4hi(gw[r]), v0 = bf4lo(vw[r]), v1 = bf4hi(vw[r]);
            const f32x4 x0 = gm2[0] * w0a + gm1[0] * w1a + g0 * w2a + ba, x1 = gm2[1] * w0b + gm1[1] * w1b + g1 * w2b + bb4;
            u32x4 o; o.x = pk2(siluf_(x0.x) * v0.x, siluf_(x0.y) * v0.y); o.y = pk2(siluf_(x0.z) * v0.z, siluf_(x0.w) * v0.w);
            o.z = pk2(siluf_(x1.x) * v1.x, siluf_(x1.y) * v1.y); o.w = pk2(siluf_(x1.z) * v1.z, siluf_(x1.w) * v1.w);
            st16(ACT + (size_t)(row0 + 8 * b8 + r) * DFF + c0, o);
            gm2[0] = gm1[0]; gm2[1] = gm1[1]; gm1[0] = g0; gm1[1] = g1; }
    }
}

#ifndef MK_SPLIT
#define MK_SPLIT 0
#endif
constexpr int N_PHASES = 22;
struct Args { const float* in[24]; float* out; unsigned char* ws; int ph_lo, ph_hi, li, pad; };

typedef const Args __attribute__((address_space(4)))* KArgs;
struct GOrder {
    pg8::StaticOrder so; int mode, nS, nUnits, G, c; pg8::Unit one;
    DI bool next(int i, pg8::Unit& u) const {
        if (mode == 0) return so.next(i, u);
        if (mode == 1) { const int L = i * G + c; if (L >= nUnits) return false; u.pm = 32; u.pn = L / nS; u.ks = L % nS; return true; }
        if (i) return false; u = one; return true;
    }
    DI void a_ready(const pg8::Unit&) const {}
    DI void done(const pg8::Unit&) const {}
};
DI GOrder order_static(int M, int N, int G, int c) { GOrder o; o.so.init(M, N, G, c); o.mode = 0; o.nS = 1; o.nUnits = 0; o.G = G; o.c = c; o.one = pg8::Unit{0, 0, 0}; return o; }
DI GOrder order_split(int nN, int nS, int G, int c) { GOrder o; o.so.init(256, 256, G, c); o.mode = 1; o.nS = nS; o.nUnits = nN * nS; o.G = G; o.c = c; o.one = pg8::Unit{0, 0, 0}; return o; }
DI GOrder order_one(int pm, int pn) { GOrder o; o.so.init(256, 256, 1, 0); o.mode = 2; o.nS = 1; o.nUnits = 1; o.G = 1; o.c = 0; o.one = pg8::Unit{pm, pn, 0}; return o; }
DI int dequeue(gu32* qw, volatile LAS unsigned* slot, int tid) {
    __syncthreads();
    if (tid == 0) *slot = __hip_atomic_fetch_add(qw, 1u, RLX_AGENT);
    __syncthreads();
    return (int)*slot;
}

__global__ void __launch_bounds__(NTHR, 2) mk_fwd(Args a) {
    extern __shared__ __attribute__((aligned(16))) unsigned char lds_raw[];
    LAS unsigned char* lds = (LAS unsigned char*)lds_raw;
    const unsigned ldsbase = (unsigned)(size_t)lds_raw;
    const int tid = threadIdx.x, lane = tid & 63, wave = __builtin_amdgcn_readfirstlane(tid >> 6);
    const int G = gridDim.x, bid = blockIdx.x;
    volatile LAS unsigned* MISC = (volatile LAS unsigned*)(lds + MISC_OFF);
    for (int u = tid; u < (LDS_BYTES - LDSCTL_OFF) / 4; u += NTHR) ((LAS unsigned*)(lds + LDSCTL_OFF))[u] = 0u;
    __syncthreads();
    unsigned char* const ws = a.ws; float* const out0 = a.out;
    const KArgs ka0 = (KArgs)__builtin_amdgcn_kernarg_segment_ptr();
    XcdBarrier bar = xcd_barrier_post((unsigned*)ws + CW_BAR + a.li * XCD_BAR_WORDS, MISC + 8);
    const int lo = a.ph_lo, hi = a.ph_hi;
#ifndef MK_MASK
#define MK_MASK 0xFFFFFFFFu
#endif
#ifndef MK_DBL
#define MK_DBL 0u
#endif
#ifndef MK_C
#define MK_C 15
#endif
#ifndef MK_DBLC
#define MK_DBLC 0
#endif
#define RPC(j) (((MK_DBLC >> (j)) & 1) ? 2 : 1)
#define RUN(k) (lo <= (k) && (k) < hi)
#define EN(j) ((MK_MASK >> (j)) & 1u)
#define REPS(j) (((MK_DBL >> (j)) & 1u) ? 2 : 1)
#define SEAM(k) do { if (RUN(k) && RUN((k) + 1)) xcd_barrier(bar); } while (0)
#define PH() int ln = lane, td = tid; unsigned char* wsl = ws; float* out = out0; KArgs ka = ka0; asm volatile("" : "+v"(ln), "+v"(td), "+s"(wsl), "+s"(out), "+s"(ka)); \
             const int gw = bid * NWAVES + wave, ngw = G * NWAVES, gt = bid * NTHR + td, ngt = G * NTHR; (void)ln; (void)td; (void)gw; (void)ngw; (void)gt; (void)ngt; (void)out; (void)ka
#define W_(T, off) ((T*)(wsl + (off)))
#define IN_(k) (ka->in[k])
#define QW_(q) ((gu32*)wsl + CW_Q + 64 * (q))
#define PHQ() ln = lane; td = tid; wsl = ws; out = out0; ka = ka0; asm volatile("" : "+v"(ln), "+v"(td), "+s"(wsl), "+s"(out), "+s"(ka))

    if (EN(0) && RUN(0)) for (int rep_ = 0; rep_ < REPS(0); ++rep_) {
        { PH(); p0_mod(IN_(8), IN_(9), IN_(10), IN_(11), W_(float, WS_MOD), lds, bid, G, td, wave, ln); }
        { PH(); p0_rope(W_(float, WS_ROPE), W_(float, WS_ROPE) + 8200 * 64, gt, ngt); }
        { PH(); p0_weights(IN_(12), IN_(15), IN_(18), IN_(21), wsl, lds, gw, ngw, wave, ln); }
        __syncthreads();
    }
    SEAM(0);
    if (EN(1) && RUN(1)) for (int rep_ = 0; rep_ < REPS(1); ++rep_) { PH(); const float* xp = IN_(0); const float* xs = IN_(1);
        load_gate_w(IN_(12), (LAS float*)lds, td); __syncthreads();
        { f32x4 cur[8], nxt[8]; const float* mr = W_(float, WS_MOD);
          row_load(xp + (size_t)(gw < SEQ ? gw : 0) * DM, cur, ln);
          for (int row = gw; row < SEQ; row += ngw) { const int nr = row + ngw; row_load(xp + (size_t)(nr < SEQ ? nr : row) * DM, nxt, ln);
              int lq = ln; asm volatile("" : "+v"(lq));
              modulate_fin(cur, mr, mr + DM, W_(bf16, WS_U) + (size_t)row * DM, (const LAS float*)lds, IN_(13), W_(float, WS_IG), W_(float, WS_LF), row, lq);
#pragma unroll
              for (int j = 0; j < 8; ++j) cur[j] = nxt[j]; }
          for (int row = SEQ + gw; row < MR; row += ngw) { const float* ms = W_(float, WS_MOD) + (size_t)mod_row(row) * NMOD; row_load(xs + (size_t)(row - SEQ) * DM, cur, ln);
              modulate_fin(cur, ms, ms + DM, W_(bf16, WS_U) + (size_t)row * DM, (const LAS float*)lds, IN_(13), W_(float, WS_IG), W_(float, WS_LF), row, ln); } }
        __syncthreads();
    }
    SEAM(1);
    for (int l = 0; l < 2; ++l) {
        const int pb = 2 + 10 * l;
        if (EN(2) && RUN(pb + 0)) for (int rep_ = 0; rep_ < REPS(2); ++rep_) { PH();
            pg8::Gemm g{W_(bf16, WS_U), W_(bf16, WS_WIN) + (size_t)l * NINP * DM, SEQ, NINP, DM, DM}; const GOrder S = order_static(SEQ, NINP, G, bid);
            EpiIn E{wsl, out, l};
            pg8::gemm_phase<EpiIn, GOrder, true, true>(lds, g, S, E);
        }
        SEAM(pb + 0);
        if (EN(3) && RUN(pb + 1)) for (int rep_ = 0; rep_ < REPS(3); ++rep_) { PH();
            for (;;) { const int it = dequeue(QW_(4 * l + 2 * rep_), MISC + 16, td); PHQ();
                if (it < 24) { pg8::Gemm g{W_(bf16, WS_U), W_(bf16, WS_WIN) + (size_t)l * NINP * DM, MR, NINP, DM, DM}; const GOrder S = order_one(32, it); EpiIn E{wsl, out, l};
                    pg8::gemm_phase<EpiIn, GOrder, true, true>(lds, g, S, E); }
                else if (it < 24 + 768) attn_prompt_unit(W_(bf16, WS_P), W_(bf16, WS_OPART), W_(float, WS_ML), it - 24, lds, ldsbase, wave, ln);
                else if (it < 24 + 768 + NUNIT / 2) mlstm_m1_item(W_(bf16, WS_P), W_(float, WS_IG), W_(float, WS_LF), W_(float, WS_SCAL), W_(float, WS_DCT), it - (24 + 768), lds, ldsbase, wave, ln);
                else break; }
            __syncthreads();
        }
        SEAM(pb + 1);
        if (EN(4) && RUN(pb + 2)) for (int rep_ = 0; rep_ < REPS(4); ++rep_) { PH();
            for (;;) { const int it = dequeue(QW_(4 * l + 2 * rep_ + 1), MISC + 16, td); PHQ();
                if (it < 129) { for (int r2 = 0; r2 < RPC(0); ++r2) mlstm_m2(W_(float, WS_SCAL), W_(float, WS_DCT), W_(bf16, WS_CST), W_(float, WS_MST), out + O_CP + (size_t)l * 65536, out + O_NP + (size_t)l * 512, out + O_MP + (size_t)l * 8, it * NTHR + td); }
                else if (it < 129 + 256) { const int u = it - 129, b = u >> 3, hd = u & 7;
#ifdef MK_SA_V1
                    sample_attn_unit_v1(W_(bf16, WS_P), IN_(2) + (size_t)l * 32 * 2048 * 1024, IN_(3) + (size_t)l * 32 * 2048 * 1024, W_(bf16, WS_CAT), b, hd, lds, wave, ln); }
#else
                    for (int r2 = 0; r2 < RPC(1); ++r2) sample_attn_unit(W_(bf16, WS_P), IN_(2) + (size_t)l * 32 * 2048 * 1024, IN_(3) + (size_t)l * 32 * 2048 * 1024, W_(bf16, WS_CAT), b, hd, lds, ldsbase, td, wave, ln); }
#endif
                else if (it < 129 + 512) { const int u = it - (129 + 256), b = u >> 3, hd = u & 7; const size_t so = ((size_t)(l * 32 + b) * 8 + hd);
                    for (int r2 = 0; r2 < RPC(2); ++r2) sample_mlstm_unit(W_(bf16, WS_P), W_(float, WS_IG), W_(float, WS_LF), IN_(4) + so * 8192, IN_(5) + so * 64, IN_(6) + so, IN_(14) + l * 1024, W_(bf16, WS_CAT), out + O_CS + so * 8192, out + O_NS + so * 64, out + O_MS + so, b, hd, lds, td, wave, ln); }
                else if (it < 129 + 512 + 256) { const int ch = it - (129 + 512); for (int r2 = 0; r2 < RPC(3); ++r2) for (int e = ch * 4096 + td; e < (ch + 1) * 4096; e += NTHR) attn_combine(W_(bf16, WS_OPART), W_(float, WS_ML), W_(bf16, WS_CAT), e); }
                else break; }
            __syncthreads();
        }
        SEAM(pb + 2);
        if (EN(5) && RUN(pb + 3)) for (int rep_ = 0; rep_ < REPS(5); ++rep_) { PH(); for (int it = bid; it < NUNIT / 4; it += G) mlstm_m3_item(W_(bf16, WS_P), W_(float, WS_SCAL), W_(bf16, WS_CST), W_(float, WS_MST), IN_(14) + l * 1024, W_(bf16, WS_CAT), it, lds, ldsbase, wave, ln); }
        SEAM(pb + 3);
        if (EN(6) && RUN(pb + 4)) for (int rep_ = 0; rep_ < REPS(6); ++rep_) { PH();
            EpiRes E{W_(float, WS_Y), l == 0 ? IN_(0) : W_(float, WS_XR), W_(float, WS_MOD) + (size_t)l * 33 * NMOD + 2 * DM, W_(float, WS_SLAB)};
#pragma nounroll
            for (int pass = 0; pass < 2; ++pass) {
                pg8::Gemm g{W_(bf16, WS_CAT), W_(bf16, WS_WOUT) + (size_t)l * DM * DM, MR, DM, pass ? 512 : DM, DM};
                const GOrder S = pass ? order_split(8, 4, G, bid) : order_static(SEQ, DM, G, bid);
                pg8::gemm_phase<EpiRes, GOrder, true, true>(lds, g, S, E); }
        }
        SEAM(pb + 4);
        if (EN(7) && RUN(pb + 5)) for (int rep_ = 0; rep_ < REPS(7); ++rep_) { PH(); const float* lg = IN_(16) + l * DM; const float* lb = IN_(17) + l * DM; const float* xs = l == 0 ? IN_(1) : W_(float, WS_XR) + (size_t)SEQ * DM;
            { f32x4 cur[8], nxt[8]; const float* mr = W_(float, WS_MOD) + (size_t)l * 33 * NMOD;
              row_load(W_(float, WS_Y) + (size_t)(gw < SEQ ? gw : 0) * DM, cur, ln);
              for (int row = gw; row < SEQ; row += ngw) { const int nr = row + ngw; row_load(W_(float, WS_Y) + (size_t)(nr < SEQ ? nr : row) * DM, nxt, ln);
                  int lq = ln; asm volatile("" : "+v"(lq));
                  ln_fin(cur, lg, lb, W_(float, WS_XA) + (size_t)row * DM, mr + 3 * DM, mr + 4 * DM, W_(bf16, WS_U) + (size_t)row * DM, (const LAS float*)lds, false, nullptr, nullptr, nullptr, row, lq);
#pragma unroll
                  for (int j = 0; j < 8; ++j) cur[j] = nxt[j]; }
              for (int row = SEQ + gw; row < MR; row += ngw) { const float* ms = W_(float, WS_MOD) + ((size_t)l * 33 + mod_row(row)) * NMOD;
                  slab_row_load(W_(float, WS_SLAB) + (size_t)(row - SEQ) * DM, 4, xs + (size_t)(row - SEQ) * DM, ms + 2 * DM, cur, ln);
                  ln_fin(cur, lg, lb, W_(float, WS_XA) + (size_t)row * DM, ms + 3 * DM, ms + 4 * DM, W_(bf16, WS_U) + (size_t)row * DM, (const LAS float*)lds, false, nullptr, nullptr, nullptr, row, ln); } }
        }
        SEAM(pb + 5);
        if (EN(8) && RUN(pb + 6)) for (int rep_ = 0; rep_ < REPS(8); ++rep_) { PH();
            pg8::Gemm g{W_(bf16, WS_U), W_(bf16, WS_WUP) + (size_t)l * NUP * DM, MR, NUP, DM, DM}; const GOrder S = order_static(MR, NUP, G, bid);
            EpiUp E{W_(bf16, WS_GV), out + O_BP + (size_t)l * 2 * DFF, out + O_BS + (size_t)l * 32 * 2 * DFF};
            pg8::gemm_phase<EpiUp, GOrder, true, true>(lds, g, S, E);
        }
        SEAM(pb + 6);
        if (EN(9) && RUN(pb + 7)) for (int rep_ = 0; rep_ < REPS(9); ++rep_) { PH(); const float* cw = IN_(19) + (size_t)l * 3 * DFF; const float* cb = IN_(20) + (size_t)l * DFF; const float* sc = IN_(7) + (size_t)l * 32 * 2 * DFF;
            for (int e = gt; e < CONV_TASKS; e += ngt) conv_task(W_(bf16, WS_GV), W_(bf16, WS_ACT), cw, cb, sc, e); }
        SEAM(pb + 7);
        if (EN(10) && RUN(pb + 8)) for (int rep_ = 0; rep_ < REPS(10); ++rep_) { PH();
            EpiRes E{W_(float, WS_Y), W_(float, WS_XA), W_(float, WS_MOD) + (size_t)l * 33 * NMOD + 5 * DM, W_(float, WS_SLAB)};
#pragma nounroll
            for (int pass = 0; pass < 2; ++pass) {
                pg8::Gemm g{W_(bf16, WS_ACT), W_(bf16, WS_WDN) + (size_t)l * DM * DFF, MR, DM, pass ? 512 : DFF, DFF};
                const GOrder S = pass ? order_split(8, 11, G, bid) : order_static(SEQ, DM, G, bid);
                pg8::gemm_phase<EpiRes, GOrder, true, true>(lds, g, S, E); }
        }
        SEAM(pb + 8);
        if (EN(11) && RUN(pb + 9)) for (int rep_ = 0; rep_ < REPS(11); ++rep_) { PH(); const float* lg = IN_(22) + l * DM; const float* lb = IN_(23) + l * DM; float* xo = l == 0 ? W_(float, WS_XR) : out + O_XP;
            if (l == 0) { load_gate_w(IN_(12) + (size_t)DM * DIN, (LAS float*)lds, td); __syncthreads(); }
            { f32x4 cur[8]; const float* mr = W_(float, WS_MOD) + (size_t)33 * NMOD;
              bf16* const Ub = l == 0 ? W_(bf16, WS_U) : (bf16*)nullptr;
              for (int row = gw; row < SEQ; row += ngw) { int lq = ln; asm volatile("" : "+v"(lq)); row_load(W_(float, WS_Y) + (size_t)row * DM, cur, lq);
                  ln_fin(cur, lg, lb, xo + (size_t)row * DM, mr, mr + DM, Ub ? Ub + (size_t)row * DM : Ub, (const LAS float*)lds, l == 0, IN_(13) + 16, W_(float, WS_IG), W_(float, WS_LF), row, lq); }
              for (int row = SEQ + gw; row < MR; row += ngw) { const float* ms = W_(float, WS_MOD) + (size_t)(33 + mod_row(row)) * NMOD; const float* ms0 = W_(float, WS_MOD) + ((size_t)l * 33 + mod_row(row)) * NMOD;
                  slab_row_load(W_(float, WS_SLAB) + (size_t)(row - SEQ) * DM, 11, W_(float, WS_XA) + (size_t)row * DM, ms0 + 5 * DM, cur, ln);
                  ln_fin(cur, lg, lb, xo + (size_t)row * DM, ms, ms + DM, Ub ? Ub + (size_t)row * DM : Ub, (const LAS float*)lds, l == 0, IN_(13) + 16, W_(float, WS_IG), W_(float, WS_LF), row, ln); } }
            __syncthreads();
        }
        SEAM(pb + 9);
    }
#undef RUN
#undef SEAM
}

extern "C" void kernel_launch(void* const* d_in, const int* in_sizes, int n_in, void* d_out, int out_size, void* d_ws, size_t ws_size, hipStream_t stream) {
    static int grid = 0;
    if (grid == 0) {
        if (n_in != 24 || out_size != (int)O_END || ws_size < WS_END) { fprintf(stderr, "kernel_launch: unexpected shapes: n_in %d out %d ws %zu (need %zu)\n", n_in, out_size, ws_size, (size_t)WS_END); grid = -1; return; }
        int dev = 0, cus = 0, per_cu = 0;
        if (hipGetDevice(&dev) != hipSuccess || hipDeviceGetAttribute(&cus, hipDeviceAttributeMultiprocessorCount, dev) != hipSuccess) { fprintf(stderr, "kernel_launch: device query failed\n"); grid = -1; return; }
        if (hipFuncSetAttribute((const void*)mk_fwd, hipFuncAttributeMaxDynamicSharedMemorySize, LDS_BYTES) != hipSuccess) { fprintf(stderr, "kernel_launch: hipFuncSetAttribute failed\n"); grid = -1; return; }
        if (hipOccupancyMaxActiveBlocksPerMultiprocessor(&per_cu, (const void*)mk_fwd, NTHR, LDS_BYTES) != hipSuccess || per_cu < 1) fprintf(stderr, "kernel_launch: note: occupancy query reports %d blocks per CU\n", per_cu);
        (void)hipGetLastError();
        grid = cus;
    }
    if (grid < 0) return;
    (void)in_sizes;
    if (hipMemsetAsync((char*)d_ws + WS_CTL, 0, CTL_ZERO_BYTES, stream) != hipSuccess) { fprintf(stderr, "kernel_launch: memset failed\n"); return; }
    Args a{};
    for (int i = 0; i < 24; ++i) a.in[i] = (const float*)d_in[i];
    a.out = (float*)d_out; a.ws = (unsigned char*)d_ws; a.pad = 0;
#if MK_SPLIT
    for (int p = 0; p < N_PHASES; ++p) { a.ph_lo = p; a.ph_hi = p + 1; a.li = p; hipLaunchKernelGGL(mk_fwd, dim3(grid), dim3(NTHR), LDS_BYTES, stream, a); }
#else
    a.ph_lo = 0; a.ph_hi = N_PHASES; a.li = 0;
    hipLaunchKernelGGL(mk_fwd, dim3(grid), dim3(NTHR), LDS_BYTES, stream, a);
#endif
    const hipError_t le = hipPeekAtLastError();
    if (le != hipSuccess) fprintf(stderr, "kernel_launch: launch failed: %s\n", hipGetErrorName(le));
}
```

```cpp
#include <hip/hip_runtime.h>
#include <cstdio>
#include <cstdint>
namespace pg8 {
#define PG8_LAS __attribute__((address_space(3)))
typedef unsigned short bf16_t;
typedef short bf16x8 __attribute__((ext_vector_type(8)));
typedef float f32x4 __attribute__((ext_vector_type(4)));
typedef unsigned u32x4 __attribute__((ext_vector_type(4)));
constexpr int BM = 256, BK = 64, HALF = 128, HTB = HALF * BK * 2  , STAGE_BYTES = 8 * HTB, NXCD = 8, WGM = 8;

__host__ __device__ __forceinline__ int lds_byte(int r, int c) { const int st = (r >> 4) * 2 + (c >> 5), rr = r & 15, cc = c & 31, ob = rr * 64 + cc * 2; return st * 1024 + (ob ^ (((ob >> 9) & 1) << 5)); }
__host__ __device__ __forceinline__ void stage_rc(int b, int& R, int& C) { const int st = b / 1024, sb = b % 1024, swz = sb ^ (((sb >> 9) & 1) << 5); R = (st >> 1) * 16 + swz / 64; C = (st & 1) * 32 + (swz % 64) / 2; }
__host__ __device__ __forceinline__ int perm32(int rho) { const int n = rho >> 4, i = rho & 15; return 8 * (i >> 2) + 4 * n + (i & 3); }

struct Unit { int pm, pn, ks; };
struct Gemm { const bf16_t* A; const bf16_t* Bt; int M, N, K, ld, rstepA, roffA; };

struct StaticOrder {
    int nM, nN, nwg, G, c;
    __host__ __device__ void init(int M, int N, int G_, int c_) { nM = M / BM; nN = N / BM; nwg = nM * nN; G = G_; c = c_; }
    __host__ __device__ bool next(int i, Unit& u) const {
        const long L = (long)i * G + c; if (L >= nwg) return false;
        int wgid = (int)L; { const int q = nwg / NXCD, r = nwg % NXCD, xcd = wgid % NXCD, off = wgid / NXCD; wgid = (xcd < r ? xcd * (q + 1) : r * (q + 1) + (xcd - r) * q) + off; }
        const int nig = WGM * nN, gid = wgid / nig, fm = gid * WGM, gsz = (nM - fm) < WGM ? (nM - fm) : WGM;
        u.pm = fm + ((wgid % nig) % gsz); u.pn = (wgid % nig) / gsz; u.ks = 0; return true;
    }
    __device__ __forceinline__ void a_ready(const Unit&) const {}
    __device__ __forceinline__ void done(const Unit&) const {}
};

__device__ __forceinline__ unsigned cvt_pk_bf16(float lo, float hi) { unsigned r; asm volatile("v_cvt_pk_bf16_f32 %0, %1, %2" : "=v"(r) : "v"(lo), "v"(hi)); return r; }
template <class Epi, class Sched, bool ALIGN_EPI = false, bool SP2 = false>
__device__ __forceinline__ void gemm_phase(PG8_LAS unsigned char* lds, const Gemm g, const Sched& S, const Epi& E) {
    int tid_ = threadIdx.x; asm volatile("" : "+v"(tid_));
    const int tid = tid_, wid = __builtin_amdgcn_readfirstlane(tid >> 6), lane = tid & 63, wr = wid >> 2, wc = wid & 3, fr = lane & 15, fq = lane >> 4;
    const int K = g.K, nt = K / BK;
    unsigned voffA[2], voffB[2];
#pragma unroll
    for (int i = 0; i < 2; ++i) { int R, C; stage_rc(tid * 16 + i * 8192, R, C); const int Rb = Epi::PERM ? ((R & ~31) + perm32(R & 31)) : R;
        voffA[i] = (unsigned)(R * g.ld + C) * 2u; voffB[i] = (unsigned)(Rb * g.ld + C) * 2u; }
    const size_t kstep = (size_t)(BK * 2);
    const size_t hstep = (size_t)HALF * g.ld * 2;
    const size_t tstep = 2 * hstep;
    const unsigned ldsw = (unsigned)wid * 1024u;
    const int aoff = lds_byte(wr * 64 + fr, fq * 8), boff = lds_byte(wc * 32 + fr, fq * 8);
#define PG8_SA(b, h) (((b) * 2 + (h)) * HTB)
#define PG8_SB(b, h) ((4 + (b) * 2 + (h)) * HTB)
#define PG8_STAGE(bufoff, gbase, voff) do { _Pragma("unroll") for (int _i = 0; _i < 2; ++_i) \
        __builtin_amdgcn_global_load_lds((const unsigned*)((const char*)(gbase) + (voff)[_i]), (PG8_LAS unsigned*)(lds + (bufoff) + ldsw + _i * 8192), 16, 0, 0); } while (0)
#define PG8_LDA(dst, b, h) do { _Pragma("unroll") for (int m = 0; m < 4; ++m) _Pragma("unroll") for (int k = 0; k < 2; ++k) dst[m][k] = *(const PG8_LAS bf16x8*)(lds + PG8_SA(b, h) + aoff + m * 2048 + k * 1024); } while (0)
#define PG8_LDB(dst, b, h) do { _Pragma("unroll") for (int n = 0; n < 2; ++n) _Pragma("unroll") for (int k = 0; k < 2; ++k) dst[n][k] = *(const PG8_LAS bf16x8*)(lds + PG8_SB(b, h) + boff + n * 2048 + k * 1024); } while (0)
#define PG8_MMA(ai, bj, At, Bt) do { __builtin_amdgcn_s_setprio(1); _Pragma("unroll") for (int m = 0; m < 4; ++m) _Pragma("unroll") for (int n = 0; n < 2; ++n) _Pragma("unroll") for (int k = 0; k < 2; ++k) \
        acc[ai][bj][m][n] = __builtin_amdgcn_mfma_f32_16x16x32_bf16(Bt[n][k], At[m][k], acc[ai][bj][m][n], 0, 0, 0); __builtin_amdgcn_s_setprio(0); } while (0)
#define PG8_WAIT_V(n) asm volatile("s_waitcnt vmcnt(" #n ")" ::: "memory")
#define PG8_WAIT_L(n) asm volatile("s_waitcnt lgkmcnt(" #n ")" ::: "memory")
#define PG8_BAR __builtin_amdgcn_s_barrier()
#define PG8_SCHED __builtin_amdgcn_sched_barrier(0)
    Unit cur, nxt; int ui = 0;
    if (!S.next(0, cur)) return;
    f32x4 acc[2][2][4][2];
#pragma unroll
    for (int a = 0; a < 2; ++a)
#pragma unroll
        for (int b = 0; b < 2; ++b)
#pragma unroll
            for (int m = 0; m < 4; ++m)
#pragma unroll
                for (int n = 0; n < 2; ++n) acc[a][b][m][n] = (f32x4){0.f, 0.f, 0.f, 0.f};
    bf16x8 At[4][2], B0[2][2], B1[2][2];
    const char* cA = (const char*)g.A + ((long)cur.pm * g.rstepA + g.roffA) * (long)g.ld * 2 + (size_t)cur.ks * K * 2; const char* cB = (const char*)g.Bt + (size_t)cur.pn * tstep + (size_t)cur.ks * K * 2;
    S.a_ready(cur);
    if constexpr (SP2) {
        PG8_STAGE(PG8_SB(0, 0), cB, voffB); PG8_STAGE(PG8_SB(0, 1), cB + hstep, voffB); PG8_STAGE(PG8_SA(0, 0), cA, voffA); PG8_STAGE(PG8_SA(0, 1), cA + hstep, voffA);
        if (wr == 1) PG8_BAR;
        PG8_WAIT_V(2); PG8_BAR;
        PG8_STAGE(PG8_SB(1, 0), cB + kstep, voffB); PG8_STAGE(PG8_SA(1, 0), cA + kstep, voffA); PG8_STAGE(PG8_SB(1, 1), cB + hstep + kstep, voffB);
        PG8_WAIT_V(6); PG8_BAR;
    } else {
        PG8_STAGE(PG8_SB(0, 0), cB, voffB); PG8_STAGE(PG8_SA(0, 0), cA, voffA); PG8_STAGE(PG8_SB(0, 1), cB + hstep, voffB); PG8_STAGE(PG8_SA(0, 1), cA + hstep, voffA);
        if (wr == 1) PG8_BAR;
        PG8_WAIT_V(4); PG8_BAR;
        PG8_STAGE(PG8_SB(1, 0), cB + kstep, voffB); PG8_STAGE(PG8_SA(1, 0), cA + kstep, voffA); PG8_STAGE(PG8_SB(1, 1), cB + hstep + kstep, voffB);
        PG8_WAIT_V(6); PG8_BAR;
    }
    for (;;) {
        const bool has_next = S.next(ui + 1, nxt);
        const char* nA = has_next ? (const char*)g.A + ((long)nxt.pm * g.rstepA + g.roffA) * (long)g.ld * 2 + (size_t)nxt.ks * K * 2 : cA; const char* nB = has_next ? (const char*)g.Bt + (size_t)nxt.pn * tstep + (size_t)nxt.ks * K * 2 : cB;
        for (int t = 0; t < nt; t += 2) {
            const bool last = (t == nt - 2);
            const char* a1 = cA + (size_t)(t + 1) * kstep;
            const char* a2 = last ? nA : cA + (size_t)(t + 2) * kstep; const char* b2 = last ? nB : cB + (size_t)(t + 2) * kstep;
            const char* a3 = a2 + kstep; const char* b3 = b2 + kstep;
            if (last && has_next) S.a_ready(nxt);
            if constexpr (SP2) {
            PG8_LDB(B0, 0, 0); PG8_LDB(B1, 0, 1); PG8_SCHED; PG8_LDA(At, 0, 0); PG8_STAGE(PG8_SA(1, 1), a1 + hstep, voffA);
            PG8_WAIT_V(8); PG8_WAIT_L(0); PG8_BAR; PG8_MMA(0, 0, At, B0); PG8_MMA(0, 1, At, B1); PG8_BAR; PG8_SCHED;
            PG8_LDA(At, 0, 1); PG8_STAGE(PG8_SB(0, 0), b2, voffB); PG8_STAGE(PG8_SB(0, 1), b2 + hstep, voffB); PG8_STAGE(PG8_SA(0, 0), a2, voffA);
            PG8_WAIT_V(8); PG8_WAIT_L(0); PG8_BAR; PG8_MMA(1, 0, At, B0); PG8_MMA(1, 1, At, B1); PG8_BAR; PG8_SCHED;
            PG8_LDB(B0, 1, 0); PG8_LDB(B1, 1, 1); PG8_SCHED; PG8_LDA(At, 1, 0); PG8_STAGE(PG8_SA(0, 1), a2 + hstep, voffA);
            PG8_WAIT_V(8); PG8_WAIT_L(0); PG8_BAR; PG8_MMA(0, 0, At, B0); PG8_MMA(0, 1, At, B1); PG8_BAR; PG8_SCHED;
            PG8_LDA(At, 1, 1); PG8_STAGE(PG8_SB(1, 0), b3, voffB); PG8_STAGE(PG8_SB(1, 1), b3 + hstep, voffB); PG8_STAGE(PG8_SA(1, 0), a3, voffA);
            PG8_WAIT_V(8); PG8_WAIT_L(0); PG8_BAR; PG8_MMA(1, 0, At, B0); PG8_MMA(1, 1, At, B1); PG8_BAR; PG8_SCHED;
            } else {
            PG8_LDB(B0, 0, 0); PG8_SCHED; PG8_LDA(At, 0, 0); PG8_STAGE(PG8_SA(1, 1), a1 + hstep, voffA);
            PG8_WAIT_L(8); PG8_BAR; PG8_WAIT_L(0); PG8_MMA(0, 0, At, B0); PG8_BAR; PG8_SCHED;
            PG8_LDB(B1, 0, 1); PG8_STAGE(PG8_SB(0, 0), b2, voffB);
            PG8_BAR; PG8_WAIT_L(0); PG8_MMA(0, 1, At, B1); PG8_BAR;
            PG8_LDA(At, 0, 1); PG8_STAGE(PG8_SA(0, 0), a2, voffA);
            PG8_BAR; PG8_WAIT_L(0); PG8_MMA(1, 0, At, B0); PG8_BAR; PG8_SCHED;
            PG8_STAGE(PG8_SB(0, 1), b2 + hstep, voffB);
            PG8_WAIT_V(6); PG8_BAR; PG8_MMA(1, 1, At, B1); PG8_BAR;
            PG8_LDB(B0, 1, 0); PG8_SCHED; PG8_LDA(At, 1, 0); PG8_STAGE(PG8_SA(0, 1), a2 + hstep, voffA);
            PG8_WAIT_L(8); PG8_BAR; PG8_WAIT_L(0); PG8_MMA(0, 0, At, B0); PG8_BAR; PG8_SCHED;
            PG8_LDB(B1, 1, 1); PG8_STAGE(PG8_SB(1, 0), b3, voffB);
            PG8_BAR; PG8_WAIT_L(0); PG8_MMA(0, 1, At, B1); PG8_BAR;
            PG8_LDA(At, 1, 1); PG8_STAGE(PG8_SA(1, 0), a3, voffA);
            PG8_BAR; PG8_WAIT_L(0); PG8_MMA(1, 0, At, B0); PG8_BAR; PG8_SCHED;
            PG8_STAGE(PG8_SB(1, 1), b3 + hstep, voffB);
            PG8_WAIT_V(6); PG8_BAR; PG8_MMA(1, 1, At, B1); PG8_BAR;
            }
        }
        if constexpr (ALIGN_EPI) { if (wr == 0) PG8_BAR; }
        if constexpr (!Epi::AFTER_DRAIN) { E(acc, cur, wr, wc, fr, fq); S.done(cur); }
        if (!has_next) break;
#pragma unroll
        for (int a = 0; a < 2; ++a)
#pragma unroll
            for (int b = 0; b < 2; ++b)
#pragma unroll
                for (int m = 0; m < 4; ++m)
#pragma unroll
                    for (int n = 0; n < 2; ++n) acc[a][b][m][n] = (f32x4){0.f, 0.f, 0.f, 0.f};
        cur = nxt; cA = nA; cB = nB; ++ui;
        if constexpr (ALIGN_EPI) { if (wr == 1) PG8_BAR; }
    }
    PG8_WAIT_V(0);
    if constexpr (!ALIGN_EPI) { if (wr == 0) PG8_BAR; }
    PG8_BAR;
    if constexpr (Epi::AFTER_DRAIN) { E.fused(acc, cur, wr, wc, fr, fq, lds, wid, lane); S.done(cur); }
#undef PG8_SA
#undef PG8_SB
#undef PG8_STAGE
#undef PG8_LDA
#undef PG8_LDB
#undef PG8_MMA
#undef PG8_WAIT_V
#undef PG8_WAIT_L
#undef PG8_BAR
#undef PG8_SCHED
}
}

#define DI __device__ __forceinline__
#define GAS __attribute__((address_space(1)))
#define LAS __attribute__((address_space(3)))
typedef unsigned short bf16;
typedef float f32x4 __attribute__((ext_vector_type(4)));
typedef float f32x16 __attribute__((ext_vector_type(16)));
typedef short bf16x8 __attribute__((ext_vector_type(8)));
typedef short s16x4 __attribute__((ext_vector_type(4)));
typedef unsigned u32x4 __attribute__((ext_vector_type(4)));
typedef unsigned u32x2 __attribute__((ext_vector_type(2)));
typedef GAS unsigned gu32;
#define RLX_AGENT __ATOMIC_RELAXED, __HIP_MEMORY_SCOPE_AGENT
#define LDS_WAIT() asm volatile("s_waitcnt lgkmcnt(0)" ::: "memory")
#define VM_WAIT() asm volatile("s_waitcnt vmcnt(0)" ::: "memory")

constexpr int DM = 2048, SEQ = 8192, NSMP = 256, MR = SEQ + NSMP, DFF = 5632, NUP = 2 * DFF, NINP = 6144, DIN = 6160, NMOD = 6 * DM, PW = 6144;
constexpr int NCH = 128, LCH = 64, NHM = 8, NUNIT = NCH * NHM;
constexpr float ALPHA_RES = 1.4142135623730951f;
constexpr float QSCALE = 0.12751743082459868f;
constexpr float LOG2E = 1.4426950408889634f;
constexpr int NWAVES = 8, NTHR = 512;

constexpr size_t O_XP = 0, O_XS = 16777216, O_KP = 17301504, O_VP = 21495808, O_CP = 25690112, O_NP = 25821184, O_MP = 25822208, O_BP = 25822224,
                 O_KS = 25844752, O_VS = 26369040, O_CS = 26893328, O_NS = 31087632, O_MS = 31120400, O_BS = 31120912, O_END = 31841808;

constexpr size_t al256(size_t x) { return (x + 255) & ~(size_t)255; }
constexpr size_t WS_CTL = 0, CTL_ZERO_BYTES = 1u << 20;
constexpr size_t WS_MOD  = CTL_ZERO_BYTES;
constexpr size_t WS_ROPE = WS_MOD  + al256((size_t)2 * 33 * NMOD * 4);
constexpr size_t WS_WIN  = WS_ROPE + al256((size_t)2 * 8200 * 64 * 4);
constexpr size_t WS_WOUT = WS_WIN  + (size_t)2 * NINP * DM * 2;
constexpr size_t WS_WUP  = WS_WOUT + (size_t)2 * DM * DM * 2;
constexpr size_t WS_WDN  = WS_WUP  + (size_t)2 * NUP * DM * 2;
constexpr size_t WS_UPAD = WS_WDN  + (size_t)2 * DM * DFF * 2;
constexpr size_t WS_U    = WS_UPAD + (size_t)2 * DM * 2;
constexpr size_t WS_P    = WS_UPAD + (size_t)(2 + MR + 254) * DM * 2;
constexpr size_t WS_IG   = WS_P    + (size_t)MR * PW * 2;
constexpr size_t WS_LF   = WS_IG   + al256((size_t)MR * 8 * 4);
constexpr size_t WS_SCAL = WS_LF   + al256((size_t)MR * 8 * 4);
constexpr size_t WS_DCT  = WS_SCAL + (size_t)NUNIT * 192 * 4;
constexpr size_t WS_CST  = WS_DCT  + al256((size_t)NUNIT * 129 * 64 * 4);
constexpr size_t WS_MST  = WS_CST  + (size_t)NUNIT * 160 * 64 * 2;
constexpr size_t WS_OPART= WS_MST  + al256((size_t)NUNIT * 4);
constexpr size_t WS_ML   = WS_OPART+ (size_t)3 * SEQ * 1024 * 2;
constexpr size_t WS_CAT  = WS_ML   + (size_t)3 * SEQ * 8 * 2 * 4;
constexpr size_t WS_Y    = WS_CAT  + (size_t)MR * DM * 2;
constexpr size_t WS_XA   = WS_Y    + (size_t)MR * DM * 4;
constexpr size_t WS_XR   = WS_XA   + (size_t)MR * DM * 4;
constexpr size_t WS_GV   = WS_XR   + (size_t)MR * DM * 4;
constexpr size_t WS_ACT  = WS_GV   + (size_t)MR * NUP * 2;
constexpr size_t WS_SLAB = WS_ACT  + (size_t)MR * DFF * 2;
constexpr size_t WS_END  = WS_SLAB + (size_t)11 * NSMP * DM * 4;
constexpr int CW_BAR = 4096;
constexpr int CW_Q = 131072;

constexpr int RING_BYTES = 131072, LDSCTL_OFF = RING_BYTES, MISC_OFF = LDSCTL_OFF + 320, XB_OFF = LDSCTL_OFF + 1024, LDS_BYTES = 147456;

DI unsigned f2bf(float f) { unsigned u = __builtin_bit_cast(unsigned, f); return (u + 0x7fffu + ((u >> 16) & 1u)) >> 16; }
DI unsigned pk2(float lo, float hi) { return f2bf(lo) | (f2bf(hi) << 16); }
DI float bf2f(unsigned b) { return __builtin_bit_cast(float, b << 16); }
DI float bflo(unsigned w) { return __builtin_bit_cast(float, w << 16); }
DI float bfhi(unsigned w) { return __builtin_bit_cast(float, w & 0xffff0000u); }
DI f32x4 ld4(const float* p) { return *(const GAS f32x4*)p; }
DI void st4(float* p, f32x4 v) { *(GAS f32x4*)p = v; }
DI u32x4 ld16(const void* p) { return *(const GAS u32x4*)p; }
DI void st16(void* p, u32x4 v) { *(GAS u32x4*)p = v; }
DI u32x2 ld8(const void* p) { return *(const GAS u32x2*)p; }
DI void st8(void* p, u32x2 v) { *(GAS u32x2*)p = v; }
DI float ldf(const float* p) { return *(const GAS float*)p; }
DI void stf(float* p, float v) { *(GAS float*)p = v; }
DI bf16x8 ldfrag(const bf16* p) { return __builtin_bit_cast(bf16x8, *(const GAS u32x4*)p); }
DI float fexp2(float x) { return __builtin_amdgcn_exp2f(x); }
DI float fexp(float x) { return __builtin_amdgcn_exp2f(x * LOG2E); }
DI float frcp(float x) { return __builtin_amdgcn_rcpf(x); }
DI float sigmoidf_(float x) { return frcp(1.f + fexp(-x)); }
DI float siluf_(float x) { return x * sigmoidf_(x); }
DI float logsigmoidf_(float v) { const float e = fexp(-fabsf(v)); return fminf(v, 0.f) - __logf(1.f + e); }
DI int crow(int reg, int h) { return (reg & 3) + 8 * (reg >> 2) + 4 * h; }
DI f32x16 zero16() { f32x16 z; for (int i = 0; i < 16; ++i) z[i] = 0.f; return z; }
#define MFMA32(a, b, c) __builtin_amdgcn_mfma_f32_32x32x16_bf16((a), (b), (c), 0, 0, 0)
DI float wave_sum(float v) {
#pragma unroll
    for (int o = 1; o < 64; o <<= 1) v += __shfl_xor(v, o);
    return v;
}
DI float wave_max(float v) {
#pragma unroll
    for (int o = 1; o < 64; o <<= 1) v = fmaxf(v, __shfl_xor(v, o));
    return v;
}
DI bf16x8 pack_step(const f32x16& x, int s) {
    u32x4 p; p[0] = pk2(x[8 * s], x[8 * s + 1]); p[1] = pk2(x[8 * s + 2], x[8 * s + 3]); p[2] = pk2(x[8 * s + 4], x[8 * s + 5]); p[3] = pk2(x[8 * s + 6], x[8 * s + 7]);
    return __builtin_bit_cast(bf16x8, p);
}
DI bf16x8 tr_pair(unsigned tile, int pitch, int s0, int s1, int cbase, int lane) {
    const int i = lane & 15, q = i >> 2, p = i & 3, cb = (lane >> 4) & 1;
    const unsigned a0 = tile + (unsigned)((s0 + q) * pitch + (cbase + 16 * cb + 4 * p) * 2);
    const unsigned a1 = tile + (unsigned)((s1 + q) * pitch + (cbase + 16 * cb + 4 * p) * 2);
    s16x4 lo, hi;
    asm volatile("ds_read_b64_tr_b16 %0, %2\n\tds_read_b64_tr_b16 %1, %3\n\ts_waitcnt lgkmcnt(0)" : "=&v"(lo), "=&v"(hi) : "v"(a0), "v"(a1) : "memory");
    return __builtin_shufflevector(lo, hi, 0, 1, 2, 3, 4, 5, 6, 7);
}

DI int mod_row(int row) { return row < SEQ ? 0 : 1 + ((row - SEQ) >> 3); }

DI int win_src_col(int nb) {
    const int n0 = nb * 32;
    if (n0 < 3072) return n0;
    if (n0 < 5120) {
        const int which = (n0 - 3072) / 1024, rel = (n0 - 3072) % 1024, tile = rel / 256, j0 = rel % 256;
        const int bj = j0 / 128, h2 = (j0 % 128) / 64, ib = (j0 % 64) / 32;
        return 3088 + which * 1024 + (2 * tile + h2) * 128 + bj * 64 + 32 * ib;
    }
    return 5136 + (n0 - 5120);
}
DI void transpose_item(const float* W, int N, int K, bf16* WT, int drow0, int scol0, int k0, LAS float* scr, int lane) {
#pragma unroll 8
    for (int i = 0; i < 32; ++i) { const int kk = 2 * i + (lane >> 5); scr[kk * 33 + (lane & 31)] = ldf(W + (size_t)(k0 + kk) * N + scol0 + (lane & 31)); }
    LDS_WAIT();
    const int c = lane & 7;
#pragma unroll
    for (int j = 0; j < 4; ++j) { const int n = (lane >> 3) + 8 * j; const LAS float* s = scr + (8 * c) * 33 + n;
        u32x4 o; o.x = pk2(s[0 * 33], s[1 * 33]); o.y = pk2(s[2 * 33], s[3 * 33]); o.z = pk2(s[4 * 33], s[5 * 33]); o.w = pk2(s[6 * 33], s[7 * 33]);
        st16(WT + (size_t)(drow0 + n) * K + k0 + 8 * c, o); }
    LDS_WAIT();
}
constexpr int IT_IN = 32 * 192, IT_OUT = 32 * 64, IT_UP = 32 * 352, IT_DN = 88 * 64, IT_LAYER = IT_IN + IT_OUT + IT_UP + IT_DN;

DI void p0_weights(const float* w_in, const float* w_out, const float* w_up, const float* w_down, unsigned char* ws, LAS unsigned char* lds, int gw, int ngw, int wave, int lane) {
    LAS float* scr = (LAS float*)(lds + wave * 16384);
    for (int it = gw; it < 2 * IT_LAYER; it += ngw) {
        const int l = it / IT_LAYER; int r = it % IT_LAYER;
        if (r < IT_IN) { const int kb = r / 192, nb = r % 192;
            transpose_item(w_in + (size_t)l * DM * DIN, DIN, DM, (bf16*)(ws + WS_WIN) + (size_t)l * NINP * DM, nb * 32, win_src_col(nb), kb * 64, scr, lane); continue; }
        r -= IT_IN;
        if (r < IT_OUT) { const int kb = r / 64, nb = r % 64;
            transpose_item(w_out + (size_t)l * DM * DM, DM, DM, (bf16*)(ws + WS_WOUT) + (size_t)l * DM * DM, nb * 32, nb * 32, kb * 64, scr, lane); continue; }
        r -= IT_OUT;
        if (r < IT_UP) { const int kb = r / 352, nb = r % 352, tile = nb >> 3, j0 = 32 * (nb & 7);
            transpose_item(w_up + (size_t)l * DM * NUP, NUP, DM, (bf16*)(ws + WS_WUP) + (size_t)l * NUP * DM, nb * 32, (j0 >> 7) * DFF + 128 * tile + (j0 & 127), kb * 64, scr, lane); continue; }
        r -= IT_UP;
        { const int kb = r / 64, nb = r % 64;
            transpose_item(w_down + (size_t)l * DFF * DM, DM, DFF, (bf16*)(ws + WS_WDN) + (size_t)l * DM * DFF, nb * 32, nb * 32, kb * 64, scr, lane); }
    }
}
DI void p0_rope(float* cosT, float* sinT, int gt, int ngt) {
    for (int e = gt; e < 8200 * 64; e += ngt) {
        const int pos = e >> 6, i = e & 63;
        double inv = 1.0;
        if (i & 1) inv *= 0.8659643233600653;
        if (i & 2) inv *= 0.7498942093324559;
        if (i & 4) inv *= 0.5623413251903491;
        if (i & 8) inv *= 0.31622776601683794;
        if (i & 16) inv *= 0.1;
        if (i & 32) inv *= 0.01;
        double rev = (double)pos * inv * 0.15915494309189535;
        rev = rev - __builtin_rint(rev);
        const float fr = (float)rev;
        stf(cosT + e, __builtin_amdgcn_cosf(fr)); stf(sinT + e, __builtin_amdgcn_sinf(fr));
    }
}
DI void p0_mod(const float* c_prompt, const float* c_sample, const float* w_ada, const float* b_ada, float* MOD, LAS unsigned char* lds, int bid, int G, int tid, int wave, int lane) {
    LAS float* cpl = (LAS float*)(lds + 65536);
    LAS float* red = (LAS float*)(lds + 65536 + 8192);
    const int h = lane >> 5, r31 = lane & 31, kbase = 256 * wave;
    for (int i = tid; i < DM; i += NTHR) cpl[i] = siluf_(ldf(c_prompt + i));
    __syncthreads();
    for (int item = bid; item < 768; item += G) {
        const int l = item / 384, n0 = (item % 384) * 32;
        const float* W = w_ada + (size_t)l * DM * NMOD + n0 + r31;
        f32x16 acc = zero16(); float pacc = 0.f;
#pragma unroll 4
        for (int ks = 0; ks < 16; ++ks) { const int k0 = kbase + 16 * ks + 8 * h; float w[8];
#pragma unroll
            for (int j = 0; j < 8; ++j) w[j] = ldf(W + (size_t)(k0 + j) * NMOD);
            const float* cp = c_sample + (size_t)r31 * DM + k0; const f32x4 ca = ld4(cp), cb = ld4(cp + 4);
            u32x4 pa; pa.x = pk2(siluf_(ca.x), siluf_(ca.y)); pa.y = pk2(siluf_(ca.z), siluf_(ca.w)); pa.z = pk2(siluf_(cb.x), siluf_(cb.y)); pa.w = pk2(siluf_(cb.z), siluf_(cb.w));
            u32x4 p; p.x = pk2(w[0], w[1]); p.y = pk2(w[2], w[3]); p.z = pk2(w[4], w[5]); p.w = pk2(w[6], w[7]);
            acc = MFMA32(__builtin_bit_cast(bf16x8, pa), __builtin_bit_cast(bf16x8, p), acc);
            const LAS f32x4* cq = (const LAS f32x4*)(cpl + k0); const f32x4 c0 = cq[0], c1 = cq[1];
            pacc += c0.x * w[0] + c0.y * w[1] + c0.z * w[2] + c0.w * w[3] + c1.x * w[4] + c1.y * w[5] + c1.z * w[6] + c1.w * w[7]; }
        pacc += __shfl_xor(pacc, 32);
#pragma unroll
        for (int reg = 0; reg < 16; ++reg) red[(wave * 33 + 1 + crow(reg, h)) * 32 + r31] = acc[reg];
        if (h == 0) red[(wave * 33) * 32 + r31] = pacc;
        __syncthreads();
        for (int i = tid; i < 33 * 32; i += NTHR) { const int r = i >> 5, c = i & 31; float s = 0.f;
#pragma unroll
            for (int w = 0; w < 8; ++w) s += red[(w * 33 + r) * 32 + c];
            stf(MOD + ((size_t)l * 33 + r) * NMOD + n0 + c, s + ldf(b_ada + (size_t)l * NMOD + n0 + c)); }
        __syncthreads();
    }
}
DI void load_gate_w(const float* w_in_l, LAS float* Wg, int tid) {
    for (int i = tid; i < DM * 16; i += NTHR) { const int k = i >> 4, c = i & 15; Wg[c * DM + k] = ldf(w_in_l + (size_t)k * DIN + 3072 + c); }
}
DI void gate_row(const f32x4 (&v)[8], const LAS float* Wg, const float* bgate, float* IG, float* LF, int row, int lane) {
    float p[16];
#pragma unroll
    for (int c = 0; c < 16; ++c) { float a = 0.f;
#pragma unroll
        for (int j = 0; j < 8; ++j) { const f32x4 w = *(const LAS f32x4*)(Wg + c * DM + 256 * j + 4 * lane); a += v[j].x * w.x + v[j].y * w.y + v[j].z * w.z + v[j].w * w.w; }
        p[c] = a; asm volatile("" ::: "memory"); }
    float q[8], r[4], t2[2], t1;
    { const bool hi = (lane & 32) != 0;
#pragma unroll
      for (int i = 0; i < 8; ++i) { const float keep = hi ? p[8 + i] : p[i], send = hi ? p[i] : p[8 + i]; q[i] = keep + __shfl_xor(send, 32); } }
    { const bool hi = (lane & 16) != 0;
#pragma unroll
      for (int i = 0; i < 4; ++i) { const float keep = hi ? q[4 + i] : q[i], send = hi ? q[i] : q[4 + i]; r[i] = keep + __shfl_xor(send, 16); } }
    { const bool hi = (lane & 8) != 0;
#pragma unroll
      for (int i = 0; i < 2; ++i) { const float keep = hi ? r[2 + i] : r[i], send = hi ? r[i] : r[2 + i]; t2[i] = keep + __shfl_xor(send, 8); } }
    { const bool hi = (lane & 4) != 0; const float keep = hi ? t2[1] : t2[0], send = hi ? t2[0] : t2[1]; t1 = keep + __shfl_xor(send, 4); }
    t1 += __shfl_xor(t1, 2); t1 += __shfl_xor(t1, 1);
    if ((lane & 3) == 0) { const int c = (lane >> 2) & 15;
        const float x = t1 + ldf(bgate + c);
        if (c < 8) stf(IG + (size_t)row * 8 + c, x); else stf(LF + (size_t)row * 8 + (c - 8), logsigmoidf_(x)); }
}
DI void row_load(const float* p, f32x4 (&v)[8], int lane) {
#pragma unroll
    for (int j = 0; j < 8; ++j) v[j] = ld4(p + 4 * lane + 256 * j);
}
DI void modulate_fin(f32x4 (&v)[8], const float* sh, const float* sc, bf16* urow, const LAS float* Wg, const float* bgate, float* IG, float* LF, int row, int lane) {
#pragma unroll
    for (int j = 0; j < 8; ++j) { const int col = 4 * lane + 256 * j; const f32x4 a = ld4(sc + col), b = ld4(sh + col);
        v[j] = v[j] * (a + 1.f) + b; u32x2 o; o.x = pk2(v[j].x, v[j].y); o.y = pk2(v[j].z, v[j].w); st8(urow + col, o); }
    gate_row(v, Wg, bgate, IG, LF, row, lane);
}
DI void ln_fin(f32x4 (&v)[8], const float* g, const float* b, float* xo, const float* sh, const float* sc, bf16* urow,
               const LAS float* Wg, bool gates, const float* bgate, float* IG, float* LF, int row, int lane) {
    float s = 0.f;
#pragma unroll
    for (int j = 0; j < 8; ++j) s += (v[j].x + v[j].y) + (v[j].z + v[j].w);
    const float mean = wave_sum(s) * (1.f / DM); float s2 = 0.f;
#pragma unroll
    for (int j = 0; j < 8; ++j) { v[j] = v[j] - mean; s2 += (v[j].x * v[j].x + v[j].y * v[j].y) + (v[j].z * v[j].z + v[j].w * v[j].w); }
    const float rstd = 1.f / sqrtf(wave_sum(s2) * (1.f / DM) + 1e-5f);
#pragma unroll
    for (int j = 0; j < 8; ++j) { const int col = 4 * lane + 256 * j; const f32x4 gg = ld4(g + col), bb = ld4(b + col); const f32x4 o = v[j] * rstd * gg + bb; st4(xo + col, o);
        if (urow) { const f32x4 a = ld4(sc + col), c = ld4(sh + col); v[j] = o * (a + 1.f) + c; u32x2 w; w.x = pk2(v[j].x, v[j].y); w.y = pk2(v[j].z, v[j].w); st8(urow + col, w); } }
    if (gates) gate_row(v, Wg, bgate, IG, LF, row, lane);
}
DI void slab_row_load(const float* slab, int nslab, const float* res, const float* gate, f32x4 (&v)[8], int lane) {
#pragma unroll
    for (int j = 0; j < 8; ++j) { const int col = 4 * lane + 256 * j; f32x4 a = ld4(slab + col);
        for (int q = 1; q < nslab; ++q) a += ld4(slab + (size_t)q * NSMP * DM + col);
        v[j] = ld4(res + col) * ALPHA_RES + (ld4(gate + col) + 1.f) * a; }
}
#define XB_TMO      128
#define XB_XCNT(j)  (256  + 64 * (j))
#define XB_XSUB(j)  (1280 + 64 * (j))
#define XB_XGEN(j)  (2304 + 64 * (j))
#define XB_TOP      3328
#define XB_TOPGEN   3392
#define XCD_BAR_WORDS 3456
#define XB_SPIN_CAP (1u << 18)

__device__ __forceinline__ unsigned xb_ld(unsigned* p)              { return __hip_atomic_load(p, __ATOMIC_RELAXED, __HIP_MEMORY_SCOPE_AGENT); }
__device__ __forceinline__ unsigned xb_add(unsigned* p, unsigned v) { return __hip_atomic_fetch_add(p, v, __ATOMIC_RELAXED, __HIP_MEMORY_SCOPE_AGENT); }
__device__ __forceinline__ unsigned xb_xcc_id() { return (unsigned)__builtin_amdgcn_s_getreg((3 << 11) | 20) & 0xFu; }
#define XB_SPIN(cond, bar) do { unsigned _sp = 0; while (cond) { __builtin_amdgcn_s_sleep(1); \
    if ((++_sp & 255u) == 0u) { if (xb_ld(&(bar)[XB_TMO])) break; if (_sp > XB_SPIN_CAP) { atomicAdd(&(bar)[XB_TMO], 1u); break; } } } } while (0)

struct XcdBarrier {
    unsigned* bar; unsigned x;
    volatile LAS unsigned* st;
};

__device__ __forceinline__ XcdBarrier xcd_barrier_post(unsigned* bar, volatile LAS unsigned* st) {
    XcdBarrier b; b.bar = bar; b.x = xb_xcc_id(); b.st = st;
    if (threadIdx.x == 0) (void)xb_add(&bar[XB_XCNT(b.x)], 1u);
    return b;
}
__device__ __forceinline__ void xcd_barrier_complete(unsigned* bar, unsigned x, unsigned& nloc, unsigned& nx) {
    const unsigned G = gridDim.x * gridDim.y * gridDim.z;
    unsigned sum, cnt, mine, sp = 0u;
    for (;;) {
        sum = 0u; cnt = 0u; mine = 0u;
#pragma unroll
        for (unsigned j = 0; j < 16; ++j) { const unsigned c = xb_ld(&bar[XB_XCNT(j)]); sum += c; cnt += (c > 0u) ? 1u : 0u; mine = (j == x) ? c : mine; }
        if (sum == G) break;
        __builtin_amdgcn_s_sleep(1);
        if ((++sp & 255u) == 0u) { if (xb_ld(&bar[XB_TMO])) break; if (sp > XB_SPIN_CAP) { atomicAdd(&bar[XB_TMO], 1u); break; } }
    }
    nloc = mine > 0u ? mine : 1u; nx = cnt > 0u ? cnt : 1u;
}

__device__ __forceinline__ void xcd_barrier(const XcdBarrier& b) {
    asm volatile("s_waitcnt vmcnt(0)" ::: "memory");
    __syncthreads();
    if (threadIdx.x == 0) {
        unsigned* bar = b.bar;
        __builtin_amdgcn_s_waitcnt(0);
        unsigned nloc = b.st[0], nx = b.st[1];
        if (nloc == 0u) { xcd_barrier_complete(bar, b.x, nloc, nx); b.st[0] = nloc; b.st[1] = nx; }
        const unsigned old = xb_add(&bar[XB_XSUB(b.x)], 1u);
        const unsigned gen = old / nloc;
        if (old + 1u == (gen + 1u) * nloc) {
            __builtin_amdgcn_fence(__ATOMIC_RELEASE, "agent");
            asm volatile("s_waitcnt vmcnt(0)" ::: "memory");
            const unsigned og = xb_add(&bar[XB_TOP], 1u);
            const unsigned tg = og / nx;
            if (og + 1u == (tg + 1u) * nx) xb_add(&bar[XB_TOPGEN], 1u);
            else XB_SPIN(xb_ld(&bar[XB_TOPGEN]) == tg, bar);
            __builtin_amdgcn_fence(__ATOMIC_ACQUIRE, "agent");
            xb_add(&bar[XB_XGEN(b.x)], 1u);
            asm volatile("s_waitcnt vmcnt(0)" ::: "memory");
        } else {
            XB_SPIN(xb_ld(&bar[XB_XGEN(b.x)]) == gen, bar);
            __builtin_amdgcn_fence(__ATOMIC_ACQUIRE, "agent");
            asm volatile("s_waitcnt vmcnt(0)" ::: "memory");
        }
    }
    __syncthreads();
}

DI u32x4 pack8(f32x4 a, f32x4 b) { u32x4 w; w.x = pg8::cvt_pk_bf16(a[0], a[1]); w.y = pg8::cvt_pk_bf16(a[2], a[3]); w.z = pg8::cvt_pk_bf16(b[0], b[1]); w.w = pg8::cvt_pk_bf16(b[2], b[3]); return w; }

struct EpiIn {
    static constexpr bool PERM = true, AFTER_DRAIN = false;
    unsigned char* wsb; float* outb; int l;
    DI void operator()(const f32x4 (&acc)[2][2][4][2], const pg8::Unit& u, int wr, int wc, int fr0, int fq0) const {
        int fr = fr0, fq = fq0; asm volatile("" : "+v"(fr), "+v"(fq));
        bf16* P = (bf16*)(wsb + WS_P); const float* cosT = (const float*)(wsb + WS_ROPE); const float* sinT = cosT + 8200 * 64;
        float* kp = outb + O_KP + (size_t)l * 2048 * 1024; float* vp = outb + O_VP + (size_t)l * 2048 * 1024; float* ks = outb + O_KS + (size_t)l * NSMP * 1024; float* vs = outb + O_VS + (size_t)l * NSMP * 1024;
        const int pn = u.pn, rowb = u.pm * 256 + wr * 64 + fr;
        if (pn < 12 || pn >= 20) {
            const float sc = (pn == 2 || pn == 3) ? 0.125f : 1.f;
            const int colP = (pn < 12 ? pn * 256 : 5120 + (pn - 20) * 256) + wc * 32 + 8 * fq;
#pragma unroll
            for (int ai = 0; ai < 2; ++ai)
#pragma unroll
                for (int m = 0; m < 4; ++m) { const int row = rowb + ai * 128 + m * 16; bf16* rp = P + (size_t)row * PW + colP;
                    float* o = nullptr;
                    if (pn >= 20) { if (row >= SEQ) o = vs + (size_t)(row - SEQ) * 1024; else if (row >= SEQ - 2048) o = vp + (size_t)(row - (SEQ - 2048)) * 1024; }
#pragma unroll
                    for (int bj = 0; bj < 2; ++bj) { st16(rp + bj * 128, pack8(acc[ai][bj][m][0] * sc, acc[ai][bj][m][1] * sc));
                        if (o) { float* oc = o + (pn - 20) * 256 + bj * 128 + wc * 32 + 8 * fq; st4(oc, acc[ai][bj][m][0]); st4(oc + 4, acc[ai][bj][m][1]); } } }
        } else {
            const bool isq = pn < 16; const int tile = (pn - 12) & 3, head = 2 * tile + (wc >> 1), i0 = 32 * (wc & 1) + 8 * fq;
            const float qs = isq ? QSCALE : 1.f;
            const int colP = (isq ? 3072 : 4096) + head * 128 + i0;
#pragma unroll
            for (int ai = 0; ai < 2; ++ai)
#pragma unroll
                for (int m = 0; m < 4; ++m) { const int row = rowb + ai * 128 + m * 16; const int pos = row < SEQ ? row : SEQ + ((row - SEQ) & 7);
                    const f32x4 c0 = ld4(cosT + pos * 64 + i0), c1 = ld4(cosT + pos * 64 + i0 + 4), s0 = ld4(sinT + pos * 64 + i0), s1 = ld4(sinT + pos * 64 + i0 + 4);
                    const f32x4 x1a = acc[ai][0][m][0], x1b = acc[ai][0][m][1], x2a = acc[ai][1][m][0], x2b = acc[ai][1][m][1];
                    const f32x4 o1a = (x1a * c0 - x2a * s0) * qs, o1b = (x1b * c1 - x2b * s1) * qs, o2a = (x2a * c0 + x1a * s0) * qs, o2b = (x2b * c1 + x1b * s1) * qs;
                    bf16* rp = P + (size_t)row * PW + colP; st16(rp, pack8(o1a, o1b)); st16(rp + 64, pack8(o2a, o2b));
                    if (!isq) { float* o = nullptr; if (row >= SEQ) o = ks + (size_t)(row - SEQ) * 1024; else if (row >= SEQ - 2048) o = kp + (size_t)(row - (SEQ - 2048)) * 1024;
                        if (o) { o += head * 128 + i0; st4(o, o1a); st4(o + 4, o1b); st4(o + 64, o2a); st4(o + 68, o2b); } }
                    asm volatile("" ::: "memory"); }
        }
    }
};
struct EpiRes {
    static constexpr bool PERM = false, AFTER_DRAIN = false;
    float* Y; const float* resP; const float* gate; float* slab;
    DI void operator()(const f32x4 (&acc)[2][2][4][2], const pg8::Unit& u, int wr, int wc, int fr0, int fq0) const {
        int fr = fr0, fq = fq0; asm volatile("" : "+v"(fr), "+v"(fq));
        const int rowb = u.pm * 256 + wr * 64 + fr, col0 = u.pn * 256 + wc * 32 + 4 * fq;
        if (u.pm >= 32) {
#pragma unroll
            for (int ai = 0; ai < 2; ++ai)
#pragma unroll
                for (int m = 0; m < 4; ++m) { float* sp = slab + ((size_t)u.ks * NSMP + (wr * 64 + fr + ai * 128 + m * 16)) * DM + col0;
#pragma unroll
                    for (int bj = 0; bj < 2; ++bj)
#pragma unroll
                        for (int n = 0; n < 2; ++n) st4(sp + bj * 128 + n * 16, acc[ai][bj][m][n]); }
            return;
        }
#pragma unroll
        for (int ai = 0; ai < 2; ++ai)
#pragma unroll
            for (int m = 0; m < 4; ++m) { const int row = rowb + ai * 128 + m * 16;
                const float* res = resP + (size_t)row * DM; const float* gp = gate; float* yp = Y + (size_t)row * DM;
#pragma unroll
                for (int bj = 0; bj < 2; ++bj)
#pragma unroll
                    for (int n = 0; n < 2; ++n) { const int col = col0 + bj * 128 + n * 16; const f32x4 r = ld4(res + col), g = ld4(gp + col);
                        st4(yp + col, r * ALPHA_RES + (g + 1.f) * acc[ai][bj][m][n]); }
                asm volatile("" ::: "memory"); }
    }
};
DI f32x4 shfl4(f32x4 v, int src) { f32x4 r; r.x = __shfl(v.x, src); r.y = __shfl(v.y, src); r.z = __shfl(v.z, src); r.w = __shfl(v.w, src); return r; }
template <int CTRL> DI float dpp1(float x) { return __builtin_bit_cast(float, __builtin_amdgcn_update_dpp(0, __builtin_bit_cast(int, x), CTRL, 0xf, 0xf, false)); }
template <int CTRL> DI f32x4 dpp4(f32x4 v) { f32x4 r; r.x = dpp1<CTRL>(v.x); r.y = dpp1<CTRL>(v.y); r.z = dpp1<CTRL>(v.z); r.w = dpp1<CTRL>(v.w); return r; }
DI f32x4 sel4(bool c, f32x4 a, f32x4 b) { return c ? a : b; }
DI f32x4 silu4(f32x4 x) { return (f32x4){siluf_(x.x), siluf_(x.y), siluf_(x.z), siluf_(x.w)}; }
struct EpiUpConv {
    static constexpr bool PERM = true, AFTER_DRAIN = false;
    unsigned char* wsb; float* outb; const float* const __attribute__((address_space(4)))* inp; int l;
    DI void operator()(const f32x4 (&acc)[2][2][4][2], const pg8::Unit& u, int wr, int wc, int fr0, int fq0) const {
        int fr = fr0, fq = fq0; asm volatile("" : "+v"(fr), "+v"(fq));
        bf16* ACT = (bf16*)(wsb + WS_ACT); const float* cw = inp[19] + (size_t)l * 3 * DFF; const float* cb = inp[20] + (size_t)l * DFF; const float* sconv = inp[7] + (size_t)l * 32 * 2 * DFF;
        float* bp = outb + O_BP + (size_t)l * 2 * DFF; float* bs = outb + O_BS + (size_t)l * 32 * 2 * DFF; LAS float* xb = (LAS float*)(size_t)XB_OFF;
        const int lane = fq * 16 + fr, chl = wc * 32 + 8 * fq, ch0 = u.pn * 128 + chl, arow = 254 * u.pm - 2;
#pragma unroll
        for (int ai = 0; ai < 2; ++ai) if (fr >= 14) { LAS float* p = xb + ((2 * ai + wr) * 2 + (fr - 14)) * 128 + chl; *(LAS f32x4*)p = acc[ai][0][3][0]; *(LAS f32x4*)(p + 4) = acc[ai][0][3][1]; }
        asm volatile("s_waitcnt lgkmcnt(0)" ::: "memory"); __builtin_amdgcn_s_barrier(); asm volatile("" ::: "memory");
        const bool smp = arow + 255 >= SEQ;
#pragma unroll
        for (int ai = 0; ai < 2; ++ai)
#pragma unroll
            for (int hb = 0; hb < 2; ++hb) {
                const int ch = ch0 + 4 * hb;
                const f32x4 w0 = ld4(cw + ch), w1 = ld4(cw + DFF + ch), w2 = ld4(cw + 2 * DFF + ch), bi = ld4(cb + ch);
                const int q = 2 * ai + wr;
                f32x4 p1 = {0.f, 0.f, 0.f, 0.f}, p2 = p1;
                if (q > 0) { const LAS float* r14 = xb + ((q - 1) * 2) * 128 + chl + 4 * hb; p1 = *(const LAS f32x4*)(r14 + 128); p2 = fr == 0 ? *(const LAS f32x4*)r14 : p1; }
#pragma unroll
                for (int m = 0; m < 4; ++m) {
                    const f32x4 Gv = acc[ai][0][m][hb], Vv = acc[ai][1][m][hb];
                    const f32x4 c1 = dpp4<0x121>(Gv), c2 = dpp4<0x122>(Gv);
                    f32x4 g1 = sel4(fr >= 1, c1, p1), g2 = sel4(fr >= 2, c2, p2);
                    const int rt = 128 * ai + 64 * wr + 16 * m + fr, row = arow + rt;
                    if (smp && row >= SEQ && row < MR) { const int t = (row - SEQ) & 7;
                        if (t < 2) { const float* s1 = sconv + ((size_t)((row - SEQ) >> 3) * 2 + 1) * DFF + ch; const f32x4 s1v = ld4(s1);
                            if (t == 0) { g1 = s1v; g2 = ld4(s1 - DFF); } else g2 = s1v; } }
                    const f32x4 o = silu4(g2 * w0 + g1 * w1 + Gv * w2 + bi) * Vv;
                    if (rt >= 2 && row < MR) { u32x2 w; w.x = pg8::cvt_pk_bf16(o.x, o.y); w.y = pg8::cvt_pk_bf16(o.z, o.w); st8(ACT + (size_t)row * DFF + ch, w);
                        float* op = nullptr;
                        if (row < SEQ) { if (row >= SEQ - 2) op = bp + (size_t)(row - (SEQ - 2)) * DFF; } else { const int t = (row - SEQ) & 7; if (t >= 6) op = bs + ((size_t)((row - SEQ) >> 3) * 2 + (t - 6)) * DFF; }
                        if (op) st4(op + ch, Gv); }
                    p1 = c1; p2 = c2;
                    asm volatile("" : "+v"(p1), "+v"(p2));
                }
            }
    }
};

constexpr int VPITCH = 272, KPITCH = 144;

DI void attn_prompt_unit(const bf16* P, bf16* OP, float* ML, int u, LAS unsigned char* lds, unsigned ldsbase, int wave, int lane) {
    const int br = u >> 8, rem = u & 255, head = rem >> 5, blk = rem & 31;
    const int ld = 2 * br;
    const int sb = blk * 8 + wave, nbl = 8 - ld;
    const int r = sb >> nbl, u0 = (sb & ((1 << nbl) - 1)) << 5;
    const int r31 = lane & 31, h = lane >> 5;
    const unsigned vt = ldsbase + (unsigned)wave * (32 * VPITCH); LAS unsigned char* vtp = lds + wave * (32 * VPITCH);
    const int tokq = ((u0 + r31) << ld) + r;
    bf16x8 Qf[8];
    { const bf16* qp = P + (size_t)tokq * PW + 3072 + head * 128 + 8 * h;
#pragma unroll
      for (int ks = 0; ks < 8; ++ks) Qf[ks] = ldfrag(qp + 16 * ks); }
    f32x16 O[4];
#pragma unroll
    for (int d = 0; d < 4; ++d) O[d] = zero16();
    float mrun = -1e30f, lrun = 0.f;
    for (int jt = 0; jt < 5; ++jt) {
        const int ub = u0 - 128 + 32 * jt;
        if (ub < 0) continue;
        const bf16* kp = P + (size_t)(((ub + r31) << ld) + r) * PW + 4096 + head * 128 + 8 * h;
        bf16x8 Kf[8];
#pragma unroll
        for (int ks = 0; ks < 8; ++ks) Kf[ks] = ldfrag(kp + 16 * ks);
        u32x4 vst[8];
#pragma unroll
        for (int i = 0; i < 8; ++i) { const int row = 4 * i + (lane >> 4), ch = lane & 15; vst[i] = ld16(P + (size_t)(((ub + row) << ld) + r) * PW + 5120 + head * 128 + ch * 8); }
        f32x16 S = zero16();
#pragma unroll
        for (int ks = 0; ks < 8; ++ks) S = MFMA32(Kf[ks], Qf[ks], S);
#pragma unroll
        for (int i = 0; i < 8; ++i) { const int row = 4 * i + (lane >> 4), ch = lane & 15; *(LAS u32x4*)(vtp + row * VPITCH + ch * 16) = vst[i]; }
        float tmax = -INFINITY;
#pragma unroll
        for (int reg = 0; reg < 16; ++reg) { const int kk = crow(reg, h); const bool ok = (jt == 0) ? (kk >= r31) : ((jt == 4) ? (kk <= r31) : true);
            S[reg] = ok ? S[reg] : -INFINITY; tmax = fmaxf(tmax, S[reg]); }
        tmax = fmaxf(tmax, __shfl_xor(tmax, 32));
        const float mnew = fmaxf(mrun, tmax), alpha = fexp2(mrun - mnew); mrun = mnew;
        float psum = 0.f;
#pragma unroll
        for (int reg = 0; reg < 16; ++reg) { S[reg] = fexp2(S[reg] - mnew); psum += S[reg]; }
        psum += __shfl_xor(psum, 32);
        lrun = lrun * alpha + psum;
#pragma unroll
        for (int d = 0; d < 4; ++d) O[d] = O[d] * alpha;
        const bf16x8 P0 = pack_step(S, 0), P1 = pack_step(S, 1);
        LDS_WAIT();
#pragma unroll
        for (int d = 0; d < 4; ++d) {
            const bf16x8 A0 = tr_pair(vt, VPITCH, 4 * h, 8 + 4 * h, 32 * d, lane);
            O[d] = MFMA32(A0, P0, O[d]);
            const bf16x8 A1 = tr_pair(vt, VPITCH, 16 + 4 * h, 24 + 4 * h, 32 * d, lane);
            O[d] = MFMA32(A1, P1, O[d]);
        }
    }
    const float inv = 1.f / lrun;
    bf16* op = OP + ((size_t)br * SEQ + tokq) * 1024 + head * 128;
#pragma unroll
    for (int d = 0; d < 4; ++d)
#pragma unroll
        for (int g = 0; g < 4; ++g) { u32x2 w; w.x = pk2(O[d][4 * g] * inv, O[d][4 * g + 1] * inv); w.y = pk2(O[d][4 * g + 2] * inv, O[d][4 * g + 3] * inv); st8(op + 32 * d + 8 * g + 4 * h, w); }
    if (h == 0) { float* mp = ML + (((size_t)br * SEQ + tokq) * 8 + head) * 2; stf(mp, mrun); stf(mp + 1, lrun); }
}

DI void mlstm_m1_item(const bf16* P, const float* IG, const float* LF, float* SCAL, float* DCT, int it, LAS unsigned char* lds, unsigned ldsbase, int wave, int lane) {
    const int half = wave >> 2, wq = wave & 3, unit = it * 2 + half, c = unit >> 3, hd = unit & 7, row0 = c * LCH;
    const int hoff = half * 32768;
    LAS unsigned char* Vt = lds + hoff; LAS unsigned char* Kt = lds + hoff + 64 * VPITCH; LAS float* sc = (LAS float*)(lds + hoff + 64 * VPITCH + 64 * KPITCH);
    const int r31 = lane & 31, h = lane >> 5, t256 = wq * 64 + lane;
    if (wq == 0) {
        const float lf = ldf(LF + (size_t)(row0 + lane) * 8 + hd), ig = ldf(IG + (size_t)(row0 + lane) * 8 + hd);
        float b = lf;
#pragma unroll
        for (int o = 1; o < 64; o <<= 1) { const float t = __shfl_up(b, o); if (lane >= o) b += t; }
        const float d = ig - b; float pm = d;
#pragma unroll
        for (int o = 1; o < 64; o <<= 1) { const float t = __shfl_up(pm, o); if (lane >= o) pm = fmaxf(pm, t); }
        const float pm63 = __shfl(pm, 63);
        sc[lane] = fexp(d - pm63);
        float* sp = SCAL + (size_t)unit * 192; stf(sp + lane, b); stf(sp + 64 + lane, d); stf(sp + 128 + lane, pm);
    }
#pragma unroll
    for (int i = 0; i < 4; ++i) { const int id = i * 256 + t256, row = id >> 4, ch = id & 15;
        *(LAS u32x4*)(Vt + row * VPITCH + ch * 16) = ld16(P + (size_t)(row0 + row) * PW + 1024 + hd * 128 + ch * 8); }
    __syncthreads();
#pragma unroll
    for (int i = 0; i < 2; ++i) { const int id = i * 256 + t256, row = id >> 3, ch = id & 7; const float w = sc[row];
        const u32x4 kv = ld16(P + (size_t)(row0 + row) * PW + 512 + hd * 64 + ch * 8); u32x4 o;
        o.x = pk2(bflo(kv.x) * w, bfhi(kv.x) * w); o.y = pk2(bflo(kv.y) * w, bfhi(kv.y) * w); o.z = pk2(bflo(kv.z) * w, bfhi(kv.z) * w); o.w = pk2(bflo(kv.w) * w, bfhi(kv.w) * w);
        *(LAS u32x4*)(Kt + row * KPITCH + ch * 16) = o; }
    __syncthreads();
    f32x16 a0 = zero16(), a1 = zero16();
    const unsigned vtb = ldsbase + hoff, ktb = ldsbase + hoff + 64 * VPITCH;
#pragma unroll
    for (int ks = 0; ks < 4; ++ks) {
        const bf16x8 A = tr_pair(vtb, VPITCH, 16 * ks + 8 * h, 16 * ks + 8 * h + 4, 32 * wq, lane);
        const bf16x8 B0 = tr_pair(ktb, KPITCH, 16 * ks + 8 * h, 16 * ks + 8 * h + 4, 0, lane);
        const bf16x8 B1 = tr_pair(ktb, KPITCH, 16 * ks + 8 * h, 16 * ks + 8 * h + 4, 32, lane);
        a0 = MFMA32(A, B0, a0); a1 = MFMA32(A, B1, a1);
    }
    float* dp = DCT + (size_t)unit * (129 * 64);
#pragma unroll
    for (int reg = 0; reg < 16; ++reg) { const int dv = 32 * wq + crow(reg, h); stf(dp + dv * 64 + r31, a0[reg]); stf(dp + dv * 64 + 32 + r31, a1[reg]); }
    if (wq == 1) { float s = 0.f;
#pragma unroll 8
        for (int r = 0; r < 64; ++r) s += bf2f(*(const LAS unsigned short*)(Kt + r * KPITCH + lane * 2));
        stf(dp + 128 * 64 + lane, s); }
    __syncthreads();
}

DI void mlstm_m2(const float* SCAL, const float* DCT, bf16* CST, float* MST, float* outC, float* outN, float* outM, int e) {
    const int hd = e / 8256, idx = e % 8256;
    float C = 0.f, m = 0.f;
#pragma unroll 4
    for (int c = 0; c < NCH; ++c) {
        const int unit = c * 8 + hd;
        const float Bc = ldf(SCAL + (size_t)unit * 192 + 63), pmc = ldf(SCAL + (size_t)unit * 192 + 191), Ac = Bc + pmc;
        const float dc = ldf(DCT + (size_t)unit * 8256 + idx);
        const float mn = fmaxf(Bc + m, Ac), f1 = fexp(Bc + m - mn), f2 = fexp(Ac - mn);
        *(GAS unsigned short*)(CST + (size_t)unit * (160 * 64) + idx) = (unsigned short)f2bf(C);
        if (idx == 0) stf(MST + unit, m);
        C = f1 * C + f2 * dc; m = mn;
    }
    const int row = idx >> 6, dk = idx & 63;
    if (row < 128) stf(outC + (size_t)hd * 8192 + dk * 128 + row, C); else stf(outN + hd * 64 + dk, C);
    if (idx == 0) stf(outM + hd, m);
}
DI void attn_combine(const bf16* OP, const float* ML, bf16* CAT, int e) {
    const int tok = e >> 7, c8 = e & 127, head = c8 >> 4;
    float m[3], l[3];
#pragma unroll
    for (int b = 0; b < 3; ++b) { const float* mp = ML + (((size_t)b * SEQ + tok) * 8 + head) * 2; m[b] = ldf(mp); l[b] = ldf(mp + 1); }
    const float M = fmaxf(m[0], fmaxf(m[1], m[2]));
    float w[3], ws = 0.f;
#pragma unroll
    for (int b = 0; b < 3; ++b) { w[b] = fexp2(m[b] - M) * l[b]; ws += w[b]; }
    const float inv = 1.f / ws; float o[8];
#pragma unroll
    for (int j = 0; j < 8; ++j) o[j] = 0.f;
#pragma unroll
    for (int b = 0; b < 3; ++b) { const u32x4 v = ld16(OP + ((size_t)b * SEQ + tok) * 1024 + c8 * 8); const float wb = w[b] * inv;
        o[0] += wb * bflo(v.x); o[1] += wb * bfhi(v.x); o[2] += wb * bflo(v.y); o[3] += wb * bfhi(v.y); o[4] += wb * bflo(v.z); o[5] += wb * bfhi(v.z); o[6] += wb * bflo(v.w); o[7] += wb * bfhi(v.w); }
    u32x4 r; r.x = pk2(o[0], o[1]); r.y = pk2(o[2], o[3]); r.z = pk2(o[4], o[5]); r.w = pk2(o[6], o[7]);
    st16(CAT + (size_t)tok * DM + 1024 + c8 * 8, r);
}

DI void mlstm_m3_item(const bf16* P, const float* SCAL, const bf16* CST, const float* MST, const float* ghead, bf16* CAT, int it, LAS unsigned char* lds, unsigned ldsbase, int wave, int lane) {
    const int slot = wave >> 1, tw = wave & 1, unit = it * 4 + slot, c = unit >> 3, hd = unit & 7, row0 = c * LCH;
    const int r31 = lane & 31, h = lane >> 5, t = 32 * tw + r31;
    LAS unsigned char* Vt = lds + slot * (64 * VPITCH); const unsigned vtb = ldsbase + slot * (64 * VPITCH);
    { const int t128 = tw * 64 + lane;
#pragma unroll
      for (int i = 0; i < 8; ++i) { const int id = i * 128 + t128, row = id >> 4, ch = id & 15;
          *(LAS u32x4*)(Vt + row * VPITCH + ch * 16) = ld16(P + (size_t)(row0 + row) * PW + 1024 + hd * 128 + ch * 8); } }
    const float* sp = SCAL + (size_t)unit * 192;
    const float mc = ldf(MST + unit), bt = ldf(sp + t), pmt = ldf(sp + 128 + t);
    const float Mt = fmaxf(mc, pmt), gt = fexp(mc - Mt);
    bf16x8 Qf[4], Qg[4];
    { const bf16* qp = P + (size_t)(row0 + t) * PW + hd * 64 + 8 * h;
#pragma unroll
      for (int ks = 0; ks < 4; ++ks) { const u32x4 q = ld16(qp + 16 * ks); Qf[ks] = __builtin_bit_cast(bf16x8, q); u32x4 g;
          g.x = pk2(bflo(q.x) * gt, bfhi(q.x) * gt); g.y = pk2(bflo(q.y) * gt, bfhi(q.y) * gt); g.z = pk2(bflo(q.z) * gt, bfhi(q.z) * gt); g.w = pk2(bflo(q.w) * gt, bfhi(q.w) * gt); Qg[ks] = __builtin_bit_cast(bf16x8, g); } }
    f32x16 acc[5];
#pragma unroll
    for (int d = 0; d < 5; ++d) acc[d] = zero16();
    { const bf16* cp = CST + (size_t)unit * (160 * 64) + (size_t)r31 * 64 + 8 * h;
#pragma unroll
      for (int d = 0; d < 5; ++d)
#pragma unroll
          for (int ks = 0; ks < 4; ++ks) acc[d] = MFMA32(ldfrag(cp + d * 32 * 64 + 16 * ks), Qg[ks], acc[d]); }
    __syncthreads();
    float rowsum = 0.f;
    for (int st = 0; st <= tw; ++st) {
        const bf16* kp = P + (size_t)(row0 + 32 * st + r31) * PW + 512 + hd * 64 + 8 * h;
        f32x16 S = zero16();
#pragma unroll
        for (int ks = 0; ks < 4; ++ks) S = MFMA32(ldfrag(kp + 16 * ks), Qf[ks], S);
#pragma unroll
        for (int g = 0; g < 4; ++g) { const f32x4 dv = ld4(sp + 64 + 32 * st + 8 * g + 4 * h);
#pragma unroll
            for (int e = 0; e < 4; ++e) { const int kk = 8 * g + 4 * h + e; const bool ok = (st < tw) || (kk <= r31);
                const float p = ok ? S[4 * g + e] * fexp(dv[e] - Mt) : 0.f; S[4 * g + e] = p; rowsum += p; } }
        const bf16x8 P0 = pack_step(S, 0), P1 = pack_step(S, 1);
#pragma unroll
        for (int d = 0; d < 4; ++d) {
            const bf16x8 A0 = tr_pair(vtb, VPITCH, 32 * st + 4 * h, 32 * st + 8 + 4 * h, 32 * d, lane);
            acc[d] = MFMA32(A0, P0, acc[d]);
            const bf16x8 A1 = tr_pair(vtb, VPITCH, 32 * st + 16 + 4 * h, 32 * st + 24 + 4 * h, 32 * d, lane);
            acc[d] = MFMA32(A1, P1, acc[d]);
        }
    }
    rowsum += __shfl_xor(rowsum, 32);
    const float qn = __shfl(acc[4][0], r31);
    const float den = qn + rowsum, dn = fmaxf(fabsf(den), fexp(-(bt + Mt))), inv = 1.f / dn;
    float ss = 0.f;
#pragma unroll
    for (int d = 0; d < 4; ++d)
#pragma unroll
        for (int reg = 0; reg < 16; ++reg) { acc[d][reg] *= inv; ss += acc[d][reg] * acc[d][reg]; }
    ss += __shfl_xor(ss, 32);
    const float rn = 1.f / sqrtf(ss * (1.f / 128.f) + 1e-6f);
    const bf16* omp = P + (size_t)(row0 + t) * PW + 2048 + hd * 128; bf16* cp = CAT + (size_t)(row0 + t) * DM + hd * 128;
#pragma unroll
    for (int d = 0; d < 4; ++d)
#pragma unroll
        for (int g = 0; g < 4; ++g) { const int dv0 = 32 * d + 8 * g + 4 * h; const f32x4 gh = ld4(ghead + hd * 128 + dv0); const u32x2 om = ld8(omp + dv0);
            const float o0 = acc[d][4 * g] * rn * gh.x * sigmoidf_(bflo(om.x)), o1 = acc[d][4 * g + 1] * rn * gh.y * sigmoidf_(bfhi(om.x));
            const float o2 = acc[d][4 * g + 2] * rn * gh.z * sigmoidf_(bflo(om.y)), o3 = acc[d][4 * g + 3] * rn * gh.w * sigmoidf_(bfhi(om.y));
            u32x2 w; w.x = pk2(o0, o1); w.y = pk2(o2, o3); st8(cp + dv0, w); }
    __syncthreads();
}

DI void sample_mlstm_unit(const bf16* P, const float* IG, const float* LF, const float* C0g, const float* n0g, const float* m0g, const float* ghead, bf16* CAT,
                          float* outC, float* outN, float* outM, int b, int hd, LAS unsigned char* lds, int tid, int wave, int lane) {
    LAS float* q = (LAS float*)lds;
    LAS float* k = q + 512;
    LAS float* v = k + 512;
    LAS float* S = v + 1024;
    LAS float* sb = S + 64;
    LAS float* sd = sb + 8;
    LAS float* sM = sd + 8;
    LAS float* sg = sM + 8;
    LAS float* sqn = sg + 8;
    LAS float* sdi = sqn + 8;
    LAS float* sss = sdi + 8;
    LAS float* skw = sss + 16;
    const int R0 = SEQ + 8 * b;
    { const int t = tid >> 6, dk = tid & 63;
      q[tid] = bf2f(*(const GAS unsigned short*)(P + (size_t)(R0 + t) * PW + hd * 64 + dk));
      k[tid] = bf2f(*(const GAS unsigned short*)(P + (size_t)(R0 + t) * PW + 512 + hd * 64 + dk));
#pragma unroll
      for (int i = 0; i < 2; ++i) { const int e = tid + 512 * i, tt = e >> 7, dv = e & 127; v[e] = bf2f(*(const GAS unsigned short*)(P + (size_t)(R0 + tt) * PW + 1024 + hd * 128 + dv)); } }
    const float m0 = ldf(m0g);
    if (wave == 0) {
        const int tt = lane & 7;
        const float lf = ldf(LF + (size_t)(R0 + tt) * 8 + hd), ig = ldf(IG + (size_t)(R0 + tt) * 8 + hd);
        float bb = lf;
#pragma unroll
        for (int o = 1; o < 8; o <<= 1) { const float x = __shfl_up(bb, o, 8); if (tt >= o) bb += x; }
        const float d = ig - bb; float pm = d;
#pragma unroll
        for (int o = 1; o < 8; o <<= 1) { const float x = __shfl_up(pm, o, 8); if (tt >= o) pm = fmaxf(pm, x); }
        if (lane < 8) { const float M = fmaxf(m0, pm); sb[tt] = bb; sd[tt] = d; sM[tt] = M; sg[tt] = fexp(m0 - M); }
    }
    __syncthreads();
    if (tid < 64) { const int t = tid >> 3, s = tid & 7; float a = 0.f;
#pragma unroll 8
        for (int dk = 0; dk < 64; ++dk) a += q[t * 64 + dk] * k[s * 64 + dk];
        S[tid] = (s <= t) ? a * fexp(sd[s] - sM[t]) : 0.f;
    } else if (tid < 128) { const int i = tid - 64, t = i >> 3, part = i & 7; float a = 0.f;
#pragma unroll
        for (int j = 0; j < 8; ++j) a += q[t * 64 + part * 8 + j] * ldf(n0g + part * 8 + j);
        a += __shfl_xor(a, 1); a += __shfl_xor(a, 2); a += __shfl_xor(a, 4);
        if (part == 0) sqn[t] = a;
    }
    { const int s = tid >> 6, dk = tid & 63; skw[tid] = fexp(sd[s] - sM[7]) * k[s * 64 + dk]; }
    __syncthreads();
    if (tid < 8) { float rs = 0.f;
#pragma unroll
        for (int s = 0; s < 8; ++s) rs += S[tid * 8 + s];
        const float den = sg[tid] * sqn[tid] + rs; sdi[tid] = 1.f / fmaxf(fabsf(den), fexp(-(sb[tid] + sM[tid]))); }
    __syncthreads();
    const int dv = tid & 127, tq = tid >> 7;
    float a0 = 0.f, a1 = 0.f;
#pragma unroll 8
    for (int dk = 0; dk < 64; ++dk) { const float c = ldf(C0g + dk * 128 + dv); a0 += q[tq * 64 + dk] * c; a1 += q[(tq + 4) * 64 + dk] * c; }
    float vv[8];
#pragma unroll
    for (int s = 0; s < 8; ++s) vv[s] = v[s * 128 + dv];
    float n0_ = sg[tq] * a0, n1_ = sg[tq + 4] * a1;
#pragma unroll
    for (int s = 0; s < 8; ++s) { n0_ += S[tq * 8 + s] * vv[s]; n1_ += S[(tq + 4) * 8 + s] * vv[s]; }
    const float h0 = n0_ * sdi[tq], h1 = n1_ * sdi[tq + 4];
    const float p0 = wave_sum(h0 * h0), p1 = wave_sum(h1 * h1);
    if (lane == 0) { sss[tq * 2 + (wave & 1)] = p0; sss[(tq + 4) * 2 + (wave & 1)] = p1; }
    __syncthreads();
    { const float r0 = 1.f / sqrtf((sss[tq * 2] + sss[tq * 2 + 1]) * (1.f / 128.f) + 1e-6f), r1 = 1.f / sqrtf((sss[(tq + 4) * 2] + sss[(tq + 4) * 2 + 1]) * (1.f / 128.f) + 1e-6f);
      const float gh = ldf(ghead + hd * 128 + dv);
      const float om0 = bf2f(*(const GAS unsigned short*)(P + (size_t)(R0 + tq) * PW + 2048 + hd * 128 + dv)), om1 = bf2f(*(const GAS unsigned short*)(P + (size_t)(R0 + tq + 4) * PW + 2048 + hd * 128 + dv));
      *(GAS unsigned short*)(CAT + (size_t)(R0 + tq) * DM + hd * 128 + dv) = (unsigned short)f2bf(h0 * r0 * gh * sigmoidf_(om0));
      *(GAS unsigned short*)(CAT + (size_t)(R0 + tq + 4) * DM + hd * 128 + dv) = (unsigned short)f2bf(h1 * r1 * gh * sigmoidf_(om1)); }
    const float gend = sg[7];
#pragma unroll 4
    for (int j = 0; j < 16; ++j) { const int dk = 16 * tq + j; float c = gend * ldf(C0g + dk * 128 + dv);
#pragma unroll
        for (int s = 0; s < 8; ++s) c += skw[s * 64 + dk] * vv[s];
        stf(outC + dk * 128 + dv, c); }
    if (tid < 64) { float n = gend * ldf(n0g + tid);
#pragma unroll
        for (int s = 0; s < 8; ++s) n += skw[s * 64 + tid];
        stf(outN + tid, n); }
    if (tid == 0) stf(outM, sb[7] + sM[7]);
    __syncthreads();
}

DI int sa_slot_idx(int tile, int s) {
    if (tile < 24) { const int sl = tile * 32 + s; return (sl >> 3) * 16 + (sl & 7); }
    if (tile < 40) return 1536 + (tile - 24) * 32 + s;
    return s < 8 ? 2048 + s : -1;
}
DI void sample_attn_unit(const bf16* P, const float* ck, const float* cv, bf16* CAT, int b, int head, LAS unsigned char* lds, unsigned ldsbase, int tid, int wave, int lane0) {
    const int lane = lane0, r31 = lane & 31, h = lane >> 5, R0 = SEQ + 8 * b;
    LAS unsigned char* vtp = lds + wave * (32 * VPITCH); const unsigned vt = ldsbase + (unsigned)wave * (32 * VPITCH);
    LAS float* Ow = (LAS float*)(lds + 73728);
    LAS float* Mw = (LAS float*)(lds + 73728 + 32768);
    LAS float* Lw = Mw + 64;
    f32x16 O[4];
#pragma unroll
    for (int d = 0; d < 4; ++d) O[d] = zero16();
    float mrun = -1e30f, lrun = 0.f;
    const float* ckb = ck + (size_t)b * 2048 * 1024 + head * 128; const float* cvb = cv + (size_t)b * 2048 * 1024 + head * 128;
    for (int tile = wave; tile < 41; tile += 8) {
        int lq = lane; asm volatile("" : "+v"(lq));
        const int r31 = lq & 31, h = lq >> 5, lane = lq;
        f32x16 S = zero16(); f32x4 vv[16];
        bf16x8 Qf[8];
        { const bf16* qp = P + (size_t)(R0 + (r31 & 7)) * PW + 3072 + head * 128 + 8 * h;
#pragma unroll
          for (int ks = 0; ks < 8; ++ks) { u32x4 q = ld16(qp + 16 * ks); if (r31 >= 8) q = (u32x4){0u, 0u, 0u, 0u}; Qf[ks] = __builtin_bit_cast(bf16x8, q); } }
        if (tile < 40) {
            const float* kp = ckb + (size_t)sa_slot_idx(tile, r31) * 1024 + 8 * h;
            f32x4 kk[16];
#pragma unroll
            for (int ks = 0; ks < 8; ++ks) { kk[2 * ks] = ld4(kp + 16 * ks); kk[2 * ks + 1] = ld4(kp + 16 * ks + 4); }
#pragma unroll
            for (int ks = 0; ks < 8; ++ks) { const f32x4 a = kk[2 * ks], c = kk[2 * ks + 1];
                u32x4 w; w.x = pk2(a.x, a.y); w.y = pk2(a.z, a.w); w.z = pk2(c.x, c.y); w.w = pk2(c.z, c.w); S = MFMA32(__builtin_bit_cast(bf16x8, w), Qf[ks], S); }
            asm volatile("" ::: "memory");
#pragma unroll
            for (int i = 0; i < 16; ++i) { const int id = i * 64 + lane, row = id >> 5, c4 = id & 31; vv[i] = ld4(cvb + (size_t)sa_slot_idx(tile, row) * 1024 + 4 * c4); }
        } else {
            const bf16* kp = P + (size_t)(R0 + (r31 & 7)) * PW + 4096 + head * 128 + 8 * h;
#pragma unroll
            for (int ks = 0; ks < 8; ++ks) { u32x4 w = ld16(kp + 16 * ks); if (r31 >= 8) w = (u32x4){0u, 0u, 0u, 0u}; S = MFMA32(__builtin_bit_cast(bf16x8, w), Qf[ks], S); }
#pragma unroll
            for (int i = 0; i < 8; ++i) { const int id = i * 64 + lane, row = id >> 4, ch = id & 15; u32x4 w = ld16(P + (size_t)(R0 + (row & 7)) * PW + 5120 + head * 128 + ch * 8); if (row >= 8) w = (u32x4){0u, 0u, 0u, 0u};
                *(LAS u32x4*)(vtp + row * VPITCH + ch * 16) = w; }
#pragma unroll
            for (int i = 0; i < 16; ++i) vv[i] = (f32x4){0.f, 0.f, 0.f, 0.f};
        }
        float tmax = -INFINITY;
#pragma unroll
        for (int reg = 0; reg < 16; ++reg) { const int idx = sa_slot_idx(tile, crow(reg, h)); const int dist = 2048 + r31 - idx;
            int mult = 0;
            if (idx >= 0 && r31 < 8 && dist >= 0) mult = (dist <= 128 ? 1 : 0) + (((dist & 3) == 0 && dist <= 512) ? 1 : 0) + (((dist & 15) == 0 && dist <= 2048) ? 1 : 0);
            if (mult) tmax = fmaxf(tmax, S[reg]);
            const float lm = mult == 3 ? 1.5849625f : (mult == 2 ? 1.f : 0.f);
            S[reg] = mult ? S[reg] + lm : -INFINITY; }
        tmax = fmaxf(tmax, __shfl_xor(tmax, 32));
        const float mnew = fmaxf(mrun, tmax), alpha = fexp2(mrun - mnew); mrun = mnew;
        float psum = 0.f;
#pragma unroll
        for (int reg = 0; reg < 16; ++reg) { S[reg] = fexp2(S[reg] - mnew); psum += S[reg]; }
        psum += __shfl_xor(psum, 32);
        lrun = lrun * alpha + psum;
#pragma unroll
        for (int d = 0; d < 4; ++d) O[d] = O[d] * alpha;
        const bf16x8 P0 = pack_step(S, 0), P1 = pack_step(S, 1);
        if (tile < 40) {
#pragma unroll
            for (int i = 0; i < 16; ++i) { const int id = i * 64 + lane, row = id >> 5, c4 = id & 31; u32x2 w; w.x = pk2(vv[i].x, vv[i].y); w.y = pk2(vv[i].z, vv[i].w); *(LAS u32x2*)(vtp + row * VPITCH + c4 * 8) = w; }
        }
        LDS_WAIT();
#pragma unroll
        for (int d = 0; d < 4; ++d) {
            const bf16x8 A0 = tr_pair(vt, VPITCH, 4 * h, 8 + 4 * h, 32 * d, lane);
            O[d] = MFMA32(A0, P0, O[d]);
            const bf16x8 A1 = tr_pair(vt, VPITCH, 16 + 4 * h, 24 + 4 * h, 32 * d, lane);
            O[d] = MFMA32(A1, P1, O[d]);
        }
    }
    if (r31 < 8) {
#pragma unroll
        for (int d = 0; d < 4; ++d)
#pragma unroll
            for (int reg = 0; reg < 16; ++reg) Ow[(wave * 8 + r31) * 128 + 32 * d + crow(reg, h)] = O[d][reg];
        if (h == 0) { Mw[wave * 8 + r31] = mrun; Lw[wave * 8 + r31] = lrun; }
    }
    __syncthreads();
#pragma unroll
    for (int i = 0; i < 2; ++i) { const int e = tid + 512 * i, t = e >> 7, d = e & 127; float M = -1e30f;
#pragma unroll
        for (int w = 0; w < 8; ++w) M = fmaxf(M, Mw[w * 8 + t]);
        float num = 0.f, den = 0.f;
#pragma unroll
        for (int w = 0; w < 8; ++w) { const float f = fexp2(Mw[w * 8 + t] - M); num += f * Ow[(w * 8 + t) * 128 + d]; den += f * Lw[w * 8 + t]; }
        *(GAS unsigned short*)(CAT + (size_t)(R0 + t) * DM + 1024 + head * 128 + d) = (unsigned short)f2bf(num / den); }
    __syncthreads();
}

DI void sample_attn_unit_v1(const bf16* P, const float* ck, const float* cv, bf16* CAT, int b, int head, LAS unsigned char* lds, int wave, int lane) {
    LAS float* sc = (LAS float*)lds + wave * 136;
    const int t = wave, half = lane >> 5, r31 = lane & 31, R0 = SEQ + 8 * b;
    f32x4 q;
    { const u32x2 w = ld8(P + (size_t)(R0 + t) * PW + 3072 + head * 128 + 4 * r31); q.x = bflo(w.x); q.y = bfhi(w.x); q.z = bflo(w.y); q.w = bfhi(w.y); }
    float Mr = -1e30f, Lr = 0.f; f32x4 Ar = {0.f, 0.f, 0.f, 0.f};
    const float* ckb = ck + (size_t)b * 2048 * 1024 + head * 128 + 4 * r31; const float* cvb = cv + (size_t)b * 2048 * 1024 + head * 128 + 4 * r31;
    for (int br = 0; br < 3; ++br) {
        const int ld = 2 * br;
#pragma unroll 5
        for (int jj = 0; jj < 65; ++jj) { const int j = 2 * jj + half; const bool ok = j <= 128; const int idx = 2048 + t - ((ok ? j : 0) << ld);
            f32x4 kv;
            if (idx >= 2048) { const u32x2 w = ld8(P + (size_t)(R0 + idx - 2048) * PW + 4096 + head * 128 + 4 * r31); kv.x = bflo(w.x); kv.y = bfhi(w.x); kv.z = bflo(w.y); kv.w = bfhi(w.y); }
            else kv = ld4(ckb + (size_t)idx * 1024);
            float s = q.x * kv.x + q.y * kv.y + q.z * kv.z + q.w * kv.w;
            s += __shfl_xor(s, 1); s += __shfl_xor(s, 2); s += __shfl_xor(s, 4); s += __shfl_xor(s, 8); s += __shfl_xor(s, 16);
            if (r31 == 0 && ok) sc[j] = s; }
        LDS_WAIT();
        float s0 = sc[lane], s1 = sc[64 + lane], s2 = (lane == 0) ? sc[128] : -INFINITY;
        const float m = wave_max(fmaxf(s0, fmaxf(s1, s2)));
        s0 = fexp2(s0 - m); s1 = fexp2(s1 - m); s2 = fexp2(s2 - m);
        const float l = wave_sum(s0 + s1 + s2);
        sc[lane] = s0; sc[64 + lane] = s1; if (lane == 0) sc[128] = s2;
        LDS_WAIT();
        f32x4 acc = {0.f, 0.f, 0.f, 0.f};
#pragma unroll 5
        for (int jj = 0; jj < 65; ++jj) { const int j = 2 * jj + half; const bool ok = j <= 128; const int idx = 2048 + t - ((ok ? j : 0) << ld);
            f32x4 vv;
            if (idx >= 2048) { const u32x2 w = ld8(P + (size_t)(R0 + idx - 2048) * PW + 5120 + head * 128 + 4 * r31); vv.x = bflo(w.x); vv.y = bfhi(w.x); vv.z = bflo(w.y); vv.w = bfhi(w.y); }
            else vv = ld4(cvb + (size_t)idx * 1024);
            const float p = ok ? sc[ok ? j : 0] : 0.f;
            acc += vv * p; }
        acc.x += __shfl_xor(acc.x, 32); acc.y += __shfl_xor(acc.y, 32); acc.z += __shfl_xor(acc.z, 32); acc.w += __shfl_xor(acc.w, 32);
        const float Mn = fmaxf(Mr, m), fa = fexp2(Mr - Mn), fb = fexp2(m - Mn);
        Ar = Ar * fa + acc * fb; Lr = Lr * fa + l * fb; Mr = Mn;
        LDS_WAIT();
    }
    if (half == 0) { const float inv = 1.f / Lr; u32x2 w; w.x = pk2(Ar.x * inv, Ar.y * inv); w.y = pk2(Ar.z * inv, Ar.w * inv);
        st8(CAT + (size_t)(R0 + t) * DM + 1024 + head * 128 + 4 * r31, w); }
}

DI f32x4 bf4lo(u32x4 w) { return (f32x4){bflo(w.x), bfhi(w.x), bflo(w.y), bfhi(w.y)}; }
DI f32x4 bf4hi(u32x4 w) { return (f32x4){bflo(w.z), bfhi(w.z), bflo(w.w), bfhi(w.w)}; }
constexpr int CONV_ROWS = 64, CONV_PT = (SEQ / CONV_ROWS) * 704, CONV_TASKS = CONV_PT + 32 * 704;
DI void conv_task(const bf16* GV, bf16* ACT, const float* cw, const float* cb, const float* sconv, int e) {
    int row0, nb, cg; f32x4 gm2[2], gm1[2];
    if (e < CONV_PT) { const int rc = e / 704; cg = e % 704; row0 = rc * CONV_ROWS; nb = CONV_ROWS / 8;
        if (rc == 0) { gm2[0] = gm2[1] = gm1[0] = gm1[1] = (f32x4){0.f, 0.f, 0.f, 0.f}; }
        else { const u32x4 a = ld16(GV + (size_t)(row0 - 2) * NUP + cg * 8), b = ld16(GV + (size_t)(row0 - 1) * NUP + cg * 8);
            gm2[0] = bf4lo(a); gm2[1] = bf4hi(a); gm1[0] = bf4lo(b); gm1[1] = bf4hi(b); }
    } else { const int e2 = e - CONV_PT, bb = e2 / 704; cg = e2 % 704; row0 = SEQ + 8 * bb; nb = 1;
        const float* s0 = sconv + ((size_t)bb * 2) * DFF + cg * 8;
        gm2[0] = ld4(s0); gm2[1] = ld4(s0 + 4); gm1[0] = ld4(s0 + DFF); gm1[1] = ld4(s0 + DFF + 4); }
    const int c0 = cg * 8;
    const f32x4 w0a = ld4(cw + c0), w0b = ld4(cw + c0 + 4), w1a = ld4(cw + DFF + c0), w1b = ld4(cw + DFF + c0 + 4), w2a = ld4(cw + 2 * DFF + c0), w2b = ld4(cw + 2 * DFF + c0 + 4);
    const f32x4 ba = ld4(cb + c0), bb4 = ld4(cb + c0 + 4);
    for (int b8 = 0; b8 < nb; ++b8) {
        u32x4 gw[8], vw[8];
#pragma unroll
        for (int r = 0; r < 8; ++r) { const size_t ro = (size_t)(row0 + 8 * b8 + r) * NUP + c0; gw[r] = ld16(GV + ro); vw[r] = ld16(GV + ro + DFF); }
#pragma unroll
        for (int r = 0; r < 8; ++r) {
            const f32x4 g0 = bf4lo(gw[r]), g1 = bf4hi(gw[r]), v0 = bf4lo(vw[r]), v1 = bf4hi(vw[r]);
            const f32x4 x0 = gm2[0] * w0a + gm1[0] * w1a + g0 * w2a + ba, x1 = gm2[1] * w0b + gm1[1] * w1b + g1 * w2b + bb4;
            u32x4 o; o.x = pk2(siluf_(x0.x) * v0.x, siluf_(x0.y) * v0.y); o.y = pk2(siluf_(x0.z) * v0.z, siluf_(x0.w) * v0.w);
            o.z = pk2(siluf_(x1.x) * v1.x, siluf_(x1.y) * v1.y); o.w = pk2(siluf_(x1.z) * v1.z, siluf_(x1.w) * v1.w);
            st16(ACT + (size_t)(row0 + 8 * b8 + r) * DFF + c0, o);
            gm2[0] = gm1[0]; gm2[1] = gm1[1]; gm1[0] = g0; gm1[1] = g1; }
    }
}

#ifndef MK_SPLIT
#define MK_SPLIT 0
#endif
constexpr int N_PHASES = 22;
struct Args { const float* in[24]; float* out; unsigned char* ws; int ph_lo, ph_hi, li, pad; };

typedef const Args __attribute__((address_space(4)))* KArgs;
struct GOrder {
    pg8::StaticOrder so; int mode, nS, nUnits, G, c; pg8::Unit one;
    DI bool next(int i, pg8::Unit& u) const {
        if (mode == 0) return so.next(i, u);
        if (mode == 1) { const int L = i * G + c; if (L >= nUnits) return false; u.pm = 32; u.pn = L / nS; u.ks = L % nS; return true; }
        if (i) return false; u = one; return true;
    }
    DI void a_ready(const pg8::Unit&) const {}
    DI void done(const pg8::Unit&) const {}
};
DI GOrder order_static(int M, int N, int G, int c) { GOrder o; o.so.init(M, N, G, c); o.mode = 0; o.nS = 1; o.nUnits = 0; o.G = G; o.c = c; o.one = pg8::Unit{0, 0, 0}; return o; }
DI GOrder order_split(int nN, int nS, int G, int c) { GOrder o; o.so.init(256, 256, G, c); o.mode = 1; o.nS = nS; o.nUnits = nN * nS; o.G = G; o.c = c; o.one = pg8::Unit{0, 0, 0}; return o; }
DI GOrder order_one(int pm, int pn) { GOrder o; o.so.init(256, 256, 1, 0); o.mode = 2; o.nS = 1; o.nUnits = 1; o.G = 1; o.c = 0; o.one = pg8::Unit{pm, pn, 0}; return o; }
DI int dequeue(gu32* qw, volatile LAS unsigned* slot, int tid) {
    __syncthreads();
    if (tid == 0) *slot = __hip_atomic_fetch_add(qw, 1u, RLX_AGENT);
    __syncthreads();
    return (int)*slot;
}

__global__ void __launch_bounds__(NTHR, 2) mk_fwd(Args a) {
    extern __shared__ __attribute__((aligned(16))) unsigned char lds_raw[];
    LAS unsigned char* lds = (LAS unsigned char*)lds_raw;
    const unsigned ldsbase = (unsigned)(size_t)lds_raw;
    const int tid = threadIdx.x, lane = tid & 63, wave = __builtin_amdgcn_readfirstlane(tid >> 6);
    const int G = gridDim.x, bid = blockIdx.x;
    volatile LAS unsigned* MISC = (volatile LAS unsigned*)(lds + MISC_OFF);
    for (int u = tid; u < (LDS_BYTES - LDSCTL_OFF) / 4; u += NTHR) ((LAS unsigned*)(lds + LDSCTL_OFF))[u] = 0u;
    __syncthreads();
    unsigned char* const ws = a.ws; float* const out0 = a.out;
    const KArgs ka0 = (KArgs)__builtin_amdgcn_kernarg_segment_ptr();
    XcdBarrier bar = xcd_barrier_post((unsigned*)ws + CW_BAR + a.li * XCD_BAR_WORDS, MISC + 8);
    const int lo = a.ph_lo, hi = a.ph_hi;
#ifndef MK_MASK
#define MK_MASK 0xFFFFFFFFu
#endif
#ifndef MK_DBL
#define MK_DBL 0u
#endif
#ifndef MK_C
#define MK_C 15
#endif
#ifndef MK_DBLC
#define MK_DBLC 0
#endif
#define RPC(j) (((MK_DBLC >> (j)) & 1) ? 2 : 1)
#define RUN(k) (lo <= (k) && (k) < hi)
#define EN(j) ((MK_MASK >> (j)) & 1u)
#define REPS(j) (((MK_DBL >> (j)) & 1u) ? 2 : 1)
#ifndef MK_BAR2
#define MK_BAR2 0
#endif
#define SEAM(k) do { if (RUN(k) && RUN((k) + 1)) { xcd_barrier(bar); if (MK_BAR2) xcd_barrier(bar); } } while (0)
#define PH() int ln = lane, td = tid; unsigned char* wsl = ws; float* out = out0; KArgs ka = ka0; asm volatile("" : "+v"(ln), "+v"(td), "+s"(wsl), "+s"(out), "+s"(ka)); \
             const int gw = bid * NWAVES + wave, ngw = G * NWAVES, gt = bid * NTHR + td, ngt = G * NTHR; (void)ln; (void)td; (void)gw; (void)ngw; (void)gt; (void)ngt; (void)out; (void)ka
#define W_(T, off) ((T*)(wsl + (off)))
#define IN_(k) (ka->in[k])
#define QW_(q) ((gu32*)wsl + CW_Q + 64 * (q))
#define PHQ() ln = lane; td = tid; wsl = ws; out = out0; ka = ka0; asm volatile("" : "+v"(ln), "+v"(td), "+s"(wsl), "+s"(out), "+s"(ka))

    if (EN(0) && RUN(0)) for (int rep_ = 0; rep_ < REPS(0); ++rep_) {
        { PH(); p0_mod(IN_(8), IN_(9), IN_(10), IN_(11), W_(float, WS_MOD), lds, bid, G, td, wave, ln); }
        { PH(); p0_rope(W_(float, WS_ROPE), W_(float, WS_ROPE) + 8200 * 64, gt, ngt);
          if (gt < 2 * DM / 8) st16(W_(bf16, WS_UPAD) + (size_t)gt * 8, (u32x4){0u, 0u, 0u, 0u}); }
        { PH(); p0_weights(IN_(12), IN_(15), IN_(18), IN_(21), wsl, lds, gw, ngw, wave, ln); }
        __syncthreads();
    }
    SEAM(0);
    if (EN(1) && RUN(1)) for (int rep_ = 0; rep_ < REPS(1); ++rep_) { PH(); const float* xp = IN_(0); const float* xs = IN_(1);
        load_gate_w(IN_(12), (LAS float*)lds, td); __syncthreads();
        { f32x4 cur[8], nxt[8]; const float* mr = W_(float, WS_MOD);
          row_load(xp + (size_t)(gw < SEQ ? gw : 0) * DM, cur, ln);
          for (int row = gw; row < SEQ; row += ngw) { const int nr = row + ngw; row_load(xp + (size_t)(nr < SEQ ? nr : row) * DM, nxt, ln);
              int lq = ln; asm volatile("" : "+v"(lq));
              modulate_fin(cur, mr, mr + DM, W_(bf16, WS_U) + (size_t)row * DM, (const LAS float*)lds, IN_(13), W_(float, WS_IG), W_(float, WS_LF), row, lq);
#pragma unroll
              for (int j = 0; j < 8; ++j) cur[j] = nxt[j]; }
          for (int row = SEQ + gw; row < MR; row += ngw) { const float* ms = W_(float, WS_MOD) + (size_t)mod_row(row) * NMOD; row_load(xs + (size_t)(row - SEQ) * DM, cur, ln);
              modulate_fin(cur, ms, ms + DM, W_(bf16, WS_U) + (size_t)row * DM, (const LAS float*)lds, IN_(13), W_(float, WS_IG), W_(float, WS_LF), row, ln); } }
        __syncthreads();
    }
    SEAM(1);
    for (int l = 0; l < 2; ++l) {
        const int pb = 2 + 10 * l;
        if (EN(2) && RUN(pb + 0)) for (int rep_ = 0; rep_ < REPS(2); ++rep_) { PH();
            pg8::Gemm g{W_(bf16, WS_U), W_(bf16, WS_WIN) + (size_t)l * NINP * DM, SEQ, NINP, DM, DM, 256, 0}; const GOrder S = order_static(SEQ, NINP, G, bid);
            EpiIn E{wsl, out, l};
            pg8::gemm_phase<EpiIn, GOrder, true, true>(lds, g, S, E);
        }
        SEAM(pb + 0);
        if (EN(3) && RUN(pb + 1)) for (int rep_ = 0; rep_ < REPS(3); ++rep_) { PH();
            for (;;) { const int it = dequeue(QW_(4 * l + 2 * rep_), MISC + 16, td); PHQ();
                if (it < 24) { pg8::Gemm g{W_(bf16, WS_U), W_(bf16, WS_WIN) + (size_t)l * NINP * DM, MR, NINP, DM, DM, 256, 0}; const GOrder S = order_one(32, it); EpiIn E{wsl, out, l};
                    pg8::gemm_phase<EpiIn, GOrder, true, true>(lds, g, S, E); }
                else if (it < 24 + 768) attn_prompt_unit(W_(bf16, WS_P), W_(bf16, WS_OPART), W_(float, WS_ML), it - 24, lds, ldsbase, wave, ln);
                else if (it < 24 + 768 + NUNIT / 2) mlstm_m1_item(W_(bf16, WS_P), W_(float, WS_IG), W_(float, WS_LF), W_(float, WS_SCAL), W_(float, WS_DCT), it - (24 + 768), lds, ldsbase, wave, ln);
                else break; }
            __syncthreads();
        }
        SEAM(pb + 1);
        if (EN(4) && RUN(pb + 2)) for (int rep_ = 0; rep_ < REPS(4); ++rep_) { PH();
            for (;;) { const int it = dequeue(QW_(4 * l + 2 * rep_ + 1), MISC + 16, td); PHQ();
                if (it < 129) { for (int r2 = 0; r2 < RPC(0); ++r2) mlstm_m2(W_(float, WS_SCAL), W_(float, WS_DCT), W_(bf16, WS_CST), W_(float, WS_MST), out + O_CP + (size_t)l * 65536, out + O_NP + (size_t)l * 512, out + O_MP + (size_t)l * 8, it * NTHR + td); }
                else if (it < 129 + 256) { const int u = it - 129, b = u >> 3, hd = u & 7;
#ifdef MK_SA_V1
                    sample_attn_unit_v1(W_(bf16, WS_P), IN_(2) + (size_t)l * 32 * 2048 * 1024, IN_(3) + (size_t)l * 32 * 2048 * 1024, W_(bf16, WS_CAT), b, hd, lds, wave, ln); }
#else
                    for (int r2 = 0; r2 < RPC(1); ++r2) sample_attn_unit(W_(bf16, WS_P), IN_(2) + (size_t)l * 32 * 2048 * 1024, IN_(3) + (size_t)l * 32 * 2048 * 1024, W_(bf16, WS_CAT), b, hd, lds, ldsbase, td, wave, ln); }
#endif
                else if (it < 129 + 512) { const int u = it - (129 + 256), b = u >> 3, hd = u & 7; const size_t so = ((size_t)(l * 32 + b) * 8 + hd);
                    for (int r2 = 0; r2 < RPC(2); ++r2) sample_mlstm_unit(W_(bf16, WS_P), W_(float, WS_IG), W_(float, WS_LF), IN_(4) + so * 8192, IN_(5) + so * 64, IN_(6) + so, IN_(14) + l * 1024, W_(bf16, WS_CAT), out + O_CS + so * 8192, out + O_NS + so * 64, out + O_MS + so, b, hd, lds, td, wave, ln); }
                else if (it < 129 + 512 + 256) { const int ch = it - (129 + 512); for (int r2 = 0; r2 < RPC(3); ++r2) for (int e = ch * 4096 + td; e < (ch + 1) * 4096; e += NTHR) attn_combine(W_(bf16, WS_OPART), W_(float, WS_ML), W_(bf16, WS_CAT), e); }
                else break; }
            __syncthreads();
        }
        SEAM(pb + 2);
        if (EN(5) && RUN(pb + 3)) for (int rep_ = 0; rep_ < REPS(5); ++rep_) { PH(); for (int it = bid; it < NUNIT / 4; it += G) mlstm_m3_item(W_(bf16, WS_P), W_(float, WS_SCAL), W_(bf16, WS_CST), W_(float, WS_MST), IN_(14) + l * 1024, W_(bf16, WS_CAT), it, lds, ldsbase, wave, ln); }
        SEAM(pb + 3);
        if (EN(6) && RUN(pb + 4)) for (int rep_ = 0; rep_ < REPS(6); ++rep_) { PH();
            EpiRes E{W_(float, WS_Y), l == 0 ? IN_(0) : W_(float, WS_XR), W_(float, WS_MOD) + (size_t)l * 33 * NMOD + 2 * DM, W_(float, WS_SLAB)};
#pragma nounroll
            for (int pass = 0; pass < 2; ++pass) {
                pg8::Gemm g{W_(bf16, WS_CAT), W_(bf16, WS_WOUT) + (size_t)l * DM * DM, MR, DM, pass ? 512 : DM, DM, 256, 0};
                const GOrder S = pass ? order_split(8, 4, G, bid) : order_static(SEQ, DM, G, bid);
                pg8::gemm_phase<EpiRes, GOrder, true, true>(lds, g, S, E); }
        }
        SEAM(pb + 4);
        if (EN(7) && RUN(pb + 5)) for (int rep_ = 0; rep_ < REPS(7); ++rep_) { PH(); const float* lg = IN_(16) + l * DM; const float* lb = IN_(17) + l * DM; const float* xs = l == 0 ? IN_(1) : W_(float, WS_XR) + (size_t)SEQ * DM;
            { f32x4 cur[8], nxt[8]; const float* mr = W_(float, WS_MOD) + (size_t)l * 33 * NMOD;
              row_load(W_(float, WS_Y) + (size_t)(gw < SEQ ? gw : 0) * DM, cur, ln);
              for (int row = gw; row < SEQ; row += ngw) { const int nr = row + ngw; row_load(W_(float, WS_Y) + (size_t)(nr < SEQ ? nr : row) * DM, nxt, ln);
                  int lq = ln; asm volatile("" : "+v"(lq));
                  ln_fin(cur, lg, lb, W_(float, WS_XA) + (size_t)row * DM, mr + 3 * DM, mr + 4 * DM, W_(bf16, WS_U) + (size_t)row * DM, (const LAS float*)lds, false, nullptr, nullptr, nullptr, row, lq);
#pragma unroll
                  for (int j = 0; j < 8; ++j) cur[j] = nxt[j]; }
              for (int row = SEQ + gw; row < MR; row += ngw) { const float* ms = W_(float, WS_MOD) + ((size_t)l * 33 + mod_row(row)) * NMOD;
                  slab_row_load(W_(float, WS_SLAB) + (size_t)(row - SEQ) * DM, 4, xs + (size_t)(row - SEQ) * DM, ms + 2 * DM, cur, ln);
                  ln_fin(cur, lg, lb, W_(float, WS_XA) + (size_t)row * DM, ms + 3 * DM, ms + 4 * DM, W_(bf16, WS_U) + (size_t)row * DM, (const LAS float*)lds, false, nullptr, nullptr, nullptr, row, ln); } }
        }
        SEAM(pb + 5);
        if (EN(8) && RUN(pb + 6)) for (int rep_ = 0; rep_ < REPS(8); ++rep_) { PH();
            pg8::Gemm g{W_(bf16, WS_U), W_(bf16, WS_WUP) + (size_t)l * NUP * DM, 34 * 256, NUP, DM, DM, 254, -2}; const GOrder S = order_static(34 * 256, NUP, G, bid);
            EpiUpConv E{wsl, out, ka->in, l};
            pg8::gemm_phase<EpiUpConv, GOrder, true, true>(lds, g, S, E);
        }
        SEAM(pb + 6);
        if (EN(10) && RUN(pb + 8)) for (int rep_ = 0; rep_ < REPS(10); ++rep_) { PH();
            EpiRes E{W_(float, WS_Y), W_(float, WS_XA), W_(float, WS_MOD) + (size_t)l * 33 * NMOD + 5 * DM, W_(float, WS_SLAB)};
#pragma nounroll
            for (int pass = 0; pass < 2; ++pass) {
                pg8::Gemm g{W_(bf16, WS_ACT), W_(bf16, WS_WDN) + (size_t)l * DM * DFF, MR, DM, pass ? 512 : DFF, DFF, 256, 0};
                const GOrder S = pass ? order_split(8, 11, G, bid) : order_static(SEQ, DM, G, bid);
                pg8::gemm_phase<EpiRes, GOrder, true, true>(lds, g, S, E); }
        }
        SEAM(pb + 8);
        if (EN(11) && RUN(pb + 9)) for (int rep_ = 0; rep_ < REPS(11); ++rep_) { PH(); const float* lg = IN_(22) + l * DM; const float* lb = IN_(23) + l * DM; float* xo = l == 0 ? W_(float, WS_XR) : out + O_XP;
            if (l == 0) { load_gate_w(IN_(12) + (size_t)DM * DIN, (LAS float*)lds, td); __syncthreads(); }
            { f32x4 cur[8]; const float* mr = W_(float, WS_MOD) + (size_t)33 * NMOD;
              bf16* const Ub = l == 0 ? W_(bf16, WS_U) : (bf16*)nullptr;
              for (int row = gw; row < SEQ; row += ngw) { int lq = ln; asm volatile("" : "+v"(lq)); row_load(W_(float, WS_Y) + (size_t)row * DM, cur, lq);
                  ln_fin(cur, lg, lb, xo + (size_t)row * DM, mr, mr + DM, Ub ? Ub + (size_t)row * DM : Ub, (const LAS float*)lds, l == 0, IN_(13) + 16, W_(float, WS_IG), W_(float, WS_LF), row, lq); }
              for (int row = SEQ + gw; row < MR; row += ngw) { const float* ms = W_(float, WS_MOD) + (size_t)(33 + mod_row(row)) * NMOD; const float* ms0 = W_(float, WS_MOD) + ((size_t)l * 33 + mod_row(row)) * NMOD;
                  slab_row_load(W_(float, WS_SLAB) + (size_t)(row - SEQ) * DM, 11, W_(float, WS_XA) + (size_t)row * DM, ms0 + 5 * DM, cur, ln);
                  ln_fin(cur, lg, lb, xo + (size_t)row * DM, ms, ms + DM, Ub ? Ub + (size_t)row * DM : Ub, (const LAS float*)lds, l == 0, IN_(13) + 16, W_(float, WS_IG), W_(float, WS_LF), row, ln); } }
            __syncthreads();
        }
        SEAM(pb + 9);
    }
#undef RUN
#undef SEAM
}

extern "C" void kernel_launch(void* const* d_in, const int* in_sizes, int n_in, void* d_out, int out_size, void* d_ws, size_t ws_size, hipStream_t stream) {
    static int grid = 0;
    if (grid == 0) {
        if (n_in != 24 || out_size != (int)O_END || ws_size < WS_END) { fprintf(stderr, "kernel_launch: unexpected shapes: n_in %d out %d ws %zu (need %zu)\n", n_in, out_size, ws_size, (size_t)WS_END); grid = -1; return; }
        int dev = 0, cus = 0, per_cu = 0;
        if (hipGetDevice(&dev) != hipSuccess || hipDeviceGetAttribute(&cus, hipDeviceAttributeMultiprocessorCount, dev) != hipSuccess) { fprintf(stderr, "kernel_launch: device query failed\n"); grid = -1; return; }
        if (hipFuncSetAttribute((const void*)mk_fwd, hipFuncAttributeMaxDynamicSharedMemorySize, LDS_BYTES) != hipSuccess) { fprintf(stderr, "kernel_launch: hipFuncSetAttribute failed\n"); grid = -1; return; }
        if (hipOccupancyMaxActiveBlocksPerMultiprocessor(&per_cu, (const void*)mk_fwd, NTHR, LDS_BYTES) != hipSuccess || per_cu < 1) fprintf(stderr, "kernel_launch: note: occupancy query reports %d blocks per CU\n", per_cu);
        (void)hipGetLastError();
        grid = cus;
    }
    if (grid < 0) return;
    (void)in_sizes;
    if (hipMemsetAsync((char*)d_ws + WS_CTL, 0, CTL_ZERO_BYTES, stream) != hipSuccess) { fprintf(stderr, "kernel_launch: memset failed\n"); return; }
    Args a{};
    for (int i = 0; i < 24; ++i) a.in[i] = (const float*)d_in[i];
    a.out = (float*)d_out; a.ws = (unsigned char*)d_ws; a.pad = 0;
#if MK_SPLIT
    for (int p = 0; p < N_PHASES; ++p) { a.ph_lo = p; a.ph_hi = p + 1; a.li = p; hipLaunchKernelGGL(mk_fwd, dim3(grid), dim3(NTHR), LDS_BYTES, stream, a); }
#else
    a.ph_lo = 0; a.ph_hi = N_PHASES; a.li = 0;
    hipLaunchKernelGGL(mk_fwd, dim3(grid), dim3(NTHR), LDS_BYTES, stream, a);
#endif
    const hipError_t le = hipPeekAtLastError();
    if (le != hipSuccess) fprintf(stderr, "kernel_launch: launch failed: %s\n", hipGetErrorName(le));
}
```

```cpp
#include <hip/hip_runtime.h>
#include <cstdio>
#include <cstdint>
namespace pg8 {
#define PG8_LAS __attribute__((address_space(3)))
typedef unsigned short bf16_t;
typedef short bf16x8 __attribute__((ext_vector_type(8)));
typedef float f32x4 __attribute__((ext_vector_type(4)));
typedef unsigned u32x4 __attribute__((ext_vector_type(4)));
constexpr int BM = 256, BK = 64, HALF = 128, HTB = HALF * BK * 2  , STAGE_BYTES = 8 * HTB, NXCD = 8, WGM = 8;

__host__ __device__ __forceinline__ int lds_byte(int r, int c) { const int st = (r >> 4) * 2 + (c >> 5), rr = r & 15, cc = c & 31, ob = rr * 64 + cc * 2; return st * 1024 + (ob ^ (((ob >> 9) & 1) << 5)); }
__host__ __device__ __forceinline__ void stage_rc(int b, int& R, int& C) { const int st = b / 1024, sb = b % 1024, swz = sb ^ (((sb >> 9) & 1) << 5); R = (st >> 1) * 16 + swz / 64; C = (st & 1) * 32 + (swz % 64) / 2; }
__host__ __device__ __forceinline__ int perm32(int rho) { const int n = rho >> 4, i = rho & 15; return 8 * (i >> 2) + 4 * n + (i & 3); }

struct Unit { int pm, pn, ks; };
struct Gemm { const bf16_t* A; const bf16_t* Bt; int M, N, K, ld, rstepA, roffA; };

struct StaticOrder {
    int nM, nN, nwg, G, c;
    __host__ __device__ void init(int M, int N, int G_, int c_) { nM = M / BM; nN = N / BM; nwg = nM * nN; G = G_; c = c_; }
    __host__ __device__ bool next(int i, Unit& u) const {
        const long L = (long)i * G + c; if (L >= nwg) return false;
        int wgid = (int)L; { const int q = nwg / NXCD, r = nwg % NXCD, xcd = wgid % NXCD, off = wgid / NXCD; wgid = (xcd < r ? xcd * (q + 1) : r * (q + 1) + (xcd - r) * q) + off; }
        const int nig = WGM * nN, gid = wgid / nig, fm = gid * WGM, gsz = (nM - fm) < WGM ? (nM - fm) : WGM;
        u.pm = fm + ((wgid % nig) % gsz); u.pn = (wgid % nig) / gsz; u.ks = 0; return true;
    }
    __device__ __forceinline__ void a_ready(const Unit&) const {}
    __device__ __forceinline__ void done(const Unit&) const {}
};

__device__ __forceinline__ unsigned cvt_pk_bf16(float lo, float hi) { unsigned r; asm volatile("v_cvt_pk_bf16_f32 %0, %1, %2" : "=v"(r) : "v"(lo), "v"(hi)); return r; }
template <class Epi, class Sched, bool ALIGN_EPI = false, bool SP2 = false>
__device__ __forceinline__ void gemm_phase(PG8_LAS unsigned char* lds, const Gemm g, const Sched& S, const Epi& E) {
    int tid_ = threadIdx.x; asm volatile("" : "+v"(tid_));
    const int tid = tid_, wid = __builtin_amdgcn_readfirstlane(tid >> 6), lane = tid & 63, wr = wid >> 2, wc = wid & 3, fr = lane & 15, fq = lane >> 4;
    const int K = g.K, nt = K / BK;
    unsigned voffA[2], voffB[2];
#pragma unroll
    for (int i = 0; i < 2; ++i) { int R, C; stage_rc(tid * 16 + i * 8192, R, C); const int Rb = Epi::PERM ? ((R & ~31) + perm32(R & 31)) : R;
        voffA[i] = (unsigned)(R * g.ld + C) * 2u; voffB[i] = (unsigned)(Rb * g.ld + C) * 2u; }
    const size_t kstep = (size_t)(BK * 2);
    const size_t hstep = (size_t)HALF * g.ld * 2;
    const size_t tstep = 2 * hstep;
    const unsigned ldsw = (unsigned)wid * 1024u;
    const int aoff = lds_byte(wr * 64 + fr, fq * 8), boff = lds_byte(wc * 32 + fr, fq * 8);
#define PG8_SA(b, h) (((b) * 2 + (h)) * HTB)
#define PG8_SB(b, h) ((4 + (b) * 2 + (h)) * HTB)
#define PG8_STAGE(bufoff, gbase, voff) do { _Pragma("unroll") for (int _i = 0; _i < 2; ++_i) \
        __builtin_amdgcn_global_load_lds((const unsigned*)((const char*)(gbase) + (voff)[_i]), (PG8_LAS unsigned*)(lds + (bufoff) + ldsw + _i * 8192), 16, 0, 0); } while (0)
#define PG8_LDA(dst, b, h) do { _Pragma("unroll") for (int m = 0; m < 4; ++m) _Pragma("unroll") for (int k = 0; k < 2; ++k) dst[m][k] = *(const PG8_LAS bf16x8*)(lds + PG8_SA(b, h) + aoff + m * 2048 + k * 1024); } while (0)
#define PG8_LDB(dst, b, h) do { _Pragma("unroll") for (int n = 0; n < 2; ++n) _Pragma("unroll") for (int k = 0; k < 2; ++k) dst[n][k] = *(const PG8_LAS bf16x8*)(lds + PG8_SB(b, h) + boff + n * 2048 + k * 1024); } while (0)
#define PG8_MMA(ai, bj, At, Bt) do { __builtin_amdgcn_s_setprio(1); _Pragma("unroll") for (int m = 0; m < 4; ++m) _Pragma("unroll") for (int n = 0; n < 2; ++n) _Pragma("unroll") for (int k = 0; k < 2; ++k) \
        acc[ai][bj][m][n] = __builtin_amdgcn_mfma_f32_16x16x32_bf16(Bt[n][k], At[m][k], acc[ai][bj][m][n], 0, 0, 0); __builtin_amdgcn_s_setprio(0); } while (0)
#define PG8_WAIT_V(n) asm volatile("s_waitcnt vmcnt(" #n ")" ::: "memory")
#define PG8_WAIT_L(n) asm volatile("s_waitcnt lgkmcnt(" #n ")" ::: "memory")
#define PG8_BAR __builtin_amdgcn_s_barrier()
#define PG8_SCHED __builtin_amdgcn_sched_barrier(0)
    Unit cur, nxt; int ui = 0;
    if (!S.next(0, cur)) return;
    f32x4 acc[2][2][4][2];
#pragma unroll
    for (int a = 0; a < 2; ++a)
#pragma unroll
        for (int b = 0; b < 2; ++b)
#pragma unroll
            for (int m = 0; m < 4; ++m)
#pragma unroll
                for (int n = 0; n < 2; ++n) acc[a][b][m][n] = (f32x4){0.f, 0.f, 0.f, 0.f};
    bf16x8 At[4][2], B0[2][2], B1[2][2];
    const char* cA = (const char*)g.A + ((long)cur.pm * g.rstepA + g.roffA) * (long)g.ld * 2 + (size_t)cur.ks * K * 2; const char* cB = (const char*)g.Bt + (size_t)cur.pn * tstep + (size_t)cur.ks * K * 2;
    S.a_ready(cur);
    if constexpr (SP2) {
        PG8_STAGE(PG8_SB(0, 0), cB, voffB); PG8_STAGE(PG8_SB(0, 1), cB + hstep, voffB); PG8_STAGE(PG8_SA(0, 0), cA, voffA); PG8_STAGE(PG8_SA(0, 1), cA + hstep, voffA);
        if (wr == 1) PG8_BAR;
        PG8_WAIT_V(2); PG8_BAR;
        PG8_STAGE(PG8_SB(1, 0), cB + kstep, voffB); PG8_STAGE(PG8_SA(1, 0), cA + kstep, voffA); PG8_STAGE(PG8_SB(1, 1), cB + hstep + kstep, voffB);
        PG8_WAIT_V(6); PG8_BAR;
    } else {
        PG8_STAGE(PG8_SB(0, 0), cB, voffB); PG8_STAGE(PG8_SA(0, 0), cA, voffA); PG8_STAGE(PG8_SB(0, 1), cB + hstep, voffB); PG8_STAGE(PG8_SA(0, 1), cA + hstep, voffA);
        if (wr == 1) PG8_BAR;
        PG8_WAIT_V(4); PG8_BAR;
        PG8_STAGE(PG8_SB(1, 0), cB + kstep, voffB); PG8_STAGE(PG8_SA(1, 0), cA + kstep, voffA); PG8_STAGE(PG8_SB(1, 1), cB + hstep + kstep, voffB);
        PG8_WAIT_V(6); PG8_BAR;
    }
    for (;;) {
        const bool has_next = S.next(ui + 1, nxt);
        const char* nA = has_next ? (const char*)g.A + ((long)nxt.pm * g.rstepA + g.roffA) * (long)g.ld * 2 + (size_t)nxt.ks * K * 2 : cA; const char* nB = has_next ? (const char*)g.Bt + (size_t)nxt.pn * tstep + (size_t)nxt.ks * K * 2 : cB;
        for (int t = 0; t < nt; t += 2) {
            const bool last = (t == nt - 2);
            const char* a1 = cA + (size_t)(t + 1) * kstep;
            const char* a2 = last ? nA : cA + (size_t)(t + 2) * kstep; const char* b2 = last ? nB : cB + (size_t)(t + 2) * kstep;
            const char* a3 = a2 + kstep; const char* b3 = b2 + kstep;
            if (last && has_next) S.a_ready(nxt);
            if constexpr (SP2) {
            PG8_LDB(B0, 0, 0); PG8_LDB(B1, 0, 1); PG8_SCHED; PG8_LDA(At, 0, 0); PG8_STAGE(PG8_SA(1, 1), a1 + hstep, voffA);
            PG8_WAIT_V(8); PG8_WAIT_L(0); PG8_BAR; PG8_MMA(0, 0, At, B0); PG8_MMA(0, 1, At, B1); PG8_BAR; PG8_SCHED;
            PG8_LDA(At, 0, 1); PG8_STAGE(PG8_SB(0, 0), b2, voffB); PG8_STAGE(PG8_SB(0, 1), b2 + hstep, voffB); PG8_STAGE(PG8_SA(0, 0), a2, voffA);
            PG8_WAIT_V(8); PG8_WAIT_L(0); PG8_BAR; PG8_MMA(1, 0, At, B0); PG8_MMA(1, 1, At, B1); PG8_BAR; PG8_SCHED;
            PG8_LDB(B0, 1, 0); PG8_LDB(B1, 1, 1); PG8_SCHED; PG8_LDA(At, 1, 0); PG8_STAGE(PG8_SA(0, 1), a2 + hstep, voffA);
            PG8_WAIT_V(8); PG8_WAIT_L(0); PG8_BAR; PG8_MMA(0, 0, At, B0); PG8_MMA(0, 1, At, B1); PG8_BAR; PG8_SCHED;
            PG8_LDA(At, 1, 1); PG8_STAGE(PG8_SB(1, 0), b3, voffB); PG8_STAGE(PG8_SB(1, 1), b3 + hstep, voffB); PG8_STAGE(PG8_SA(1, 0), a3, voffA);
            PG8_WAIT_V(8); PG8_WAIT_L(0); PG8_BAR; PG8_MMA(1, 0, At, B0); PG8_MMA(1, 1, At, B1); PG8_BAR; PG8_SCHED;
            } else {
            PG8_LDB(B0, 0, 0); PG8_SCHED; PG8_LDA(At, 0, 0); PG8_STAGE(PG8_SA(1, 1), a1 + hstep, voffA);
            PG8_WAIT_L(8); PG8_BAR; PG8_WAIT_L(0); PG8_MMA(0, 0, At, B0); PG8_BAR; PG8_SCHED;
            PG8_LDB(B1, 0, 1); PG8_STAGE(PG8_SB(0, 0), b2, voffB);
            PG8_BAR; PG8_WAIT_L(0); PG8_MMA(0, 1, At, B1); PG8_BAR;
            PG8_LDA(At, 0, 1); PG8_STAGE(PG8_SA(0, 0), a2, voffA);
            PG8_BAR; PG8_WAIT_L(0); PG8_MMA(1, 0, At, B0); PG8_BAR; PG8_SCHED;
            PG8_STAGE(PG8_SB(0, 1), b2 + hstep, voffB);
            PG8_WAIT_V(6); PG8_BAR; PG8_MMA(1, 1, At, B1); PG8_BAR;
            PG8_LDB(B0, 1, 0); PG8_SCHED; PG8_LDA(At, 1, 0); PG8_STAGE(PG8_SA(0, 1), a2 + hstep, voffA);
            PG8_WAIT_L(8); PG8_BAR; PG8_WAIT_L(0); PG8_MMA(0, 0, At, B0); PG8_BAR; PG8_SCHED;
            PG8_LDB(B1, 1, 1); PG8_STAGE(PG8_SB(1, 0), b3, voffB);
            PG8_BAR; PG8_WAIT_L(0); PG8_MMA(0, 1, At, B1); PG8_BAR;
            PG8_LDA(At, 1, 1); PG8_STAGE(PG8_SA(1, 0), a3, voffA);
            PG8_BAR; PG8_WAIT_L(0); PG8_MMA(1, 0, At, B0); PG8_BAR; PG8_SCHED;
            PG8_STAGE(PG8_SB(1, 1), b3 + hstep, voffB);
            PG8_WAIT_V(6); PG8_BAR; PG8_MMA(1, 1, At, B1); PG8_BAR;
            }
        }
        if constexpr (ALIGN_EPI) { if (wr == 0) PG8_BAR; }
        if constexpr (!Epi::AFTER_DRAIN) { E(acc, cur, wr, wc, fr, fq); S.done(cur); }
        if (!has_next) break;
#pragma unroll
        for (int a = 0; a < 2; ++a)
#pragma unroll
            for (int b = 0; b < 2; ++b)
#pragma unroll
                for (int m = 0; m < 4; ++m)
#pragma unroll
                    for (int n = 0; n < 2; ++n) acc[a][b][m][n] = (f32x4){0.f, 0.f, 0.f, 0.f};
        cur = nxt; cA = nA; cB = nB; ++ui;
        if constexpr (ALIGN_EPI) { if (wr == 1) PG8_BAR; }
    }
    PG8_WAIT_V(0);
    if constexpr (!ALIGN_EPI) { if (wr == 0) PG8_BAR; }
    PG8_BAR;
    if constexpr (Epi::AFTER_DRAIN) { E.fused(acc, cur, wr, wc, fr, fq, lds, wid, lane); S.done(cur); }
#undef PG8_SA
#undef PG8_SB
#undef PG8_STAGE
#undef PG8_LDA
#undef PG8_LDB
#undef PG8_MMA
#undef PG8_WAIT_V
#undef PG8_WAIT_L
#undef PG8_BAR
#undef PG8_SCHED
}
}

#define DI __device__ __forceinline__
#define GAS __attribute__((address_space(1)))
#define LAS __attribute__((address_space(3)))
typedef unsigned short bf16;
typedef float f32x4 __attribute__((ext_vector_type(4)));
typedef float f32x16 __attribute__((ext_vector_type(16)));
typedef short bf16x8 __attribute__((ext_vector_type(8)));
typedef short s16x4 __attribute__((ext_vector_type(4)));
typedef unsigned u32x4 __attribute__((ext_vector_type(4)));
typedef unsigned u32x2 __attribute__((ext_vector_type(2)));
typedef GAS unsigned gu32;
#define RLX_AGENT __ATOMIC_RELAXED, __HIP_MEMORY_SCOPE_AGENT
#define LDS_WAIT() asm volatile("s_waitcnt lgkmcnt(0)" ::: "memory")
#define VM_WAIT() asm volatile("s_waitcnt vmcnt(0)" ::: "memory")

constexpr int DM = 2048, SEQ = 8192, NSMP = 256, MR = SEQ + NSMP, DFF = 5632, NUP = 2 * DFF, NINP = 6144, DIN = 6160, NMOD = 6 * DM, PW = 6144;
constexpr int NCH = 128, LCH = 64, NHM = 8, NUNIT = NCH * NHM;
constexpr float ALPHA_RES = 1.4142135623730951f;
constexpr float QSCALE = 0.12751743082459868f;
constexpr float LOG2E = 1.4426950408889634f;
constexpr int NWAVES = 8, NTHR = 512;

constexpr size_t O_XP = 0, O_XS = 16777216, O_KP = 17301504, O_VP = 21495808, O_CP = 25690112, O_NP = 25821184, O_MP = 25822208, O_BP = 25822224,
                 O_KS = 25844752, O_VS = 26369040, O_CS = 26893328, O_NS = 31087632, O_MS = 31120400, O_BS = 31120912, O_END = 31841808;

constexpr size_t al256(size_t x) { return (x + 255) & ~(size_t)255; }
constexpr size_t WS_CTL = 0, CTL_ZERO_BYTES = 1u << 20;
constexpr size_t WS_MOD  = CTL_ZERO_BYTES;
constexpr size_t WS_ROPE = WS_MOD  + al256((size_t)2 * 33 * NMOD * 4);
constexpr size_t WS_WIN  = WS_ROPE + al256((size_t)2 * 8200 * 64 * 4);
constexpr size_t WS_WOUT = WS_WIN  + (size_t)2 * NINP * DM * 2;
constexpr size_t WS_WUP  = WS_WOUT + (size_t)2 * DM * DM * 2;
constexpr size_t WS_WDN  = WS_WUP  + (size_t)2 * NUP * DM * 2;
constexpr size_t WS_UPAD = WS_WDN  + (size_t)2 * DM * DFF * 2;
constexpr size_t WS_U    = WS_UPAD + (size_t)2 * DM * 2;
constexpr size_t WS_P    = WS_UPAD + (size_t)(2 + MR + 254) * DM * 2;
constexpr size_t WS_IG   = WS_P    + (size_t)MR * PW * 2;
constexpr size_t WS_LF   = WS_IG   + al256((size_t)MR * 8 * 4);
constexpr size_t WS_SCAL = WS_LF   + al256((size_t)MR * 8 * 4);
constexpr size_t WS_DCT  = WS_SCAL + (size_t)NUNIT * 192 * 4;
constexpr size_t WS_CST  = WS_DCT  + al256((size_t)NUNIT * 129 * 64 * 4);
constexpr size_t WS_MST  = WS_CST  + (size_t)NUNIT * 160 * 64 * 2;
constexpr size_t WS_OPART= WS_MST  + al256((size_t)NUNIT * 4);
constexpr size_t WS_ML   = WS_OPART+ (size_t)3 * SEQ * 1024 * 2;
constexpr size_t WS_CAT  = WS_ML   + (size_t)3 * SEQ * 8 * 2 * 4;
constexpr size_t WS_Y    = WS_CAT  + (size_t)MR * DM * 2;
constexpr size_t WS_XA   = WS_Y    + (size_t)MR * DM * 4;
constexpr size_t WS_XR   = WS_XA   + (size_t)MR * DM * 4;
constexpr size_t WS_GV   = WS_XR   + (size_t)MR * DM * 4;
constexpr size_t WS_ACT  = WS_GV   + (size_t)MR * NUP * 2;
constexpr size_t WS_SLAB = WS_ACT  + (size_t)MR * DFF * 2;
constexpr size_t WS_END  = WS_SLAB + (size_t)11 * NSMP * DM * 4;
constexpr int CW_BAR = 4096;
constexpr int CW_Q = 131072;

constexpr int RING_BYTES = 131072, LDSCTL_OFF = RING_BYTES, MISC_OFF = LDSCTL_OFF + 320, XB_OFF = LDSCTL_OFF + 1024, LDS_BYTES = 147456;

DI unsigned f2bf(float f) { unsigned u = __builtin_bit_cast(unsigned, f); return (u + 0x7fffu + ((u >> 16) & 1u)) >> 16; }
DI unsigned pk2(float lo, float hi) { return f2bf(lo) | (f2bf(hi) << 16); }
DI float bf2f(unsigned b) { return __builtin_bit_cast(float, b << 16); }
DI float bflo(unsigned w) { return __builtin_bit_cast(float, w << 16); }
DI float bfhi(unsigned w) { return __builtin_bit_cast(float, w & 0xffff0000u); }
DI f32x4 ld4(const float* p) { return *(const GAS f32x4*)p; }
DI void st4(float* p, f32x4 v) { *(GAS f32x4*)p = v; }
DI u32x4 ld16(const void* p) { return *(const GAS u32x4*)p; }
DI void st16(void* p, u32x4 v) { *(GAS u32x4*)p = v; }
DI u32x2 ld8(const void* p) { return *(const GAS u32x2*)p; }
DI void st8(void* p, u32x2 v) { *(GAS u32x2*)p = v; }
DI float ldf(const float* p) { return *(const GAS float*)p; }
DI void stf(float* p, float v) { *(GAS float*)p = v; }
DI bf16x8 ldfrag(const bf16* p) { return __builtin_bit_cast(bf16x8, *(const GAS u32x4*)p); }
DI float fexp2(float x) { return __builtin_amdgcn_exp2f(x); }
DI float fexp(float x) { return __builtin_amdgcn_exp2f(x * LOG2E); }
DI float frcp(float x) { return __builtin_amdgcn_rcpf(x); }
DI float sigmoidf_(float x) { return frcp(1.f + fexp(-x)); }
DI float siluf_(float x) { return x * sigmoidf_(x); }
DI float logsigmoidf_(float v) { const float e = fexp(-fabsf(v)); return fminf(v, 0.f) - __logf(1.f + e); }
DI int crow(int reg, int h) { return (reg & 3) + 8 * (reg >> 2) + 4 * h; }
DI f32x16 zero16() { f32x16 z; for (int i = 0; i < 16; ++i) z[i] = 0.f; return z; }
#define MFMA32(a, b, c) __builtin_amdgcn_mfma_f32_32x32x16_bf16((a), (b), (c), 0, 0, 0)
DI float wave_sum(float v) {
#pragma unroll
    for (int o = 1; o < 64; o <<= 1) v += __shfl_xor(v, o);
    return v;
}
DI float wave_max(float v) {
#pragma unroll
    for (int o = 1; o < 64; o <<= 1) v = fmaxf(v, __shfl_xor(v, o));
    return v;
}
DI bf16x8 pack_step(const f32x16& x, int s) {
    u32x4 p; p[0] = pk2(x[8 * s], x[8 * s + 1]); p[1] = pk2(x[8 * s + 2], x[8 * s + 3]); p[2] = pk2(x[8 * s + 4], x[8 * s + 5]); p[3] = pk2(x[8 * s + 6], x[8 * s + 7]);
    return __builtin_bit_cast(bf16x8, p);
}
DI bf16x8 tr_pair(unsigned tile, int pitch, int s0, int s1, int cbase, int lane) {
    const int i = lane & 15, q = i >> 2, p = i & 3, cb = (lane >> 4) & 1;
    const unsigned a0 = tile + (unsigned)((s0 + q) * pitch + (cbase + 16 * cb + 4 * p) * 2);
    const unsigned a1 = tile + (unsigned)((s1 + q) * pitch + (cbase + 16 * cb + 4 * p) * 2);
    s16x4 lo, hi;
    asm volatile("ds_read_b64_tr_b16 %0, %2\n\tds_read_b64_tr_b16 %1, %3\n\ts_waitcnt lgkmcnt(0)" : "=&v"(lo), "=&v"(hi) : "v"(a0), "v"(a1) : "memory");
    return __builtin_shufflevector(lo, hi, 0, 1, 2, 3, 4, 5, 6, 7);
}

DI int mod_row(int row) { return row < SEQ ? 0 : 1 + ((row - SEQ) >> 3); }

DI int win_src_col(int nb) {
    const int n0 = nb * 32;
    if (n0 < 3072) return n0;
    if (n0 < 5120) {
        const int which = (n0 - 3072) / 1024, rel = (n0 - 3072) % 1024, tile = rel / 256, j0 = rel % 256;
        const int bj = j0 / 128, h2 = (j0 % 128) / 64, ib = (j0 % 64) / 32;
        return 3088 + which * 1024 + (2 * tile + h2) * 128 + bj * 64 + 32 * ib;
    }
    return 5136 + (n0 - 5120);
}
DI void transpose_item(const float* W, int N, int K, bf16* WT, int drow0, int scol0, int k0, LAS float* scr, int lane) {
    const int kq = lane >> 3, n4 = lane & 7;
    f32x4 v[8];
#pragma unroll
    for (int i = 0; i < 8; ++i) v[i] = ld4(W + (size_t)(k0 + 8 * i + kq) * N + scol0 + 4 * n4);
#pragma unroll
    for (int i = 0; i < 8; ++i) { LAS float* d = scr + (8 * i + kq) * 33 + 4 * n4; d[0] = v[i].x; d[1] = v[i].y; d[2] = v[i].z; d[3] = v[i].w; }
    LDS_WAIT();
    const int c = lane & 7;
#pragma unroll
    for (int j = 0; j < 4; ++j) { const int n = (lane >> 3) + 8 * j; const LAS float* s = scr + (8 * c) * 33 + n;
        u32x4 o; o.x = pk2(s[0 * 33], s[1 * 33]); o.y = pk2(s[2 * 33], s[3 * 33]); o.z = pk2(s[4 * 33], s[5 * 33]); o.w = pk2(s[6 * 33], s[7 * 33]);
        st16(WT + (size_t)(drow0 + n) * K + k0 + 8 * c, o); }
    LDS_WAIT();
}
constexpr int IT_IN = 32 * 192, IT_OUT = 32 * 64, IT_UP = 32 * 352, IT_DN = 88 * 64, IT_LAYER = IT_IN + IT_OUT + IT_UP + IT_DN;

DI void p0_weights(const float* w_in, const float* w_out, const float* w_up, const float* w_down, unsigned char* ws, LAS unsigned char* lds, int gw, int ngw, int wave, int lane) {
    LAS float* scr = (LAS float*)(lds + wave * 16384);
    for (int it = gw; it < 2 * IT_LAYER; it += ngw) {
        const int l = it / IT_LAYER; int r = it % IT_LAYER;
        if (r < IT_IN) { const int kb = r / 192, nb = r % 192;
            transpose_item(w_in + (size_t)l * DM * DIN, DIN, DM, (bf16*)(ws + WS_WIN) + (size_t)l * NINP * DM, nb * 32, win_src_col(nb), kb * 64, scr, lane); continue; }
        r -= IT_IN;
        if (r < IT_OUT) { const int kb = r / 64, nb = r % 64;
            transpose_item(w_out + (size_t)l * DM * DM, DM, DM, (bf16*)(ws + WS_WOUT) + (size_t)l * DM * DM, nb * 32, nb * 32, kb * 64, scr, lane); continue; }
        r -= IT_OUT;
        if (r < IT_UP) { const int kb = r / 352, nb = r % 352, tile = nb >> 3, j0 = 32 * (nb & 7);
            transpose_item(w_up + (size_t)l * DM * NUP, NUP, DM, (bf16*)(ws + WS_WUP) + (size_t)l * NUP * DM, nb * 32, (j0 >> 7) * DFF + 128 * tile + (j0 & 127), kb * 64, scr, lane); continue; }
        r -= IT_UP;
        { const int kb = r / 64, nb = r % 64;
            transpose_item(w_down + (size_t)l * DFF * DM, DM, DFF, (bf16*)(ws + WS_WDN) + (size_t)l * DM * DFF, nb * 32, nb * 32, kb * 64, scr, lane); }
    }
}
DI void p0_rope(float* cosT, float* sinT, int gt, int ngt) {
    for (int e = gt; e < 8200 * 64; e += ngt) {
        const int pos = e >> 6, i = e & 63;
        double inv = 1.0;
        if (i & 1) inv *= 0.8659643233600653;
        if (i & 2) inv *= 0.7498942093324559;
        if (i & 4) inv *= 0.5623413251903491;
        if (i & 8) inv *= 0.31622776601683794;
        if (i & 16) inv *= 0.1;
        if (i & 32) inv *= 0.01;
        double rev = (double)pos * inv * 0.15915494309189535;
        rev = rev - __builtin_rint(rev);
        const float fr = (float)rev;
        stf(cosT + e, __builtin_amdgcn_cosf(fr)); stf(sinT + e, __builtin_amdgcn_sinf(fr));
    }
}
DI void p0_mod(const float* c_prompt, const float* c_sample, const float* w_ada, const float* b_ada, float* MOD, LAS unsigned char* lds, int bid, int G, int tid, int wave, int lane) {
    LAS float* cpl = (LAS float*)(lds + 65536);
    LAS float* red = (LAS float*)(lds + 65536 + 8192);
    const int h = lane >> 5, r31 = lane & 31, kbase = 256 * wave;
    for (int i = tid; i < DM; i += NTHR) cpl[i] = siluf_(ldf(c_prompt + i));
    __syncthreads();
    for (int item = bid; item < 768; item += G) {
        const int l = item / 384, n0 = (item % 384) * 32;
        const float* W = w_ada + (size_t)l * DM * NMOD + n0 + r31;
        f32x16 acc = zero16(); float pacc = 0.f;
#pragma unroll 4
        for (int ks = 0; ks < 16; ++ks) { const int k0 = kbase + 16 * ks + 8 * h; float w[8];
#pragma unroll
            for (int j = 0; j < 8; ++j) w[j] = ldf(W + (size_t)(k0 + j) * NMOD);
            const float* cp = c_sample + (size_t)r31 * DM + k0; const f32x4 ca = ld4(cp), cb = ld4(cp + 4);
            u32x4 pa; pa.x = pk2(siluf_(ca.x), siluf_(ca.y)); pa.y = pk2(siluf_(ca.z), siluf_(ca.w)); pa.z = pk2(siluf_(cb.x), siluf_(cb.y)); pa.w = pk2(siluf_(cb.z), siluf_(cb.w));
            u32x4 p; p.x = pk2(w[0], w[1]); p.y = pk2(w[2], w[3]); p.z = pk2(w[4], w[5]); p.w = pk2(w[6], w[7]);
            acc = MFMA32(__builtin_bit_cast(bf16x8, pa), __builtin_bit_cast(bf16x8, p), acc);
            const LAS f32x4* cq = (const LAS f32x4*)(cpl + k0); const f32x4 c0 = cq[0], c1 = cq[1];
            pacc += c0.x * w[0] + c0.y * w[1] + c0.z * w[2] + c0.w * w[3] + c1.x * w[4] + c1.y * w[5] + c1.z * w[6] + c1.w * w[7]; }
        pacc += __shfl_xor(pacc, 32);
#pragma unroll
        for (int reg = 0; reg < 16; ++reg) red[(wave * 33 + 1 + crow(reg, h)) * 32 + r31] = acc[reg];
        if (h == 0) red[(wave * 33) * 32 + r31] = pacc;
        __syncthreads();
        for (int i = tid; i < 33 * 32; i += NTHR) { const int r = i >> 5, c = i & 31; float s = 0.f;
#pragma unroll
            for (int w = 0; w < 8; ++w) s += red[(w * 33 + r) * 32 + c];
            stf(MOD + ((size_t)l * 33 + r) * NMOD + n0 + c, s + ldf(b_ada + (size_t)l * NMOD + n0 + c)); }
        __syncthreads();
    }
}
DI void load_gate_w(const float* w_in_l, LAS float* Wg, int tid) {
    for (int i = tid; i < DM * 16; i += NTHR) { const int k = i >> 4, c = i & 15; Wg[c * DM + k] = ldf(w_in_l + (size_t)k * DIN + 3072 + c); }
}
DI void gate_row(const f32x4 (&v)[8], const LAS float* Wg, const float* bgate, float* IG, float* LF, int row, int lane) {
    float p[16];
#pragma unroll
    for (int c = 0; c < 16; ++c) { float a = 0.f;
#pragma unroll
        for (int j = 0; j < 8; ++j) { const f32x4 w = *(const LAS f32x4*)(Wg + c * DM + 256 * j + 4 * lane); a += v[j].x * w.x + v[j].y * w.y + v[j].z * w.z + v[j].w * w.w; }
        p[c] = a; asm volatile("" ::: "memory"); }
    float q[8], r[4], t2[2], t1;
    { const bool hi = (lane & 32) != 0;
#pragma unroll
      for (int i = 0; i < 8; ++i) { const float keep = hi ? p[8 + i] : p[i], send = hi ? p[i] : p[8 + i]; q[i] = keep + __shfl_xor(send, 32); } }
    { const bool hi = (lane & 16) != 0;
#pragma unroll
      for (int i = 0; i < 4; ++i) { const float keep = hi ? q[4 + i] : q[i], send = hi ? q[i] : q[4 + i]; r[i] = keep + __shfl_xor(send, 16); } }
    { const bool hi = (lane & 8) != 0;
#pragma unroll
      for (int i = 0; i < 2; ++i) { const float keep = hi ? r[2 + i] : r[i], send = hi ? r[i] : r[2 + i]; t2[i] = keep + __shfl_xor(send, 8); } }
    { const bool hi = (lane & 4) != 0; const float keep = hi ? t2[1] : t2[0], send = hi ? t2[0] : t2[1]; t1 = keep + __shfl_xor(send, 4); }
    t1 += __shfl_xor(t1, 2); t1 += __shfl_xor(t1, 1);
    if ((lane & 3) == 0) { const int c = (lane >> 2) & 15;
        const float x = t1 + ldf(bgate + c);
        if (c < 8) stf(IG + (size_t)row * 8 + c, x); else stf(LF + (size_t)row * 8 + (c - 8), logsigmoidf_(x)); }
}
DI void row_load(const float* p, f32x4 (&v)[8], int lane) {
#pragma unroll
    for (int j = 0; j < 8; ++j) v[j] = ld4(p + 4 * lane + 256 * j);
}
DI void modulate_fin(f32x4 (&v)[8], const float* sh, const float* sc, bf16* urow, const LAS float* Wg, const float* bgate, float* IG, float* LF, int row, int lane) {
#pragma unroll
    for (int j = 0; j < 8; ++j) { const int col = 4 * lane + 256 * j; const f32x4 a = ld4(sc + col), b = ld4(sh + col);
        v[j] = v[j] * (a + 1.f) + b; u32x2 o; o.x = pk2(v[j].x, v[j].y); o.y = pk2(v[j].z, v[j].w); st8(urow + col, o); }
    gate_row(v, Wg, bgate, IG, LF, row, lane);
}
DI void ln_fin(f32x4 (&v)[8], const float* g, const float* b, float* xo, const float* sh, const float* sc, bf16* urow,
               const LAS float* Wg, bool gates, const float* bgate, float* IG, float* LF, int row, int lane) {
    float s = 0.f;
#pragma unroll
    for (int j = 0; j < 8; ++j) s += (v[j].x + v[j].y) + (v[j].z + v[j].w);
    const float mean = wave_sum(s) * (1.f / DM); float s2 = 0.f;
#pragma unroll
    for (int j = 0; j < 8; ++j) { v[j] = v[j] - mean; s2 += (v[j].x * v[j].x + v[j].y * v[j].y) + (v[j].z * v[j].z + v[j].w * v[j].w); }
    const float rstd = 1.f / sqrtf(wave_sum(s2) * (1.f / DM) + 1e-5f);
#pragma unroll
    for (int j = 0; j < 8; ++j) { const int col = 4 * lane + 256 * j; const f32x4 gg = ld4(g + col), bb = ld4(b + col); const f32x4 o = v[j] * rstd * gg + bb; st4(xo + col, o);
        if (urow) { const f32x4 a = ld4(sc + col), c = ld4(sh + col); v[j] = o * (a + 1.f) + c; u32x2 w; w.x = pk2(v[j].x, v[j].y); w.y = pk2(v[j].z, v[j].w); st8(urow + col, w); } }
    if (gates) gate_row(v, Wg, bgate, IG, LF, row, lane);
}
DI void slab_row_load(const float* slab, int nslab, const float* res, const float* gate, f32x4 (&v)[8], int lane) {
#pragma unroll
    for (int j = 0; j < 8; ++j) { const int col = 4 * lane + 256 * j; f32x4 a = ld4(slab + col);
        for (int q = 1; q < nslab; ++q) a += ld4(slab + (size_t)q * NSMP * DM + col);
        v[j] = ld4(res + col) * ALPHA_RES + (ld4(gate + col) + 1.f) * a; }
}
#define XB_TMO      128
#define XB_XCNT(j)  (256  + 64 * (j))
#define XB_XSUB(j)  (1280 + 64 * (j))
#define XB_XGEN(j)  (2304 + 64 * (j))
#define XB_TOP      3328
#define XB_TOPGEN   3392
#define XCD_BAR_WORDS 3456
#define XB_SPIN_CAP (1u << 18)

__device__ __forceinline__ unsigned xb_ld(unsigned* p)              { return __hip_atomic_load(p, __ATOMIC_RELAXED, __HIP_MEMORY_SCOPE_AGENT); }
__device__ __forceinline__ unsigned xb_add(unsigned* p, unsigned v) { return __hip_atomic_fetch_add(p, v, __ATOMIC_RELAXED, __HIP_MEMORY_SCOPE_AGENT); }
__device__ __forceinline__ unsigned xb_xcc_id() { return (unsigned)__builtin_amdgcn_s_getreg((3 << 11) | 20) & 0xFu; }
#define XB_SPIN(cond, bar) do { unsigned _sp = 0; while (cond) { __builtin_amdgcn_s_sleep(1); \
    if ((++_sp & 255u) == 0u) { if (xb_ld(&(bar)[XB_TMO])) break; if (_sp > XB_SPIN_CAP) { atomicAdd(&(bar)[XB_TMO], 1u); break; } } } } while (0)

struct XcdBarrier {
    unsigned* bar; unsigned x;
    volatile LAS unsigned* st;
};

__device__ __forceinline__ XcdBarrier xcd_barrier_post(unsigned* bar, volatile LAS unsigned* st) {
    XcdBarrier b; b.bar = bar; b.x = xb_xcc_id(); b.st = st;
    if (threadIdx.x == 0) (void)xb_add(&bar[XB_XCNT(b.x)], 1u);
    return b;
}
__device__ __forceinline__ void xcd_barrier_complete(unsigned* bar, unsigned x, unsigned& nloc, unsigned& nx) {
    const unsigned G = gridDim.x * gridDim.y * gridDim.z;
    unsigned sum, cnt, mine, sp = 0u;
    for (;;) {
        sum = 0u; cnt = 0u; mine = 0u;
#pragma unroll
        for (unsigned j = 0; j < 16; ++j) { const unsigned c = xb_ld(&bar[XB_XCNT(j)]); sum += c; cnt += (c > 0u) ? 1u : 0u; mine = (j == x) ? c : mine; }
        if (sum == G) break;
        __builtin_amdgcn_s_sleep(1);
        if ((++sp & 255u) == 0u) { if (xb_ld(&bar[XB_TMO])) break; if (sp > XB_SPIN_CAP) { atomicAdd(&bar[XB_TMO], 1u); break; } }
    }
    nloc = mine > 0u ? mine : 1u; nx = cnt > 0u ? cnt : 1u;
}

__device__ __forceinline__ void xcd_barrier(const XcdBarrier& b) {
    asm volatile("s_waitcnt vmcnt(0)" ::: "memory");
    __syncthreads();
    if (threadIdx.x == 0) {
        unsigned* bar = b.bar;
        __builtin_amdgcn_s_waitcnt(0);
        unsigned nloc = b.st[0], nx = b.st[1];
        if (nloc == 0u) { xcd_barrier_complete(bar, b.x, nloc, nx); b.st[0] = nloc; b.st[1] = nx; }
        const unsigned old = xb_add(&bar[XB_XSUB(b.x)], 1u);
        const unsigned gen = old / nloc;
        if (old + 1u == (gen + 1u) * nloc) {
            __builtin_amdgcn_fence(__ATOMIC_RELEASE, "agent");
            asm volatile("s_waitcnt vmcnt(0)" ::: "memory");
            const unsigned og = xb_add(&bar[XB_TOP], 1u);
            const unsigned tg = og / nx;
            if (og + 1u == (tg + 1u) * nx) xb_add(&bar[XB_TOPGEN], 1u);
            else XB_SPIN(xb_ld(&bar[XB_TOPGEN]) == tg, bar);
            __builtin_amdgcn_fence(__ATOMIC_ACQUIRE, "agent");
            xb_add(&bar[XB_XGEN(b.x)], 1u);
            asm volatile("s_waitcnt vmcnt(0)" ::: "memory");
        } else {
            XB_SPIN(xb_ld(&bar[XB_XGEN(b.x)]) == gen, bar);
            __builtin_amdgcn_fence(__ATOMIC_ACQUIRE, "agent");
            asm volatile("s_waitcnt vmcnt(0)" ::: "memory");
        }
    }
    __syncthreads();
}

DI u32x4 pack8(f32x4 a, f32x4 b) { u32x4 w; w.x = pg8::cvt_pk_bf16(a[0], a[1]); w.y = pg8::cvt_pk_bf16(a[2], a[3]); w.z = pg8::cvt_pk_bf16(b[0], b[1]); w.w = pg8::cvt_pk_bf16(b[2], b[3]); return w; }

struct EpiIn {
    static constexpr bool PERM = true, AFTER_DRAIN = false;
    unsigned char* wsb; float* outb; int l;
    DI void operator()(const f32x4 (&acc)[2][2][4][2], const pg8::Unit& u, int wr, int wc, int fr0, int fq0) const {
        int fr = fr0, fq = fq0; asm volatile("" : "+v"(fr), "+v"(fq));
        bf16* P = (bf16*)(wsb + WS_P); const float* cosT = (const float*)(wsb + WS_ROPE); const float* sinT = cosT + 8200 * 64;
        float* kp = outb + O_KP + (size_t)l * 2048 * 1024; float* vp = outb + O_VP + (size_t)l * 2048 * 1024; float* ks = outb + O_KS + (size_t)l * NSMP * 1024; float* vs = outb + O_VS + (size_t)l * NSMP * 1024;
        const int pn = u.pn, rowb = u.pm * 256 + wr * 64 + fr;
        if (pn < 12 || pn >= 20) {
            const float sc = (pn == 2 || pn == 3) ? 0.125f : 1.f;
            const int colP = (pn < 12 ? pn * 256 : 5120 + (pn - 20) * 256) + wc * 32 + 8 * fq;
#pragma unroll
            for (int ai = 0; ai < 2; ++ai)
#pragma unroll
                for (int m = 0; m < 4; ++m) { const int row = rowb + ai * 128 + m * 16; bf16* rp = P + (size_t)row * PW + colP;
                    float* o = nullptr;
                    if (pn >= 20) { if (row >= SEQ) o = vs + (size_t)(row - SEQ) * 1024; else if (row >= SEQ - 2048) o = vp + (size_t)(row - (SEQ - 2048)) * 1024; }
#pragma unroll
                    for (int bj = 0; bj < 2; ++bj) { st16(rp + bj * 128, pack8(acc[ai][bj][m][0] * sc, acc[ai][bj][m][1] * sc));
                        if (o) { float* oc = o + (pn - 20) * 256 + bj * 128 + wc * 32 + 8 * fq; st4(oc, acc[ai][bj][m][0]); st4(oc + 4, acc[ai][bj][m][1]); } } }
        } else {
            const bool isq = pn < 16; const int tile = (pn - 12) & 3, head = 2 * tile + (wc >> 1), i0 = 32 * (wc & 1) + 8 * fq;
            const float qs = isq ? QSCALE : 1.f;
            const int colP = (isq ? 3072 : 4096) + head * 128 + i0;
            f32x4 tc[4], tn[4];
            { const int pos = rowb < SEQ ? rowb : SEQ + ((rowb - SEQ) & 7); tc[0] = ld4(cosT + pos * 64 + i0); tc[1] = ld4(cosT + pos * 64 + i0 + 4); tc[2] = ld4(sinT + pos * 64 + i0); tc[3] = ld4(sinT + pos * 64 + i0 + 4); }
#pragma unroll
            for (int g8 = 0; g8 < 8; ++g8) { const int ai = g8 >> 2, m = g8 & 3, row = rowb + ai * 128 + m * 16;
                { const int g9 = g8 < 7 ? g8 + 1 : 7, rown = rowb + (g9 >> 2) * 128 + (g9 & 3) * 16, pos = rown < SEQ ? rown : SEQ + ((rown - SEQ) & 7);
                  tn[0] = ld4(cosT + pos * 64 + i0); tn[1] = ld4(cosT + pos * 64 + i0 + 4); tn[2] = ld4(sinT + pos * 64 + i0); tn[3] = ld4(sinT + pos * 64 + i0 + 4); }
                const f32x4 c0 = tc[0], c1 = tc[1], s0 = tc[2], s1 = tc[3];
                const f32x4 x1a = acc[ai][0][m][0], x1b = acc[ai][0][m][1], x2a = acc[ai][1][m][0], x2b = acc[ai][1][m][1];
                const f32x4 o1a = (x1a * c0 - x2a * s0) * qs, o1b = (x1b * c1 - x2b * s1) * qs, o2a = (x2a * c0 + x1a * s0) * qs, o2b = (x2b * c1 + x1b * s1) * qs;
                bf16* rp = P + (size_t)row * PW + colP; st16(rp, pack8(o1a, o1b)); st16(rp + 64, pack8(o2a, o2b));
                if (!isq) { float* o = nullptr; if (row >= SEQ) o = ks + (size_t)(row - SEQ) * 1024; else if (row >= SEQ - 2048) o = kp + (size_t)(row - (SEQ - 2048)) * 1024;
                    if (o) { o += head * 128 + i0; st4(o, o1a); st4(o + 4, o1b); st4(o + 64, o2a); st4(o + 68, o2b); } }
#pragma unroll
                for (int i = 0; i < 4; ++i) tc[i] = tn[i];
                asm volatile("" ::: "memory"); }
        }
    }
};
struct EpiRes {
    static constexpr bool PERM = false, AFTER_DRAIN = false;
    float* Y; const float* resP; const float* gate; float* slab;
    DI void operator()(const f32x4 (&acc)[2][2][4][2], const pg8::Unit& u, int wr, int wc, int fr0, int fq0) const {
        int fr = fr0, fq = fq0; asm volatile("" : "+v"(fr), "+v"(fq));
        const int rowb = u.pm * 256 + wr * 64 + fr, col0 = u.pn * 256 + wc * 32 + 4 * fq;
        if (u.pm >= 32) {
#pragma unroll
            for (int ai = 0; ai < 2; ++ai)
#pragma unroll
                for (int m = 0; m < 4; ++m) { float* sp = slab + ((size_t)u.ks * NSMP + (wr * 64 + fr + ai * 128 + m * 16)) * DM + col0;
#pragma unroll
                    for (int bj = 0; bj < 2; ++bj)
#pragma unroll
                        for (int n = 0; n < 2; ++n) st4(sp + bj * 128 + n * 16, acc[ai][bj][m][n]); }
            return;
        }
        f32x4 gv[2][2];
#pragma unroll
        for (int bj = 0; bj < 2; ++bj)
#pragma unroll
            for (int n = 0; n < 2; ++n) gv[bj][n] = ld4(gate + col0 + bj * 128 + n * 16) + 1.f;
        f32x4 rc[2][2], rn[2][2];
#pragma unroll
        for (int bj = 0; bj < 2; ++bj)
#pragma unroll
            for (int n = 0; n < 2; ++n) rc[bj][n] = ld4(resP + (size_t)rowb * DM + col0 + bj * 128 + n * 16);
#pragma unroll
        for (int g8 = 0; g8 < 8; ++g8) { const int ai = g8 >> 2, m = g8 & 3, row = rowb + ai * 128 + m * 16;
            const int g9 = g8 < 7 ? g8 + 1 : 7, rown = rowb + (g9 >> 2) * 128 + (g9 & 3) * 16;
#pragma unroll
            for (int bj = 0; bj < 2; ++bj)
#pragma unroll
                for (int n = 0; n < 2; ++n) rn[bj][n] = ld4(resP + (size_t)rown * DM + col0 + bj * 128 + n * 16);
            float* yp = Y + (size_t)row * DM + col0;
#pragma unroll
            for (int bj = 0; bj < 2; ++bj)
#pragma unroll
                for (int n = 0; n < 2; ++n) { st4(yp + bj * 128 + n * 16, rc[bj][n] * ALPHA_RES + gv[bj][n] * acc[ai][bj][m][n]); rc[bj][n] = rn[bj][n]; }
            asm volatile("" ::: "memory"); }
    }
};
DI f32x4 shfl4(f32x4 v, int src) { f32x4 r; r.x = __shfl(v.x, src); r.y = __shfl(v.y, src); r.z = __shfl(v.z, src); r.w = __shfl(v.w, src); return r; }
template <int CTRL> DI float dpp1(float x) { return __builtin_bit_cast(float, __builtin_amdgcn_update_dpp(0, __builtin_bit_cast(int, x), CTRL, 0xf, 0xf, false)); }
template <int CTRL> DI f32x4 dpp4(f32x4 v) { f32x4 r; r.x = dpp1<CTRL>(v.x); r.y = dpp1<CTRL>(v.y); r.z = dpp1<CTRL>(v.z); r.w = dpp1<CTRL>(v.w); return r; }
DI f32x4 sel4(bool c, f32x4 a, f32x4 b) { return c ? a : b; }
DI f32x4 silu4(f32x4 x) { return (f32x4){siluf_(x.x), siluf_(x.y), siluf_(x.z), siluf_(x.w)}; }
struct EpiUpConv {
    static constexpr bool PERM = true, AFTER_DRAIN = false;
    unsigned char* wsb; float* outb; const float* const __attribute__((address_space(4)))* inp; int l;
    DI void operator()(const f32x4 (&acc)[2][2][4][2], const pg8::Unit& u, int wr, int wc, int fr0, int fq0) const {
        int fr = fr0, fq = fq0; asm volatile("" : "+v"(fr), "+v"(fq));
        bf16* ACT = (bf16*)(wsb + WS_ACT); const float* cw = inp[19] + (size_t)l * 3 * DFF; const float* cb = inp[20] + (size_t)l * DFF; const float* sconv = inp[7] + (size_t)l * 32 * 2 * DFF;
        float* bp = outb + O_BP + (size_t)l * 2 * DFF; float* bs = outb + O_BS + (size_t)l * 32 * 2 * DFF; LAS float* xb = (LAS float*)(size_t)XB_OFF;
        const int lane = fq * 16 + fr, chl = wc * 32 + 8 * fq, ch0 = u.pn * 128 + chl, arow = 254 * u.pm - 2;
#pragma unroll
        for (int ai = 0; ai < 2; ++ai) if (fr >= 14) { LAS float* p = xb + ((2 * ai + wr) * 2 + (fr - 14)) * 128 + chl; *(LAS f32x4*)p = acc[ai][0][3][0]; *(LAS f32x4*)(p + 4) = acc[ai][0][3][1]; }
        asm volatile("s_waitcnt lgkmcnt(0)" ::: "memory"); __builtin_amdgcn_s_barrier(); asm volatile("" ::: "memory");
        const bool smp = arow + 255 >= SEQ;
#pragma unroll
        for (int ai = 0; ai < 2; ++ai)
#pragma unroll
            for (int hb = 0; hb < 2; ++hb) {
                const int ch = ch0 + 4 * hb;
                const f32x4 w0 = ld4(cw + ch), w1 = ld4(cw + DFF + ch), w2 = ld4(cw + 2 * DFF + ch), bi = ld4(cb + ch);
                const int q = 2 * ai + wr;
                f32x4 p1 = {0.f, 0.f, 0.f, 0.f}, p2 = p1;
                if (q > 0) { const LAS float* r14 = xb + ((q - 1) * 2) * 128 + chl + 4 * hb; p1 = *(const LAS f32x4*)(r14 + 128); p2 = fr == 0 ? *(const LAS f32x4*)r14 : p1; }
#pragma unroll
                for (int m = 0; m < 4; ++m) {
                    const f32x4 Gv = acc[ai][0][m][hb], Vv = acc[ai][1][m][hb];
                    const f32x4 c1 = dpp4<0x121>(Gv), c2 = dpp4<0x122>(Gv);
                    f32x4 g1 = sel4(fr >= 1, c1, p1), g2 = sel4(fr >= 2, c2, p2);
                    const int rt = 128 * ai + 64 * wr + 16 * m + fr, row = arow + rt;
                    if (smp && row >= SEQ && row < MR) { const int t = (row - SEQ) & 7;
                        if (t < 2) { const float* s1 = sconv + ((size_t)((row - SEQ) >> 3) * 2 + 1) * DFF + ch; const f32x4 s1v = ld4(s1);
                            if (t == 0) { g1 = s1v; g2 = ld4(s1 - DFF); } else g2 = s1v; } }
                    const f32x4 o = silu4(g2 * w0 + g1 * w1 + Gv * w2 + bi) * Vv;
                    if (rt >= 2 && row < MR) { u32x2 w; w.x = pg8::cvt_pk_bf16(o.x, o.y); w.y = pg8::cvt_pk_bf16(o.z, o.w); st8(ACT + (size_t)row * DFF + ch, w);
                        float* op = nullptr;
                        if (row < SEQ) { if (row >= SEQ - 2) op = bp + (size_t)(row - (SEQ - 2)) * DFF; } else { const int t = (row - SEQ) & 7; if (t >= 6) op = bs + ((size_t)((row - SEQ) >> 3) * 2 + (t - 6)) * DFF; }
                        if (op) st4(op + ch, Gv); }
                    p1 = c1; p2 = c2;
                    asm volatile("" : "+v"(p1), "+v"(p2));
                }
            }
    }
};

constexpr int VPITCH = 272, KPITCH = 144;

DI void attn_prompt_unit(const bf16* P, bf16* OP, float* ML, int u, LAS unsigned char* lds, unsigned ldsbase, int wave, int lane) {
    const int br = u >> 8, rem = u & 255, head = rem >> 5, blk = rem & 31;
    const int ld = 2 * br;
    const int sb = blk * 8 + wave, nbl = 8 - ld;
    const int r = sb >> nbl, u0 = (sb & ((1 << nbl) - 1)) << 5;
    const int r31 = lane & 31, h = lane >> 5;
    const unsigned vt = ldsbase + (unsigned)wave * (32 * VPITCH); LAS unsigned char* vtp = lds + wave * (32 * VPITCH);
    const int tokq = ((u0 + r31) << ld) + r;
    bf16x8 Qf[8];
    { const bf16* qp = P + (size_t)tokq * PW + 3072 + head * 128 + 8 * h;
#pragma unroll
      for (int ks = 0; ks < 8; ++ks) Qf[ks] = ldfrag(qp + 16 * ks); }
    f32x16 O[4];
#pragma unroll
    for (int d = 0; d < 4; ++d) O[d] = zero16();
    float mrun = -1e30f, lrun = 0.f;
    for (int jt = 0; jt < 5; ++jt) {
        const int ub = u0 - 128 + 32 * jt;
        if (ub < 0) continue;
        const bf16* kp = P + (size_t)(((ub + r31) << ld) + r) * PW + 4096 + head * 128 + 8 * h;
        bf16x8 Kf[8];
#pragma unroll
        for (int ks = 0; ks < 8; ++ks) Kf[ks] = ldfrag(kp + 16 * ks);
        u32x4 vst[8];
#pragma unroll
        for (int i = 0; i < 8; ++i) { const int row = 4 * i + (lane >> 4), ch = lane & 15; vst[i] = ld16(P + (size_t)(((ub + row) << ld) + r) * PW + 5120 + head * 128 + ch * 8); }
        f32x16 S = zero16();
#pragma unroll
        for (int ks = 0; ks < 8; ++ks) S = MFMA32(Kf[ks], Qf[ks], S);
#pragma unroll
        for (int i = 0; i < 8; ++i) { const int row = 4 * i + (lane >> 4), ch = lane & 15; *(LAS u32x4*)(vtp + row * VPITCH + ch * 16) = vst[i]; }
        float tmax = -INFINITY;
#pragma unroll
        for (int reg = 0; reg < 16; ++reg) { const int kk = crow(reg, h); const bool ok = (jt == 0) ? (kk >= r31) : ((jt == 4) ? (kk <= r31) : true);
            S[reg] = ok ? S[reg] : -INFINITY; tmax = fmaxf(tmax, S[reg]); }
        tmax = fmaxf(tmax, __shfl_xor(tmax, 32));
        const float mnew = fmaxf(mrun, tmax), alpha = fexp2(mrun - mnew); mrun = mnew;
        float psum = 0.f;
#pragma unroll
        for (int reg = 0; reg < 16; ++reg) { S[reg] = fexp2(S[reg] - mnew); psum += S[reg]; }
        psum += __shfl_xor(psum, 32);
        lrun = lrun * alpha + psum;
#pragma unroll
        for (int d = 0; d < 4; ++d) O[d] = O[d] * alpha;
        const bf16x8 P0 = pack_step(S, 0), P1 = pack_step(S, 1);
        LDS_WAIT();
#pragma unroll
        for (int d = 0; d < 4; ++d) {
            const bf16x8 A0 = tr_pair(vt, VPITCH, 4 * h, 8 + 4 * h, 32 * d, lane);
            O[d] = MFMA32(A0, P0, O[d]);
            const bf16x8 A1 = tr_pair(vt, VPITCH, 16 + 4 * h, 24 + 4 * h, 32 * d, lane);
            O[d] = MFMA32(A1, P1, O[d]);
        }
    }
    const float inv = 1.f / lrun;
    bf16* op = OP + ((size_t)br * SEQ + tokq) * 1024 + head * 128;
#pragma unroll
    for (int d = 0; d < 4; ++d)
#pragma unroll
        for (int g = 0; g < 4; ++g) { u32x2 w; w.x = pk2(O[d][4 * g] * inv, O[d][4 * g + 1] * inv); w.y = pk2(O[d][4 * g + 2] * inv, O[d][4 * g + 3] * inv); st8(op + 32 * d + 8 * g + 4 * h, w); }
    if (h == 0) { float* mp = ML + (((size_t)br * SEQ + tokq) * 8 + head) * 2; stf(mp, mrun); stf(mp + 1, lrun); }
}

DI void mlstm_m1_item(const bf16* P, const float* IG, const float* LF, float* SCAL, float* DCT, int it, LAS unsigned char* lds, unsigned ldsbase, int wave, int lane) {
    const int half = wave >> 2, wq = wave & 3, unit = it * 2 + half, c = unit >> 3, hd = unit & 7, row0 = c * LCH;
    const int hoff = half * 32768;
    LAS unsigned char* Vt = lds + hoff; LAS unsigned char* Kt = lds + hoff + 64 * VPITCH; LAS float* sc = (LAS float*)(lds + hoff + 64 * VPITCH + 64 * KPITCH);
    const int r31 = lane & 31, h = lane >> 5, t256 = wq * 64 + lane;
    if (wq == 0) {
        const float lf = ldf(LF + (size_t)(row0 + lane) * 8 + hd), ig = ldf(IG + (size_t)(row0 + lane) * 8 + hd);
        float b = lf;
#pragma unroll
        for (int o = 1; o < 64; o <<= 1) { const float t = __shfl_up(b, o); if (lane >= o) b += t; }
        const float d = ig - b; float pm = d;
#pragma unroll
        for (int o = 1; o < 64; o <<= 1) { const float t = __shfl_up(pm, o); if (lane >= o) pm = fmaxf(pm, t); }
        const float pm63 = __shfl(pm, 63);
        sc[lane] = fexp(d - pm63);
        float* sp = SCAL + (size_t)unit * 192; stf(sp + lane, b); stf(sp + 64 + lane, d); stf(sp + 128 + lane, pm);
    }
#pragma unroll
    for (int i = 0; i < 4; ++i) { const int id = i * 256 + t256, row = id >> 4, ch = id & 15;
        *(LAS u32x4*)(Vt + row * VPITCH + ch * 16) = ld16(P + (size_t)(row0 + row) * PW + 1024 + hd * 128 + ch * 8); }
    __syncthreads();
#pragma unroll
    for (int i = 0; i < 2; ++i) { const int id = i * 256 + t256, row = id >> 3, ch = id & 7; const float w = sc[row];
        const u32x4 kv = ld16(P + (size_t)(row0 + row) * PW + 512 + hd * 64 + ch * 8); u32x4 o;
        o.x = pk2(bflo(kv.x) * w, bfhi(kv.x) * w); o.y = pk2(bflo(kv.y) * w, bfhi(kv.y) * w); o.z = pk2(bflo(kv.z) * w, bfhi(kv.z) * w); o.w = pk2(bflo(kv.w) * w, bfhi(kv.w) * w);
        *(LAS u32x4*)(Kt + row * KPITCH + ch * 16) = o; }
    __syncthreads();
    f32x16 a0 = zero16(), a1 = zero16();
    const unsigned vtb = ldsbase + hoff, ktb = ldsbase + hoff + 64 * VPITCH;
#pragma unroll
    for (int ks = 0; ks < 4; ++ks) {
        const bf16x8 A = tr_pair(vtb, VPITCH, 16 * ks + 8 * h, 16 * ks + 8 * h + 4, 32 * wq, lane);
        const bf16x8 B0 = tr_pair(ktb, KPITCH, 16 * ks + 8 * h, 16 * ks + 8 * h + 4, 0, lane);
        const bf16x8 B1 = tr_pair(ktb, KPITCH, 16 * ks + 8 * h, 16 * ks + 8 * h + 4, 32, lane);
        a0 = MFMA32(A, B0, a0); a1 = MFMA32(A, B1, a1);
    }
    float* dp = DCT + (size_t)unit * (129 * 64);
#pragma unroll
    for (int reg = 0; reg < 16; ++reg) { const int dv = 32 * wq + crow(reg, h); stf(dp + dv * 64 + r31, a0[reg]); stf(dp + dv * 64 + 32 + r31, a1[reg]); }
    if (wq == 1) { float s = 0.f;
#pragma unroll 8
        for (int r = 0; r < 64; ++r) s += bf2f(*(const LAS unsigned short*)(Kt + r * KPITCH + lane * 2));
        stf(dp + 128 * 64 + lane, s); }
    __syncthreads();
}

DI void mlstm_m2(const float* SCAL, const float* DCT, bf16* CST, float* MST, float* outC, float* outN, float* outM, int e) {
    const int hd = e / 8256, idx = e % 8256;
    float C = 0.f, m = 0.f;
#pragma unroll 4
    for (int c = 0; c < NCH; ++c) {
        const int unit = c * 8 + hd;
        const float Bc = ldf(SCAL + (size_t)unit * 192 + 63), pmc = ldf(SCAL + (size_t)unit * 192 + 191), Ac = Bc + pmc;
        const float dc = ldf(DCT + (size_t)unit * 8256 + idx);
        const float mn = fmaxf(Bc + m, Ac), f1 = fexp(Bc + m - mn), f2 = fexp(Ac - mn);
        *(GAS unsigned short*)(CST + (size_t)unit * (160 * 64) + idx) = (unsigned short)f2bf(C);
        if (idx == 0) stf(MST + unit, m);
        C = f1 * C + f2 * dc; m = mn;
    }
    const int row = idx >> 6, dk = idx & 63;
    if (row < 128) stf(outC + (size_t)hd * 8192 + dk * 128 + row, C); else stf(outN + hd * 64 + dk, C);
    if (idx == 0) stf(outM + hd, m);
}
DI void attn_combine(const bf16* OP, const float* ML, bf16* CAT, int e) {
    const int tok = e >> 7, c8 = e & 127, head = c8 >> 4;
    float m[3], l[3];
#pragma unroll
    for (int b = 0; b < 3; ++b) { const float* mp = ML + (((size_t)b * SEQ + tok) * 8 + head) * 2; m[b] = ldf(mp); l[b] = ldf(mp + 1); }
    const float M = fmaxf(m[0], fmaxf(m[1], m[2]));
    float w[3], ws = 0.f;
#pragma unroll
    for (int b = 0; b < 3; ++b) { w[b] = fexp2(m[b] - M) * l[b]; ws += w[b]; }
    const float inv = 1.f / ws; float o[8];
#pragma unroll
    for (int j = 0; j < 8; ++j) o[j] = 0.f;
#pragma unroll
    for (int b = 0; b < 3; ++b) { const u32x4 v = ld16(OP + ((size_t)b * SEQ + tok) * 1024 + c8 * 8); const float wb = w[b] * inv;
        o[0] += wb * bflo(v.x); o[1] += wb * bfhi(v.x); o[2] += wb * bflo(v.y); o[3] += wb * bfhi(v.y); o[4] += wb * bflo(v.z); o[5] += wb * bfhi(v.z); o[6] += wb * bflo(v.w); o[7] += wb * bfhi(v.w); }
    u32x4 r; r.x = pk2(o[0], o[1]); r.y = pk2(o[2], o[3]); r.z = pk2(o[4], o[5]); r.w = pk2(o[6], o[7]);
    st16(CAT + (size_t)tok * DM + 1024 + c8 * 8, r);
}

DI void mlstm_m3_item(const bf16* P, const float* SCAL, const bf16* CST, const float* MST, const float* ghead, bf16* CAT, int it, LAS unsigned char* lds, unsigned ldsbase, int wave, int lane) {
    const int slot = wave >> 1, tw = wave & 1, unit = it * 4 + slot, c = unit >> 3, hd = unit & 7, row0 = c * LCH;
    const int r31 = lane & 31, h = lane >> 5, t = 32 * tw + r31;
    LAS unsigned char* Vt = lds + slot * (64 * VPITCH); const unsigned vtb = ldsbase + slot * (64 * VPITCH);
    { const int t128 = tw * 64 + lane;
#pragma unroll
      for (int i = 0; i < 8; ++i) { const int id = i * 128 + t128, row = id >> 4, ch = id & 15;
          *(LAS u32x4*)(Vt + row * VPITCH + ch * 16) = ld16(P + (size_t)(row0 + row) * PW + 1024 + hd * 128 + ch * 8); } }
    const float* sp = SCAL + (size_t)unit * 192;
    const float mc = ldf(MST + unit), bt = ldf(sp + t), pmt = ldf(sp + 128 + t);
    const float Mt = fmaxf(mc, pmt), gt = fexp(mc - Mt);
    bf16x8 Qf[4], Qg[4];
    { const bf16* qp = P + (size_t)(row0 + t) * PW + hd * 64 + 8 * h;
#pragma unroll
      for (int ks = 0; ks < 4; ++ks) { const u32x4 q = ld16(qp + 16 * ks); Qf[ks] = __builtin_bit_cast(bf16x8, q); u32x4 g;
          g.x = pk2(bflo(q.x) * gt, bfhi(q.x) * gt); g.y = pk2(bflo(q.y) * gt, bfhi(q.y) * gt); g.z = pk2(bflo(q.z) * gt, bfhi(q.z) * gt); g.w = pk2(bflo(q.w) * gt, bfhi(q.w) * gt); Qg[ks] = __builtin_bit_cast(bf16x8, g); } }
    f32x16 acc[5];
#pragma unroll
    for (int d = 0; d < 5; ++d) acc[d] = zero16();
    { const bf16* cp = CST + (size_t)unit * (160 * 64) + (size_t)r31 * 64 + 8 * h;
#pragma unroll
      for (int d = 0; d < 5; ++d)
#pragma unroll
          for (int ks = 0; ks < 4; ++ks) acc[d] = MFMA32(ldfrag(cp + d * 32 * 64 + 16 * ks), Qg[ks], acc[d]); }
    __syncthreads();
    float rowsum = 0.f;
    for (int st = 0; st <= tw; ++st) {
        const bf16* kp = P + (size_t)(row0 + 32 * st + r31) * PW + 512 + hd * 64 + 8 * h;
        f32x16 S = zero16();
#pragma unroll
        for (int ks = 0; ks < 4; ++ks) S = MFMA32(ldfrag(kp + 16 * ks), Qf[ks], S);
#pragma unroll
        for (int g = 0; g < 4; ++g) { const f32x4 dv = ld4(sp + 64 + 32 * st + 8 * g + 4 * h);
#pragma unroll
            for (int e = 0; e < 4; ++e) { const int kk = 8 * g + 4 * h + e; const bool ok = (st < tw) || (kk <= r31);
                const float p = ok ? S[4 * g + e] * fexp(dv[e] - Mt) : 0.f; S[4 * g + e] = p; rowsum += p; } }
        const bf16x8 P0 = pack_step(S, 0), P1 = pack_step(S, 1);
#pragma unroll
        for (int d = 0; d < 4; ++d) {
            const bf16x8 A0 = tr_pair(vtb, VPITCH, 32 * st + 4 * h, 32 * st + 8 + 4 * h, 32 * d, lane);
            acc[d] = MFMA32(A0, P0, acc[d]);
            const bf16x8 A1 = tr_pair(vtb, VPITCH, 32 * st + 16 + 4 * h, 32 * st + 24 + 4 * h, 32 * d, lane);
            acc[d] = MFMA32(A1, P1, acc[d]);
        }
    }
    rowsum += __shfl_xor(rowsum, 32);
    const float qn = __shfl(acc[4][0], r31);
    const float den = qn + rowsum, dn = fmaxf(fabsf(den), fexp(-(bt + Mt))), inv = 1.f / dn;
    float ss = 0.f;
#pragma unroll
    for (int d = 0; d < 4; ++d)
#pragma unroll
        for (int reg = 0; reg < 16; ++reg) { acc[d][reg] *= inv; ss += acc[d][reg] * acc[d][reg]; }
    ss += __shfl_xor(ss, 32);
    const float rn = 1.f / sqrtf(ss * (1.f / 128.f) + 1e-6f);
    const bf16* omp = P + (size_t)(row0 + t) * PW + 2048 + hd * 128; bf16* cp = CAT + (size_t)(row0 + t) * DM + hd * 128;
#pragma unroll
    for (int d = 0; d < 4; ++d)
#pragma unroll
        for (int g = 0; g < 4; ++g) { const int dv0 = 32 * d + 8 * g + 4 * h; const f32x4 gh = ld4(ghead + hd * 128 + dv0); const u32x2 om = ld8(omp + dv0);
            const float o0 = acc[d][4 * g] * rn * gh.x * sigmoidf_(bflo(om.x)), o1 = acc[d][4 * g + 1] * rn * gh.y * sigmoidf_(bfhi(om.x));
            const float o2 = acc[d][4 * g + 2] * rn * gh.z * sigmoidf_(bflo(om.y)), o3 = acc[d][4 * g + 3] * rn * gh.w * sigmoidf_(bfhi(om.y));
            u32x2 w; w.x = pk2(o0, o1); w.y = pk2(o2, o3); st8(cp + dv0, w); }
    __syncthreads();
}

DI void sample_mlstm_unit(const bf16* P, const float* IG, const float* LF, const float* C0g, const float* n0g, const float* m0g, const float* ghead, bf16* CAT,
                          float* outC, float* outN, float* outM, int b, int hd, LAS unsigned char* lds, int tid, int wave, int lane) {
    LAS float* q = (LAS float*)lds;
    LAS float* k = q + 512;
    LAS float* v = k + 512;
    LAS float* S = v + 1024;
    LAS float* sb = S + 64;
    LAS float* sd = sb + 8;
    LAS float* sM = sd + 8;
    LAS float* sg = sM + 8;
    LAS float* sqn = sg + 8;
    LAS float* sdi = sqn + 8;
    LAS float* sss = sdi + 8;
    LAS float* skw = sss + 16;
    const int R0 = SEQ + 8 * b;
    { const int t = tid >> 6, dk = tid & 63;
      q[tid] = bf2f(*(const GAS unsigned short*)(P + (size_t)(R0 + t) * PW + hd * 64 + dk));
      k[tid] = bf2f(*(const GAS unsigned short*)(P + (size_t)(R0 + t) * PW + 512 + hd * 64 + dk));
#pragma unroll
      for (int i = 0; i < 2; ++i) { const int e = tid + 512 * i, tt = e >> 7, dv = e & 127; v[e] = bf2f(*(const GAS unsigned short*)(P + (size_t)(R0 + tt) * PW + 1024 + hd * 128 + dv)); } }
    const float m0 = ldf(m0g);
    if (wave == 0) {
        const int tt = lane & 7;
        const float lf = ldf(LF + (size_t)(R0 + tt) * 8 + hd), ig = ldf(IG + (size_t)(R0 + tt) * 8 + hd);
        float bb = lf;
#pragma unroll
        for (int o = 1; o < 8; o <<= 1) { const float x = __shfl_up(bb, o, 8); if (tt >= o) bb += x; }
        const float d = ig - bb; float pm = d;
#pragma unroll
        for (int o = 1; o < 8; o <<= 1) { const float x = __shfl_up(pm, o, 8); if (tt >= o) pm = fmaxf(pm, x); }
        if (lane < 8) { const float M = fmaxf(m0, pm); sb[tt] = bb; sd[tt] = d; sM[tt] = M; sg[tt] = fexp(m0 - M); }
    }
    __syncthreads();
    if (tid < 64) { const int t = tid >> 3, s = tid & 7; float a = 0.f;
#pragma unroll 8
        for (int dk = 0; dk < 64; ++dk) a += q[t * 64 + dk] * k[s * 64 + dk];
        S[tid] = (s <= t) ? a * fexp(sd[s] - sM[t]) : 0.f;
    } else if (tid < 128) { const int i = tid - 64, t = i >> 3, part = i & 7; float a = 0.f;
#pragma unroll
        for (int j = 0; j < 8; ++j) a += q[t * 64 + part * 8 + j] * ldf(n0g + part * 8 + j);
        a += __shfl_xor(a, 1); a += __shfl_xor(a, 2); a += __shfl_xor(a, 4);
        if (part == 0) sqn[t] = a;
    }
    { const int s = tid >> 6, dk = tid & 63; skw[tid] = fexp(sd[s] - sM[7]) * k[s * 64 + dk]; }
    __syncthreads();
    if (tid < 8) { float rs = 0.f;
#pragma unroll
        for (int s = 0; s < 8; ++s) rs += S[tid * 8 + s];
        const float den = sg[tid] * sqn[tid] + rs; sdi[tid] = 1.f / fmaxf(fabsf(den), fexp(-(sb[tid] + sM[tid]))); }
    __syncthreads();
    const int dv = tid & 127, tq = tid >> 7;
    float a0 = 0.f, a1 = 0.f;
#pragma unroll 8
    for (int dk = 0; dk < 64; ++dk) { const float c = ldf(C0g + dk * 128 + dv); a0 += q[tq * 64 + dk] * c; a1 += q[(tq + 4) * 64 + dk] * c; }
    float vv[8];
#pragma unroll
    for (int s = 0; s < 8; ++s) vv[s] = v[s * 128 + dv];
    float n0_ = sg[tq] * a0, n1_ = sg[tq + 4] * a1;
#pragma unroll
    for (int s = 0; s < 8; ++s) { n0_ += S[tq * 8 + s] * vv[s]; n1_ += S[(tq + 4) * 8 + s] * vv[s]; }
    const float h0 = n0_ * sdi[tq], h1 = n1_ * sdi[tq + 4];
    const float p0 = wave_sum(h0 * h0), p1 = wave_sum(h1 * h1);
    if (lane == 0) { sss[tq * 2 + (wave & 1)] = p0; sss[(tq + 4) * 2 + (wave & 1)] = p1; }
    __syncthreads();
    { const float r0 = 1.f / sqrtf((sss[tq * 2] + sss[tq * 2 + 1]) * (1.f / 128.f) + 1e-6f), r1 = 1.f / sqrtf((sss[(tq + 4) * 2] + sss[(tq + 4) * 2 + 1]) * (1.f / 128.f) + 1e-6f);
      const float gh = ldf(ghead + hd * 128 + dv);
      const float om0 = bf2f(*(const GAS unsigned short*)(P + (size_t)(R0 + tq) * PW + 2048 + hd * 128 + dv)), om1 = bf2f(*(const GAS unsigned short*)(P + (size_t)(R0 + tq + 4) * PW + 2048 + hd * 128 + dv));
      *(GAS unsigned short*)(CAT + (size_t)(R0 + tq) * DM + hd * 128 + dv) = (unsigned short)f2bf(h0 * r0 * gh * sigmoidf_(om0));
      *(GAS unsigned short*)(CAT + (size_t)(R0 + tq + 4) * DM + hd * 128 + dv) = (unsigned short)f2bf(h1 * r1 * gh * sigmoidf_(om1)); }
    const float gend = sg[7];
#pragma unroll 4
    for (int j = 0; j < 16; ++j) { const int dk = 16 * tq + j; float c = gend * ldf(C0g + dk * 128 + dv);
#pragma unroll
        for (int s = 0; s < 8; ++s) c += skw[s * 64 + dk] * vv[s];
        stf(outC + dk * 128 + dv, c); }
    if (tid < 64) { float n = gend * ldf(n0g + tid);
#pragma unroll
        for (int s = 0; s < 8; ++s) n += skw[s * 64 + tid];
        stf(outN + tid, n); }
    if (tid == 0) stf(outM, sb[7] + sM[7]);
    __syncthreads();
}

DI int sa_slot_idx(int tile, int s) {
    if (tile < 24) { const int sl = tile * 32 + s; return (sl >> 3) * 16 + (sl & 7); }
    if (tile < 40) return 1536 + (tile - 24) * 32 + s;
    return s < 8 ? 2048 + s : -1;
}
DI void sample_attn_unit(const bf16* P, const float* ck, const float* cv, bf16* CAT, int b, int head, LAS unsigned char* lds, unsigned ldsbase, int tid, int wave, int lane0) {
    const int lane = lane0, r31 = lane & 31, h = lane >> 5, R0 = SEQ + 8 * b;
    LAS unsigned char* vtp = lds + wave * (32 * VPITCH); const unsigned vt = ldsbase + (unsigned)wave * (32 * VPITCH);
    LAS float* Ow = (LAS float*)(lds + 73728);
    LAS float* Mw = (LAS float*)(lds + 73728 + 32768);
    LAS float* Lw = Mw + 64;
    f32x16 O[4];
#pragma unroll
    for (int d = 0; d < 4; ++d) O[d] = zero16();
    float mrun = -1e30f, lrun = 0.f;
    const float* ckb = ck + (size_t)b * 2048 * 1024 + head * 128; const float* cvb = cv + (size_t)b * 2048 * 1024 + head * 128;
    for (int tile = wave; tile < 41; tile += 8) {
        int lq = lane; asm volatile("" : "+v"(lq));
        const int r31 = lq & 31, h = lq >> 5, lane = lq;
        f32x16 S = zero16(); f32x4 vv[16];
        bf16x8 Qf[8];
        { const bf16* qp = P + (size_t)(R0 + (r31 & 7)) * PW + 3072 + head * 128 + 8 * h;
#pragma unroll
          for (int ks = 0; ks < 8; ++ks) { u32x4 q = ld16(qp + 16 * ks); if (r31 >= 8) q = (u32x4){0u, 0u, 0u, 0u}; Qf[ks] = __builtin_bit_cast(bf16x8, q); } }
        if (tile < 40) {
            const float* kp = ckb + (size_t)sa_slot_idx(tile, r31) * 1024 + 8 * h;
            f32x4 kk[16];
#pragma unroll
            for (int ks = 0; ks < 8; ++ks) { kk[2 * ks] = ld4(kp + 16 * ks); kk[2 * ks + 1] = ld4(kp + 16 * ks + 4); }
#pragma unroll
            for (int ks = 0; ks < 8; ++ks) { const f32x4 a = kk[2 * ks], c = kk[2 * ks + 1];
                u32x4 w; w.x = pk2(a.x, a.y); w.y = pk2(a.z, a.w); w.z = pk2(c.x, c.y); w.w = pk2(c.z, c.w); S = MFMA32(__builtin_bit_cast(bf16x8, w), Qf[ks], S); }
            asm volatile("" ::: "memory");
#pragma unroll
            for (int i = 0; i < 16; ++i) { const int id = i * 64 + lane, row = id >> 5, c4 = id & 31; vv[i] = ld4(cvb + (size_t)sa_slot_idx(tile, row) * 1024 + 4 * c4); }
        } else {
            const bf16* kp = P + (size_t)(R0 + (r31 & 7)) * PW + 4096 + head * 128 + 8 * h;
#pragma unroll
            for (int ks = 0; ks < 8; ++ks) { u32x4 w = ld16(kp + 16 * ks); if (r31 >= 8) w = (u32x4){0u, 0u, 0u, 0u}; S = MFMA32(__builtin_bit_cast(bf16x8, w), Qf[ks], S); }
#pragma unroll
            for (int i = 0; i < 8; ++i) { const int id = i * 64 + lane, row = id >> 4, ch = id & 15; u32x4 w = ld16(P + (size_t)(R0 + (row & 7)) * PW + 5120 + head * 128 + ch * 8); if (row >= 8) w = (u32x4){0u, 0u, 0u, 0u};
                *(LAS u32x4*)(vtp + row * VPITCH + ch * 16) = w; }
#pragma unroll
            for (int i = 0; i < 16; ++i) vv[i] = (f32x4){0.f, 0.f, 0.f, 0.f};
        }
        float tmax = -INFINITY;
#pragma unroll
        for (int reg = 0; reg < 16; ++reg) { const int idx = sa_slot_idx(tile, crow(reg, h)); const int dist = 2048 + r31 - idx;
            int mult = 0;
            if (idx >= 0 && r31 < 8 && dist >= 0) mult = (dist <= 128 ? 1 : 0) + (((dist & 3) == 0 && dist <= 512) ? 1 : 0) + (((dist & 15) == 0 && dist <= 2048) ? 1 : 0);
            if (mult) tmax = fmaxf(tmax, S[reg]);
            const float lm = mult == 3 ? 1.5849625f : (mult == 2 ? 1.f : 0.f);
            S[reg] = mult ? S[reg] + lm : -INFINITY; }
        tmax = fmaxf(tmax, __shfl_xor(tmax, 32));
        const float mnew = fmaxf(mrun, tmax), alpha = fexp2(mrun - mnew); mrun = mnew;
        float psum = 0.f;
#pragma unroll
        for (int reg = 0; reg < 16; ++reg) { S[reg] = fexp2(S[reg] - mnew); psum += S[reg]; }
        psum += __shfl_xor(psum, 32);
        lrun = lrun * alpha + psum;
#pragma unroll
        for (int d = 0; d < 4; ++d) O[d] = O[d] * alpha;
        const bf16x8 P0 = pack_step(S, 0), P1 = pack_step(S, 1);
        if (tile < 40) {
#pragma unroll
            for (int i = 0; i < 16; ++i) { const int id = i * 64 + lane, row = id >> 5, c4 = id & 31; u32x2 w; w.x = pk2(vv[i].x, vv[i].y); w.y = pk2(vv[i].z, vv[i].w); *(LAS u32x2*)(vtp + row * VPITCH + c4 * 8) = w; }
        }
        LDS_WAIT();
#pragma unroll
        for (int d = 0; d < 4; ++d) {
            const bf16x8 A0 = tr_pair(vt, VPITCH, 4 * h, 8 + 4 * h, 32 * d, lane);
            O[d] = MFMA32(A0, P0, O[d]);
            const bf16x8 A1 = tr_pair(vt, VPITCH, 16 + 4 * h, 24 + 4 * h, 32 * d, lane);
            O[d] = MFMA32(A1, P1, O[d]);
        }
    }
    if (r31 < 8) {
#pragma unroll
        for (int d = 0; d < 4; ++d)
#pragma unroll
            for (int reg = 0; reg < 16; ++reg) Ow[(wave * 8 + r31) * 128 + 32 * d + crow(reg, h)] = O[d][reg];
        if (h == 0) { Mw[wave * 8 + r31] = mrun; Lw[wave * 8 + r31] = lrun; }
    }
    __syncthreads();
#pragma unroll
    for (int i = 0; i < 2; ++i) { const int e = tid + 512 * i, t = e >> 7, d = e & 127; float M = -1e30f;
#pragma unroll
        for (int w = 0; w < 8; ++w) M = fmaxf(M, Mw[w * 8 + t]);
        float num = 0.f, den = 0.f;
#pragma unroll
        for (int w = 0; w < 8; ++w) { const float f = fexp2(Mw[w * 8 + t] - M); num += f * Ow[(w * 8 + t) * 128 + d]; den += f * Lw[w * 8 + t]; }
        *(GAS unsigned short*)(CAT + (size_t)(R0 + t) * DM + 1024 + head * 128 + d) = (unsigned short)f2bf(num / den); }
    __syncthreads();
}

DI void sample_attn_unit_v1(const bf16* P, const float* ck, const float* cv, bf16* CAT, int b, int head, LAS unsigned char* lds, int wave, int lane) {
    LAS float* sc = (LAS float*)lds + wave * 136;
    const int t = wave, half = lane >> 5, r31 = lane & 31, R0 = SEQ + 8 * b;
    f32x4 q;
    { const u32x2 w = ld8(P + (size_t)(R0 + t) * PW + 3072 + head * 128 + 4 * r31); q.x = bflo(w.x); q.y = bfhi(w.x); q.z = bflo(w.y); q.w = bfhi(w.y); }
    float Mr = -1e30f, Lr = 0.f; f32x4 Ar = {0.f, 0.f, 0.f, 0.f};
    const float* ckb = ck + (size_t)b * 2048 * 1024 + head * 128 + 4 * r31; const float* cvb = cv + (size_t)b * 2048 * 1024 + head * 128 + 4 * r31;
    for (int br = 0; br < 3; ++br) {
        const int ld = 2 * br;
#pragma unroll 5
        for (int jj = 0; jj < 65; ++jj) { const int j = 2 * jj + half; const bool ok = j <= 128; const int idx = 2048 + t - ((ok ? j : 0) << ld);
            f32x4 kv;
            if (idx >= 2048) { const u32x2 w = ld8(P + (size_t)(R0 + idx - 2048) * PW + 4096 + head * 128 + 4 * r31); kv.x = bflo(w.x); kv.y = bfhi(w.x); kv.z = bflo(w.y); kv.w = bfhi(w.y); }
            else kv = ld4(ckb + (size_t)idx * 1024);
            float s = q.x * kv.x + q.y * kv.y + q.z * kv.z + q.w * kv.w;
            s += __shfl_xor(s, 1); s += __shfl_xor(s, 2); s += __shfl_xor(s, 4); s += __shfl_xor(s, 8); s += __shfl_xor(s, 16);
            if (r31 == 0 && ok) sc[j] = s; }
        LDS_WAIT();
        float s0 = sc[lane], s1 = sc[64 + lane], s2 = (lane == 0) ? sc[128] : -INFINITY;
        const float m = wave_max(fmaxf(s0, fmaxf(s1, s2)));
        s0 = fexp2(s0 - m); s1 = fexp2(s1 - m); s2 = fexp2(s2 - m);
        const float l = wave_sum(s0 + s1 + s2);
        sc[lane] = s0; sc[64 + lane] = s1; if (lane == 0) sc[128] = s2;
        LDS_WAIT();
        f32x4 acc = {0.f, 0.f, 0.f, 0.f};
#pragma unroll 5
        for (int jj = 0; jj < 65; ++jj) { const int j = 2 * jj + half; const bool ok = j <= 128; const int idx = 2048 + t - ((ok ? j : 0) << ld);
            f32x4 vv;
            if (idx >= 2048) { const u32x2 w = ld8(P + (size_t)(R0 + idx - 2048) * PW + 5120 + head * 128 + 4 * r31); vv.x = bflo(w.x); vv.y = bfhi(w.x); vv.z = bflo(w.y); vv.w = bfhi(w.y); }
            else vv = ld4(cvb + (size_t)idx * 1024);
            const float p = ok ? sc[ok ? j : 0] : 0.f;
            acc += vv * p; }
        acc.x += __shfl_xor(acc.x, 32); acc.y += __shfl_xor(acc.y, 32); acc.z += __shfl_xor(acc.z, 32); acc.w += __shfl_xor(acc.w, 32);
        const float Mn = fmaxf(Mr, m), fa = fexp2(Mr - Mn), fb = fexp2(m - Mn);
        Ar = Ar * fa + acc * fb; Lr = Lr * fa + l * fb; Mr = Mn;
        LDS_WAIT();
    }
    if (half == 0) { const float inv = 1.f / Lr; u32x2 w; w.x = pk2(Ar.x * inv, Ar.y * inv); w.y = pk2(Ar.z * inv, Ar.w * inv);
        st8(CAT + (size_t)(R0 + t) * DM + 1024 + head * 128 + 4 * r31, w); }
}

DI f32x4 bf4lo(u32x4 w) { return (f32x4){bflo(w.x), bfhi(w.x), bflo(w.y), bfhi(w.y)}; }
DI f32x4 bf4hi(u32x4 w) { return (f32x4){bflo(w.z), bfhi(w.z), bflo(w.w), bfhi(w.w)}; }
constexpr int CONV_ROWS = 64, CONV_PT = (SEQ / CONV_ROWS) * 704, CONV_TASKS = CONV_PT + 32 * 704;
DI void conv_task(const bf16* GV, bf16* ACT, const float* cw, const float* cb, const float* sconv, int e) {
    int row0, nb, cg; f32x4 gm2[2], gm1[2];
    if (e < CONV_PT) { const int rc = e / 704; cg = e % 704; row0 = rc * CONV_ROWS; nb = CONV_ROWS / 8;
        if (rc == 0) { gm2[0] = gm2[1] = gm1[0] = gm1[1] = (f32x4){0.f, 0.f, 0.f, 0.f}; }
        else { const u32x4 a = ld16(GV + (size_t)(row0 - 2) * NUP + cg * 8), b = ld16(GV + (size_t)(row0 - 1) * NUP + cg * 8);
            gm2[0] = bf4lo(a); gm2[1] = bf4hi(a); gm1[0] = bf4lo(b); gm1[1] = bf4hi(b); }
    } else { const int e2 = e - CONV_PT, bb = e2 / 704; cg = e2 % 704; row0 = SEQ + 8 * bb; nb = 1;
        const float* s0 = sconv + ((size_t)bb * 2) * DFF + cg * 8;
        gm2[0] = ld4(s0); gm2[1] = ld4(s0 + 4); gm1[0] = ld4(s0 + DFF); gm1[1] = ld4(s0 + DFF + 4); }
    const int c0 = cg * 8;
    const f32x4 w0a = ld4(cw + c0), w0b = ld4(cw + c0 + 4), w1a = ld4(cw + DFF + c0), w1b = ld4(cw + DFF + c0 + 4), w2a = ld4(cw + 2 * DFF + c0), w2b = ld4(cw + 2 * DFF + c0 + 4);
    const f32x4 ba = ld4(cb + c0), bb4 = ld4(cb + c0 + 4);
    for (int b8 = 0; b8 < nb; ++b8) {
        u32x4 gw[8], vw[8];
#pragma unroll
        for (int r = 0; r < 8; ++r) { const size_t ro = (size_t)(row0 + 8 * b8 + r) * NUP + c0; gw[r] = ld16(GV + ro); vw[r] = ld16(GV + ro + DFF); }
#pragma unroll
        for (int r = 0; r < 8; ++r) {
            const f32x4 g0 = bf4lo(gw[r]), g1 = bf4hi(gw[r]), v0 = bf4lo(vw[r]), v1 = bf4hi(vw[r]);
            const f32x4 x0 = gm2[0] * w0a + gm1[0] * w1a + g0 * w2a + ba, x1 = gm2[1] * w0b + gm1[1] * w1b + g1 * w2b + bb4;
            u32x4 o; o.x = pk2(siluf_(x0.x) * v0.x, siluf_(x0.y) * v0.y); o.y = pk2(siluf_(x0.z) * v0.z, siluf_(x0.w) * v0.w);
            o.z = pk2(siluf_(x1.x) * v1.x, siluf_(x1.y) * v1.y); o.w = pk2(siluf_(x1.z) * v1.z, siluf_(x1.w) * v1.w);
            st16(ACT + (size_t)(row0 + 8 * b8 + r) * DFF + c0, o);
            gm2[0] = gm1[0]; gm2[1] = gm1[1]; gm1[0] = g0; gm1[1] = g1; }
    }
}

#ifndef MK_SPLIT
#define MK_SPLIT 0
#endif
constexpr int N_PHASES = 22;
struct Args { const float* in[24]; float* out; unsigned char* ws; int ph_lo, ph_hi, li, pad; };

typedef const Args __attribute__((address_space(4)))* KArgs;
struct GOrder {
    pg8::StaticOrder so; int mode, nS, nUnits, G, c; pg8::Unit one;
    DI bool next(int i, pg8::Unit& u) const {
        if (mode == 0) return so.next(i, u);
        if (mode == 1) { const int L = i * G + c; if (L >= nUnits) return false; u.pm = 32; u.pn = L / nS; u.ks = L % nS; return true; }
        if (i) return false; u = one; return true;
    }
    DI void a_ready(const pg8::Unit&) const {}
    DI void done(const pg8::Unit&) const {}
};
DI GOrder order_static(int M, int N, int G, int c) { GOrder o; o.so.init(M, N, G, c); o.mode = 0; o.nS = 1; o.nUnits = 0; o.G = G; o.c = c; o.one = pg8::Unit{0, 0, 0}; return o; }
DI GOrder order_split(int nN, int nS, int G, int c) { GOrder o; o.so.init(256, 256, G, c); o.mode = 1; o.nS = nS; o.nUnits = nN * nS; o.G = G; o.c = c; o.one = pg8::Unit{0, 0, 0}; return o; }
DI GOrder order_one(int pm, int pn) { GOrder o; o.so.init(256, 256, 1, 0); o.mode = 2; o.nS = 1; o.nUnits = 1; o.G = 1; o.c = 0; o.one = pg8::Unit{pm, pn, 0}; return o; }
DI int dequeue(gu32* qw, volatile LAS unsigned* slot, int tid) {
    __syncthreads();
    if (tid == 0) *slot = __hip_atomic_fetch_add(qw, 1u, RLX_AGENT);
    __syncthreads();
    return (int)*slot;
}

__global__ void __launch_bounds__(NTHR, 2) mk_fwd(Args a) {
    extern __shared__ __attribute__((aligned(16))) unsigned char lds_raw[];
    LAS unsigned char* lds = (LAS unsigned char*)lds_raw;
    const unsigned ldsbase = (unsigned)(size_t)lds_raw;
    const int tid = threadIdx.x, lane = tid & 63, wave = __builtin_amdgcn_readfirstlane(tid >> 6);
    const int G = gridDim.x, bid = blockIdx.x;
    volatile LAS unsigned* MISC = (volatile LAS unsigned*)(lds + MISC_OFF);
    for (int u = tid; u < (LDS_BYTES - LDSCTL_OFF) / 4; u += NTHR) ((LAS unsigned*)(lds + LDSCTL_OFF))[u] = 0u;
    __syncthreads();
    unsigned char* const ws = a.ws; float* const out0 = a.out;
    const KArgs ka0 = (KArgs)__builtin_amdgcn_kernarg_segment_ptr();
    XcdBarrier bar = xcd_barrier_post((unsigned*)ws + CW_BAR + a.li * XCD_BAR_WORDS, MISC + 8);
    const int lo = a.ph_lo, hi = a.ph_hi;
#ifndef MK_MASK
#define MK_MASK 0xFFFFFFFFu
#endif
#ifndef MK_DBL
#define MK_DBL 0u
#endif
#ifndef MK_C
#define MK_C 15
#endif
#ifndef MK_DBLC
#define MK_DBLC 0
#endif
#define RPC(j) (((MK_DBLC >> (j)) & 1) ? 2 : 1)
#define RUN(k) (lo <= (k) && (k) < hi)
#define EN(j) ((MK_MASK >> (j)) & 1u)
#define REPS(j) (((MK_DBL >> (j)) & 1u) ? 2 : 1)
#ifndef MK_BAR2
#define MK_BAR2 0
#endif
#define SEAM(k) do { if (RUN(k) && RUN((k) + 1)) { xcd_barrier(bar); if (MK_BAR2) xcd_barrier(bar); } } while (0)
#define PH() int ln = lane, td = tid; unsigned char* wsl = ws; float* out = out0; KArgs ka = ka0; asm volatile("" : "+v"(ln), "+v"(td), "+s"(wsl), "+s"(out), "+s"(ka)); \
             const int gw = bid * NWAVES + wave, ngw = G * NWAVES, gt = bid * NTHR + td, ngt = G * NTHR; (void)ln; (void)td; (void)gw; (void)ngw; (void)gt; (void)ngt; (void)out; (void)ka
#define W_(T, off) ((T*)(wsl + (off)))
#define IN_(k) (ka->in[k])
#define QW_(q) ((gu32*)wsl + CW_Q + 64 * (q))
#define PHQ() ln = lane; td = tid; wsl = ws; out = out0; ka = ka0; asm volatile("" : "+v"(ln), "+v"(td), "+s"(wsl), "+s"(out), "+s"(ka))

    if (EN(0) && RUN(0)) for (int rep_ = 0; rep_ < REPS(0); ++rep_) {
        { PH(); p0_mod(IN_(8), IN_(9), IN_(10), IN_(11), W_(float, WS_MOD), lds, bid, G, td, wave, ln); }
        { PH(); p0_rope(W_(float, WS_ROPE), W_(float, WS_ROPE) + 8200 * 64, gt, ngt);
          if (gt < 2 * DM / 8) st16(W_(bf16, WS_UPAD) + (size_t)gt * 8, (u32x4){0u, 0u, 0u, 0u}); }
        { PH(); p0_weights(IN_(12), IN_(15), IN_(18), IN_(21), wsl, lds, gw, ngw, wave, ln); }
        __syncthreads();
    }
    SEAM(0);
    if (EN(1) && RUN(1)) for (int rep_ = 0; rep_ < REPS(1); ++rep_) { PH(); const float* xp = IN_(0); const float* xs = IN_(1);
        load_gate_w(IN_(12), (LAS float*)lds, td); __syncthreads();
        { f32x4 cur[8], nxt[8]; const float* mr = W_(float, WS_MOD);
          row_load(xp + (size_t)(gw < SEQ ? gw : 0) * DM, cur, ln);
          for (int row = gw; row < SEQ; row += ngw) { const int nr = row + ngw; row_load(xp + (size_t)(nr < SEQ ? nr : row) * DM, nxt, ln);
              int lq = ln; asm volatile("" : "+v"(lq));
              modulate_fin(cur, mr, mr + DM, W_(bf16, WS_U) + (size_t)row * DM, (const LAS float*)lds, IN_(13), W_(float, WS_IG), W_(float, WS_LF), row, lq);
#pragma unroll
              for (int j = 0; j < 8; ++j) cur[j] = nxt[j]; }
          for (int row = SEQ + gw; row < MR; row += ngw) { const float* ms = W_(float, WS_MOD) + (size_t)mod_row(row) * NMOD; row_load(xs + (size_t)(row - SEQ) * DM, cur, ln);
              modulate_fin(cur, ms, ms + DM, W_(bf16, WS_U) + (size_t)row * DM, (const LAS float*)lds, IN_(13), W_(float, WS_IG), W_(float, WS_LF), row, ln); } }
        __syncthreads();
    }
    SEAM(1);
    for (int l = 0; l < 2; ++l) {
        const int pb = 2 + 10 * l;
        if (EN(2) && RUN(pb + 0)) for (int rep_ = 0; rep_ < REPS(2); ++rep_) { PH();
            pg8::Gemm g{W_(bf16, WS_U), W_(bf16, WS_WIN) + (size_t)l * NINP * DM, SEQ, NINP, DM, DM, 256, 0}; const GOrder S = order_static(SEQ, NINP, G, bid);
            EpiIn E{wsl, out, l};
            pg8::gemm_phase<EpiIn, GOrder, true, true>(lds, g, S, E);
        }
        SEAM(pb + 0);
        if (EN(3) && RUN(pb + 1)) for (int rep_ = 0; rep_ < REPS(3); ++rep_) { PH();
            for (;;) { const int it = dequeue(QW_(4 * l + 2 * rep_), MISC + 16, td); PHQ();
                if (it < 24) { pg8::Gemm g{W_(bf16, WS_U), W_(bf16, WS_WIN) + (size_t)l * NINP * DM, MR, NINP, DM, DM, 256, 0}; const GOrder S = order_one(32, it); EpiIn E{wsl, out, l};
                    pg8::gemm_phase<EpiIn, GOrder, true, true>(lds, g, S, E); }
                else if (it < 24 + 768) attn_prompt_unit(W_(bf16, WS_P), W_(bf16, WS_OPART), W_(float, WS_ML), it - 24, lds, ldsbase, wave, ln);
                else if (it < 24 + 768 + NUNIT / 2) mlstm_m1_item(W_(bf16, WS_P), W_(float, WS_IG), W_(float, WS_LF), W_(float, WS_SCAL), W_(float, WS_DCT), it - (24 + 768), lds, ldsbase, wave, ln);
                else break; }
            __syncthreads();
        }
        SEAM(pb + 1);
        if (EN(4) && RUN(pb + 2)) for (int rep_ = 0; rep_ < REPS(4); ++rep_) { PH();
            for (;;) { const int it = dequeue(QW_(4 * l + 2 * rep_ + 1), MISC + 16, td); PHQ();
                if (it < 129) { for (int r2 = 0; r2 < RPC(0); ++r2) mlstm_m2(W_(float, WS_SCAL), W_(float, WS_DCT), W_(bf16, WS_CST), W_(float, WS_MST), out + O_CP + (size_t)l * 65536, out + O_NP + (size_t)l * 512, out + O_MP + (size_t)l * 8, it * NTHR + td); }
                else if (it < 129 + 256) { const int u = it - 129, b = u >> 3, hd = u & 7;
#ifdef MK_SA_V1
                    sample_attn_unit_v1(W_(bf16, WS_P), IN_(2) + (size_t)l * 32 * 2048 * 1024, IN_(3) + (size_t)l * 32 * 2048 * 1024, W_(bf16, WS_CAT), b, hd, lds, wave, ln); }
#else
                    for (int r2 = 0; r2 < RPC(1); ++r2) sample_attn_unit(W_(bf16, WS_P), IN_(2) + (size_t)l * 32 * 2048 * 1024, IN_(3) + (size_t)l * 32 * 2048 * 1024, W_(bf16, WS_CAT), b, hd, lds, ldsbase, td, wave, ln); }
#endif
                else if (it < 129 + 512) { const int u = it - (129 + 256), b = u >> 3, hd = u & 7; const size_t so = ((size_t)(l * 32 + b) * 8 + hd);
                    for (int r2 = 0; r2 < RPC(2); ++r2) sample_mlstm_unit(W_(bf16, WS_P), W_(float, WS_IG), W_(float, WS_LF), IN_(4) + so * 8192, IN_(5) + so * 64, IN_(6) + so, IN_(14) + l * 1024, W_(bf16, WS_CAT), out + O_CS + so * 8192, out + O_NS + so * 64, out + O_MS + so, b, hd, lds, td, wave, ln); }
                else if (it < 129 + 512 + 256) { const int ch = it - (129 + 512); for (int r2 = 0; r2 < RPC(3); ++r2) for (int e = ch * 4096 + td; e < (ch + 1) * 4096; e += NTHR) attn_combine(W_(bf16, WS_OPART), W_(float, WS_ML), W_(bf16, WS_CAT), e); }
                else break; }
            __syncthreads();
        }
        SEAM(pb + 2);
        if (EN(5) && RUN(pb + 3)) for (int rep_ = 0; rep_ < REPS(5); ++rep_) { PH(); for (int it = bid; it < NUNIT / 4; it += G) mlstm_m3_item(W_(bf16, WS_P), W_(float, WS_SCAL), W_(bf16, WS_CST), W_(float, WS_MST), IN_(14) + l * 1024, W_(bf16, WS_CAT), it, lds, ldsbase, wave, ln); }
        SEAM(pb + 3);
        if (EN(6) && RUN(pb + 4)) for (int rep_ = 0; rep_ < REPS(6); ++rep_) { PH();
            EpiRes E{W_(float, WS_Y), l == 0 ? IN_(0) : W_(float, WS_XR), W_(float, WS_MOD) + (size_t)l * 33 * NMOD + 2 * DM, W_(float, WS_SLAB)};
#pragma nounroll
            for (int pass = 0; pass < 2; ++pass) {
                pg8::Gemm g{W_(bf16, WS_CAT), W_(bf16, WS_WOUT) + (size_t)l * DM * DM, MR, DM, pass ? 512 : DM, DM, 256, 0};
                const GOrder S = pass ? order_split(8, 4, G, bid) : order_static(SEQ, DM, G, bid);
                pg8::gemm_phase<EpiRes, GOrder, true, true>(lds, g, S, E); }
        }
        SEAM(pb + 4);
        if (EN(7) && RUN(pb + 5)) for (int rep_ = 0; rep_ < REPS(7); ++rep_) { PH(); const float* lg = IN_(16) + l * DM; const float* lb = IN_(17) + l * DM; const float* xs = l == 0 ? IN_(1) : W_(float, WS_XR) + (size_t)SEQ * DM;
            { f32x4 cur[8], nxt[8]; const float* mr = W_(float, WS_MOD) + (size_t)l * 33 * NMOD;
              row_load(W_(float, WS_Y) + (size_t)(gw < SEQ ? gw : 0) * DM, cur, ln);
              for (int row = gw; row < SEQ; row += ngw) { const int nr = row + ngw; row_load(W_(float, WS_Y) + (size_t)(nr < SEQ ? nr : row) * DM, nxt, ln);
                  int lq = ln; asm volatile("" : "+v"(lq));
                  ln_fin(cur, lg, lb, W_(float, WS_XA) + (size_t)row * DM, mr + 3 * DM, mr + 4 * DM, W_(bf16, WS_U) + (size_t)row * DM, (const LAS float*)lds, false, nullptr, nullptr, nullptr, row, lq);
#pragma unroll
                  for (int j = 0; j < 8; ++j) cur[j] = nxt[j]; }
              for (int row = SEQ + gw; row < MR; row += ngw) { const float* ms = W_(float, WS_MOD) + ((size_t)l * 33 + mod_row(row)) * NMOD;
                  slab_row_load(W_(float, WS_SLAB) + (size_t)(row - SEQ) * DM, 4, xs + (size_t)(row - SEQ) * DM, ms + 2 * DM, cur, ln);
                  ln_fin(cur, lg, lb, W_(float, WS_XA) + (size_t)row * DM, ms + 3 * DM, ms + 4 * DM, W_(bf16, WS_U) + (size_t)row * DM, (const LAS float*)lds, false, nullptr, nullptr, nullptr, row, ln); } }
        }
        SEAM(pb + 5);
        if (EN(8) && RUN(pb + 6)) for (int rep_ = 0; rep_ < REPS(8); ++rep_) { PH();
            pg8::Gemm g{W_(bf16, WS_U), W_(bf16, WS_WUP) + (size_t)l * NUP * DM, 34 * 256, NUP, DM, DM, 254, -2}; const GOrder S = order_static(34 * 256, NUP, G, bid);
            EpiUpConv E{wsl, out, ka->in, l};
            pg8::gemm_phase<EpiUpConv, GOrder, true, true>(lds, g, S, E);
        }
        SEAM(pb + 6);
        if (EN(10) && RUN(pb + 8)) for (int rep_ = 0; rep_ < REPS(10); ++rep_) { PH();
            EpiRes E{W_(float, WS_Y), W_(float, WS_XA), W_(float, WS_MOD) + (size_t)l * 33 * NMOD + 5 * DM, W_(float, WS_SLAB)};
#pragma nounroll
            for (int pass = 0; pass < 2; ++pass) {
                pg8::Gemm g{W_(bf16, WS_ACT), W_(bf16, WS_WDN) + (size_t)l * DM * DFF, MR, DM, pass ? 512 : DFF, DFF, 256, 0};
                const GOrder S = pass ? order_split(8, 11, G, bid) : order_static(SEQ, DM, G, bid);
                pg8::gemm_phase<EpiRes, GOrder, true, true>(lds, g, S, E); }
        }
        SEAM(pb + 8);
        if (EN(11) && RUN(pb + 9)) for (int rep_ = 0; rep_ < REPS(11); ++rep_) { PH(); const float* lg = IN_(22) + l * DM; const float* lb = IN_(23) + l * DM; float* xo = l == 0 ? W_(float, WS_XR) : out + O_XP;
            if (l == 0) { load_gate_w(IN_(12) + (size_t)DM * DIN, (LAS float*)lds, td); __syncthreads(); }
            { f32x4 cur[8]; const float* mr = W_(float, WS_MOD) + (size_t)33 * NMOD;
              bf16* const Ub = l == 0 ? W_(bf16, WS_U) : (bf16*)nullptr;
              for (int row = gw; row < SEQ; row += ngw) { int lq = ln; asm volatile("" : "+v"(lq)); row_load(W_(float, WS_Y) + (size_t)row * DM, cur, lq);
                  ln_fin(cur, lg, lb, xo + (size_t)row * DM, mr, mr + DM, Ub ? Ub + (size_t)row * DM : Ub, (const LAS float*)lds, l == 0, IN_(13) + 16, W_(float, WS_IG), W_(float, WS_LF), row, lq); }
              for (int row = SEQ + gw; row < MR; row += ngw) { const float* ms = W_(float, WS_MOD) + (size_t)(33 + mod_row(row)) * NMOD; const float* ms0 = W_(float, WS_MOD) + ((size_t)l * 33 + mod_row(row)) * NMOD;
                  slab_row_load(W_(float, WS_SLAB) + (size_t)(row - SEQ) * DM, 11, W_(float, WS_XA) + (size_t)row * DM, ms0 + 5 * DM, cur, ln);
                  ln_fin(cur, lg, lb, xo + (size_t)row * DM, ms, ms + DM, Ub ? Ub + (size_t)row * DM : Ub, (const LAS float*)lds, l == 0, IN_(13) + 16, W_(float, WS_IG), W_(float, WS_LF), row, ln); } }
            __syncthreads();
        }
        SEAM(pb + 9);
    }
#undef RUN
#undef SEAM
}

extern "C" void kernel_launch(void* const* d_in, const int* in_sizes, int n_in, void* d_out, int out_size, void* d_ws, size_t ws_size, hipStream_t stream) {
    static int grid = 0;
    if (grid == 0) {
        if (n_in != 24 || out_size != (int)O_END || ws_size < WS_END) { fprintf(stderr, "kernel_launch: unexpected shapes: n_in %d out %d ws %zu (need %zu)\n", n_in, out_size, ws_size, (size_t)WS_END); grid = -1; return; }
        int dev = 0, cus = 0, per_cu = 0;
        if (hipGetDevice(&dev) != hipSuccess || hipDeviceGetAttribute(&cus, hipDeviceAttributeMultiprocessorCount, dev) != hipSuccess) { fprintf(stderr, "kernel_launch: device query failed\n"); grid = -1; return; }
        if (hipFuncSetAttribute((const void*)mk_fwd, hipFuncAttributeMaxDynamicSharedMemorySize, LDS_BYTES) != hipSuccess) { fprintf(stderr, "kernel_launch: hipFuncSetAttribute failed\n"); grid = -1; return; }
        if (hipOccupancyMaxActiveBlocksPerMultiprocessor(&per_cu, (const void*)mk_fwd, NTHR, LDS_BYTES) != hipSuccess || per_cu < 1) fprintf(stderr, "kernel_launch: note: occupancy query reports %d blocks per CU\n", per_cu);
        (void)hipGetLastError();
        grid = cus;
    }
    if (grid < 0) return;
    (void)in_sizes;
    if (hipMemsetAsync((char*)d_ws + WS_CTL, 0, CTL_ZERO_BYTES, stream) != hipSuccess) { fprintf(stderr, "kernel_launch: memset failed\n"); return; }
    Args a{};
    for (int i = 0; i < 24; ++i) a.in[i] = (const float*)d_in[i];
    a.out = (float*)d_out; a.ws = (unsigned char*)d_ws; a.pad = 0;
#if MK_SPLIT
    for (int p = 0; p < N_PHASES; ++p) { a.ph_lo = p; a.ph_hi = p + 1; a.li = p; hipLaunchKernelGGL(mk_fwd, dim3(grid), dim3(NTHR), LDS_BYTES, stream, a); }
#else
    a.ph_lo = 0; a.ph_hi = N_PHASES; a.li = 0;
    hipLaunchKernelGGL(mk_fwd, dim3(grid), dim3(NTHR), LDS_BYTES, stream, a);
#endif
    const hipError_t le = hipPeekAtLastError();
    if (le != hipSuccess) fprintf(stderr, "kernel_launch: launch failed: %s\n", hipGetErrorName(le));
}
```
